# Optimizing an MI355X kernel written in HIP

```python
import jax, jax.numpy as jnp
from jax import lax
import numpy as np

D_MODEL = 2048
BATCH = 8
SEQ = 2048
DEPTH = 1

MIX_WIDTH = D_MODEL
HG_WIDTH = MIX_WIDTH // 2
HG_HEAD_DIM = 128
HG_HEADS = HG_WIDTH // HG_HEAD_DIM
HG_CHUNK = 64
NSA_WIDTH = MIX_WIDTH - HG_WIDTH
NSA_HEAD_DIM = 64
NSA_Q_HEADS = NSA_WIDTH // NSA_HEAD_DIM
NSA_KV_HEADS = 4
NSA_GROUP = NSA_Q_HEADS // NSA_KV_HEADS
CMP_BLOCK = 32
CMP_STRIDE = 16
CMP_HIDDEN = 256
SEL_BLOCK = 64
N_SELECT = 16
N_LOCAL = 2
WINDOW = 512
Q_BLOCK = 128
SEL_Q_BLOCK = 32
FORCE_SCORE = 1e9
NEG_INF = -1e30
PEER_HEADS = 8
N_KEYS = 128
N_EXPERTS = N_KEYS * N_KEYS
PEER_KEY_DIM = 256
PEER_TOPK = 16
PEER_TOKEN_BLOCK = 128
NORM_EPS = 1e-6

KV_W = NSA_KV_HEADS * NSA_HEAD_DIM
N_GATES = 3 * NSA_Q_HEADS
IN_SIZES = [HG_WIDTH, HG_WIDTH, HG_WIDTH, HG_WIDTH,
            NSA_WIDTH,
            KV_W, KV_W, KV_W, KV_W, KV_W, KV_W,
            N_GATES]
IN_COLS = sum(IN_SIZES)

kernel_name = "hymba_hgrn2_nsa_peer"


def rms_norm(x, w):
    xf = x.astype(jnp.float32)
    y = xf * lax.rsqrt(jnp.mean(xf * xf, axis=-1, keepdims=True) + NORM_EPS)
    return (y * w.astype(jnp.float32)).astype(x.dtype)


def masked_softmax(s, mask):
    p = jax.nn.softmax(jnp.where(mask, s, NEG_INF), axis=-1)
    return jnp.where(mask, p, 0.0)


def alibi_slopes(n):
    return jnp.asarray(2.0 ** (-8.0 * np.arange(1, n + 1) / n), dtype=jnp.float32)


def hgrn2_mixer(q, f_logit, i_in, g, lb, norm_w):
    B, T, _ = q.shape
    H, dk, C = HG_HEADS, HG_HEAD_DIM, HG_CHUNK
    nc = T // C
    f = lb + (1.0 - lb) * jax.nn.sigmoid(f_logit.astype(jnp.float32))

    def chunks(a):
        return a.astype(jnp.float32).reshape(B, nc, C, H, dk).transpose(0, 3, 1, 2, 4)

    qc, kc, vc, lfc = chunks(q), chunks(1.0 - f), chunks(i_in), chunks(jnp.log(f))
    b = jnp.cumsum(lfc, axis=3)
    b_end = b[:, :, :, -1:, :]
    q_dec = qc * jnp.exp(b)
    causal = np.tril(np.ones((C, C), dtype=bool))
    attn = jnp.where(causal, jnp.einsum('bhntc,bhnsc->bhnts', q_dec, kc * jnp.exp(-b)), 0.0)
    o_intra = jnp.einsum('bhnts,bhnsv->bhntv', attn, vc)
    upd = jnp.einsum('bhnsc,bhnsv->bhncv', kc * jnp.exp(b_end - b), vc)
    dec = jnp.exp(b_end[:, :, :, 0, :])

    def step(state, inp):
        d, u = inp
        return d[..., None] * state + u, state

    s0 = jnp.zeros((B, H, dk, dk), jnp.float32)
    _, s_prev = lax.scan(step, s0, (jnp.moveaxis(dec, 2, 0), jnp.moveaxis(upd, 2, 0)))
    o_inter = jnp.einsum('bhntc,nbhcv->bhntv', q_dec, s_prev)
    o = (o_intra + o_inter).transpose(0, 2, 3, 1, 4).reshape(B, T, H, dk)
    o = rms_norm(o, norm_w) * jax.nn.silu(g.astype(jnp.float32).reshape(B, T, H, dk))
    return o.reshape(B, T, H * dk).astype(q.dtype)


def nsa_mixer(q, kc, vc, ks, vs, kw, vw, gate_logits, q_norm_w, kc_norm_w, ks_norm_w, kw_norm_w,
              pos_k, pos_v, w_ck1, w_ck2, w_cv1, w_cv2):
    B, T, _ = q.shape
    Hkv, G, dh = NSA_KV_HEADS, NSA_GROUP, NSA_HEAD_DIM
    f32 = jnp.float32
    slopes = alibi_slopes(NSA_Q_HEADS).reshape(Hkv, G)
    qn = rms_norm(q.reshape(B, T, Hkv, G, dh), q_norm_w).transpose(0, 2, 3, 1, 4) * (dh ** -0.5)

    def kv_heads(a):
        return a.reshape(B, T, Hkv, dh).transpose(0, 2, 1, 3)

    t_pos = np.arange(T)

    n_cmp = (T - CMP_BLOCK) // CMP_STRIDE + 1
    cmp_start = np.arange(n_cmp) * CMP_STRIDE
    blk_idx = cmp_start[:, None] + np.arange(CMP_BLOCK)[None, :]
    cmp_end = cmp_start + CMP_BLOCK - 1

    def compress(a, pos, w1, w2):
        blocks = kv_heads(a)[:, :, blk_idx] + pos
        flat = blocks.reshape(B, Hkv, n_cmp, CMP_BLOCK * dh)
        return jax.nn.gelu(flat @ w1) @ w2

    k_cmp = rms_norm(compress(kc, pos_k, w_ck1, w_ck2), kc_norm_w)
    v_cmp = compress(vc, pos_v, w_cv1, w_cv2)
    dist_c = t_pos[:, None] - cmp_end[None, :]
    s_c = jnp.einsum('bgrtd,bgnd->bgrtn', qn, k_cmp).astype(f32) \
        - slopes[:, :, None, None] * dist_c.astype(np.float32)
    p_cmp = masked_softmax(s_c, dist_c >= 0)
    o_cmp = jnp.einsum('bgrtn,bgnd->bgrtd', p_cmp, v_cmp)

    n_sel = T // SEL_BLOCK
    sel_start = np.arange(n_sel) * SEL_BLOCK
    overlap = ((cmp_start[:, None] < sel_start[None, :] + SEL_BLOCK)
               & (cmp_start[:, None] + CMP_BLOCK > sel_start[None, :])).astype(np.float32)
    imp = jnp.einsum('bgrtn,nj->bgtj', p_cmp, overlap)
    cur = t_pos // SEL_BLOCK
    j = np.arange(n_sel)
    forced = (j[None, :] == 0) | ((j[None, :] <= cur[:, None]) & (j[None, :] > cur[:, None] - N_LOCAL))
    future = j[None, :] > cur[:, None]
    imp = jnp.where(forced, FORCE_SCORE, jnp.where(future, -FORCE_SCORE, imp))
    n_top = min(N_SELECT, n_sel)
    _, sel_idx = lax.top_k(imp, n_top)

    k_sel = kv_heads(rms_norm(ks.reshape(B, T, Hkv * 1, dh), ks_norm_w).reshape(B, T, KV_W)) \
        .reshape(B, Hkv, n_sel, SEL_BLOCK, dh)
    v_sel = kv_heads(vs).reshape(B, Hkv, n_sel, SEL_BLOCK, dh)
    bi = jnp.arange(B)[:, None, None, None]
    gi = jnp.arange(Hkv)[None, :, None, None]
    m_keys = n_top * SEL_BLOCK

    def sel_block(args):
        q_b, idx_b, start = args
        k_g = k_sel[bi, gi, idx_b].reshape(B, Hkv, SEL_Q_BLOCK, m_keys, dh)
        v_g = v_sel[bi, gi, idx_b].reshape(B, Hkv, SEL_Q_BLOCK, m_keys, dh)
        key_pos = (idx_b[..., None] * SEL_BLOCK + jnp.arange(SEL_BLOCK)).reshape(B, Hkv, SEL_Q_BLOCK, m_keys)
        dist = ((start + jnp.arange(SEL_Q_BLOCK))[:, None] - key_pos)[:, :, None]
        s = jnp.einsum('bgrqd,bgqmd->bgrqm', q_b, k_g).astype(f32) \
            - slopes[None, :, :, None, None] * dist.astype(f32)
        p = masked_softmax(s, dist >= 0)
        return jnp.einsum('bgrqm,bgqmd->bgrqd', p, v_g)

    n_qb = T // SEL_Q_BLOCK
    q_blocks = qn.reshape(B, Hkv, G, n_qb, SEL_Q_BLOCK, dh).transpose(3, 0, 1, 2, 4, 5)
    idx_blocks = sel_idx.reshape(B, Hkv, n_qb, SEL_Q_BLOCK, n_top).transpose(2, 0, 1, 3, 4)
    starts = jnp.arange(n_qb, dtype=jnp.int32) * SEL_Q_BLOCK
    o_sel = lax.map(sel_block, (q_blocks, idx_blocks, starts))
    o_sel = o_sel.transpose(1, 2, 3, 0, 4, 5).reshape(B, Hkv, G, T, dh)

    pad = ((0, 0), (0, 0), (WINDOW, 0), (0, 0))
    k_win = jnp.pad(kv_heads(rms_norm(kw.reshape(B, T, Hkv, dh), kw_norm_w).reshape(B, T, KV_W)), pad)
    v_win = jnp.pad(kv_heads(vw), pad)
    span = Q_BLOCK + WINDOW
    dist_w = np.arange(Q_BLOCK)[:, None] + WINDOW - np.arange(span)[None, :]

    def win_block(args):
        q_b, start = args
        k_b = lax.dynamic_slice_in_dim(k_win, start, span, axis=2)
        v_b = lax.dynamic_slice_in_dim(v_win, start, span, axis=2)
        key_pos = start - WINDOW + jnp.arange(span)
        mask = (dist_w >= 0) & (dist_w < WINDOW) & (key_pos >= 0)[None, :]
        s = jnp.einsum('bgrqd,bgkd->bgrqk', q_b, k_b).astype(f32) \
            - slopes[:, :, None, None] * dist_w.astype(np.float32)
        p = masked_softmax(s, mask)
        return jnp.einsum('bgrqk,bgkd->bgrqd', p, v_b)

    n_wb = T // Q_BLOCK
    q_wblocks = qn.reshape(B, Hkv, G, n_wb, Q_BLOCK, dh).transpose(3, 0, 1, 2, 4, 5)
    w_starts = jnp.arange(n_wb, dtype=jnp.int32) * Q_BLOCK
    o_win = lax.map(win_block, (q_wblocks, w_starts))
    o_win = o_win.transpose(1, 2, 3, 0, 4, 5).reshape(B, Hkv, G, T, dh)

    gates = jax.nn.sigmoid(gate_logits.astype(f32)).reshape(B, T, Hkv, G, 3).transpose(0, 2, 3, 1, 4)
    o = gates[..., 0:1] * o_cmp + gates[..., 1:2] * o_sel + gates[..., 2:3] * o_win
    return o.transpose(0, 3, 1, 2, 4).reshape(B, T, NSA_WIDTH).astype(q.dtype)


def peer_ffn(x, w_q, sub_keys, u_tab, v_tab):
    B, T, D = x.shape
    n = B * T
    H, K = PEER_HEADS, PEER_TOPK
    xt = x.reshape(n, D)
    q = (xt @ w_q).reshape(n, H, 2, PEER_KEY_DIM // 2)
    s = jnp.einsum('nhpd,hpkd->nhpk', q, sub_keys).astype(jnp.float32)
    s_top, i_top = lax.top_k(s, K)
    cand_s = (s_top[:, :, 0, :, None] + s_top[:, :, 1, None, :]).reshape(n, H, K * K)
    cand_i = (i_top[:, :, 0, :, None] * N_KEYS + i_top[:, :, 1, None, :]).reshape(n, H, K * K)
    best_s, best_pos = lax.top_k(cand_s, K)
    expert = jnp.take_along_axis(cand_i, best_pos, axis=-1)
    gate = jax.nn.softmax(best_s, axis=-1).astype(x.dtype)
    nb = n // PEER_TOKEN_BLOCK

    def block(args):
        xb, eb, gb = args
        act = jax.nn.gelu(jnp.einsum('td,thkd->thk', xb, u_tab[eb]))
        return jnp.einsum('thk,thkd->td', gb * act, v_tab[eb])

    out = lax.map(block, (xt.reshape(nb, PEER_TOKEN_BLOCK, D),
                          expert.reshape(nb, PEER_TOKEN_BLOCK, H, K),
                          gate.reshape(nb, PEER_TOKEN_BLOCK, H, K)))
    return out.reshape(B, T, D)


def setup_inputs(seed: int = 0) -> dict:
    key = jax.random.key(seed)
    ks = jax.random.split(key, 24)
    f32 = jnp.float32
    L, dh = DEPTH, NSA_HEAD_DIM

    def nrm(k, shape, scale):
        return jax.random.normal(k, shape, f32) * scale

    def gain(k, shape):
        return 1.0 + 0.01 * jax.random.normal(k, shape, f32)

    return {
        "x": nrm(ks[0], (BATCH, SEQ, D_MODEL), 1.0),
        "norm1_w": gain(ks[1], (L, D_MODEL)),
        "w_in": nrm(ks[2], (L, D_MODEL, IN_COLS), D_MODEL ** -0.5),
        "hg_lb_logits": nrm(ks[3], (L + 1, HG_WIDTH), 0.1),
        "hg_norm_w": gain(ks[4], (L, HG_HEAD_DIM)),
        "q_norm_w": gain(ks[5], (L, dh)),
        "kc_norm_w": gain(ks[6], (L, dh)),
        "ks_norm_w": gain(ks[7], (L, dh)),
        "kw_norm_w": gain(ks[8], (L, dh)),
        "cmp_pos_k": nrm(ks[9], (L, CMP_BLOCK, dh), 0.1),
        "cmp_pos_v": nrm(ks[10], (L, CMP_BLOCK, dh), 0.1),
        "w_ck1": nrm(ks[11], (L, CMP_BLOCK * dh, CMP_HIDDEN), (CMP_BLOCK * dh) ** -0.5),
        "w_ck2": nrm(ks[12], (L, CMP_HIDDEN, dh), CMP_HIDDEN ** -0.5),
        "w_cv1": nrm(ks[13], (L, CMP_BLOCK * dh, CMP_HIDDEN), (CMP_BLOCK * dh) ** -0.5),
        "w_cv2": nrm(ks[14], (L, CMP_HIDDEN, dh), CMP_HIDDEN ** -0.5),
        "w_out": nrm(ks[15], (L, MIX_WIDTH, D_MODEL), MIX_WIDTH ** -0.5),
        "norm2_w": gain(ks[16], (L, D_MODEL)),
        "peer_w_q": nrm(ks[17], (L, D_MODEL, PEER_HEADS * PEER_KEY_DIM), D_MODEL ** -0.5),
        "peer_sub_keys": nrm(ks[18], (L, PEER_HEADS, 2, N_KEYS, PEER_KEY_DIM // 2), (PEER_KEY_DIM // 2) ** -0.5),
        "peer_u": nrm(ks[19], (L, N_EXPERTS, D_MODEL), D_MODEL ** -0.5),
        "peer_v": nrm(ks[20], (L, N_EXPERTS, D_MODEL), PEER_HEADS ** -0.5),
    }


def reference(x, norm1_w, w_in, hg_lb_logits, hg_norm_w, q_norm_w, kc_norm_w, ks_norm_w, kw_norm_w,
              cmp_pos_k, cmp_pos_v, w_ck1, w_ck2, w_cv1, w_cv2, w_out, norm2_w,
              peer_w_q, peer_sub_keys, peer_u, peer_v):
    split_at = np.cumsum(IN_SIZES)[:-1].tolist()
    lower_bounds = jnp.cumsum(jax.nn.softmax(hg_lb_logits.astype(jnp.float32), axis=0), axis=0)
    h = x
    for layer in range(DEPTH):
        hn = rms_norm(h, norm1_w[layer])
        (hq, hf, hi, hg, nq, nkc, nvc, nks, nvs, nkw, nvw, ngate) = jnp.split(hn @ w_in[layer], split_at, axis=-1)
        hg_out = hgrn2_mixer(hq, hf, hi, hg, lower_bounds[layer], hg_norm_w[layer])
        nsa_out = nsa_mixer(nq, nkc, nvc, nks, nvs, nkw, nvw, ngate,
                            q_norm_w[layer], kc_norm_w[layer], ks_norm_w[layer], kw_norm_w[layer],
                            cmp_pos_k[layer], cmp_pos_v[layer], w_ck1[layer], w_ck2[layer],
                            w_cv1[layer], w_cv2[layer])
        h = h + jnp.concatenate([hg_out, nsa_out], axis=-1) @ w_out[layer]
        h = h + peer_ffn(rms_norm(h, norm2_w[layer]), peer_w_q[layer], peer_sub_keys[layer],
                         peer_u[layer], peer_v[layer])
    return h
```

```cpp
#include <hip/hip_runtime.h>
#include <hip/hip_cooperative_groups.h>
#include <cstdio>
#include <cstdint>
namespace cg = cooperative_groups;

#define DI __device__ __forceinline__
#define LAS __attribute__((address_space(3)))
typedef unsigned short bf16_t;
typedef short bf16x8 __attribute__((ext_vector_type(8)));
typedef float f32x2 __attribute__((ext_vector_type(2)));
typedef float f32x4 __attribute__((ext_vector_type(4)));
typedef float f32x16 __attribute__((ext_vector_type(16)));
typedef unsigned u32x2 __attribute__((ext_vector_type(2)));
typedef int i32x4 __attribute__((ext_vector_type(4)));
typedef unsigned u32x4 __attribute__((ext_vector_type(4)));
typedef __bf16 bf16x2_t __attribute__((ext_vector_type(2)));

constexpr int DM = 2048, NB = 8, SEQ = 2048, M = NB * SEQ;
constexpr int NPROJ = 6704, NP = 6912;
constexpr int C_HQ = 0, C_HF = 1024, C_HI = 2048, C_HG = 3072, C_NQ = 4096, C_NKC = 5120, C_NVC = 5376, C_NKS = 5632, C_NVS = 5888, C_NKW = 6144, C_NVW = 6400, C_GATE = 6656;
constexpr float EPS = 1e-6f;
constexpr float LOG2E = 1.4426950408889634f;

constexpr size_t MiB = 1u << 20;
constexpr size_t WS_CTL = 0, CTL_BYTES = 1 * MiB;
constexpr size_t WS_WIN = 1 * MiB;
constexpr size_t WS_WOUT = 28 * MiB;
constexpr size_t WS_WQ = 36 * MiB;
constexpr size_t WS_SMALL = 44 * MiB;
constexpr size_t WS_UB = 52 * MiB;
constexpr size_t WS_VB = 116 * MiB;
constexpr size_t TAB_SCALE_OFF = 32 * MiB;
constexpr size_t WS_P = 180 * MiB;
constexpr size_t WS_XN = 396 * MiB;
constexpr size_t WS_VT = 460 * MiB;
constexpr size_t WS_SSQ = 476 * MiB;
constexpr size_t WS_LISTM = 478 * MiB;
constexpr size_t WS_END = 494 * MiB;
constexpr size_t WS_MIX8 = WS_P + 64 * MiB;
constexpr size_t WS_QP = WS_P + 64 * MiB;
constexpr size_t WS_EI = WS_P + 128 * MiB;
constexpr size_t WS_EG = WS_P + 136 * MiB;
constexpr size_t WS_W = WS_P + 144 * MiB;
constexpr size_t WS_PU = WS_P;
constexpr size_t WS_LIST = WS_P + 152 * MiB;
constexpr size_t WS_PIDX = WS_VT;
constexpr size_t WS_HQ8 = WS_WIN;
constexpr size_t WS_DQ = WS_WIN + 32 * MiB;
constexpr size_t SM_W1K = WS_SMALL;
constexpr size_t SM_W1V = WS_SMALL + 1 * MiB;
constexpr size_t SM_W2K = WS_SMALL + 2 * MiB;
constexpr size_t SM_W2V = SM_W2K + 32768;
constexpr size_t SM_SK = WS_SMALL + 3 * MiB;
constexpr size_t SM_LB = WS_SMALL + 4 * MiB;
constexpr size_t SM_BIASP = SM_LB + 4096;
constexpr size_t SM_KC = WS_SMALL + 5 * MiB;
constexpr size_t SM_SWC = WS_SMALL + 7 * MiB;
constexpr size_t SM_SWQ = WS_SMALL + 7 * MiB + 32768;
constexpr size_t SM_SWO = WS_SMALL + 7 * MiB + 49152;
constexpr size_t SM_VCT = WS_SMALL + 6 * MiB;
static_assert(WS_END <= 512 * MiB, "ws");
constexpr int CW_QUEUE = 64;
constexpr int CW_PQU = 8192, CW_PQV = 9216;
constexpr int CW_ROLE = 10240;
constexpr int CW_CNT = 16384;
constexpr int CW_OFF = 32768;
constexpr int CW_XBAR = 4096;

constexpr int LDS_BYTES = 151552;
constexpr int NTHREADS = 512, NWAVES = 8;

DI unsigned pk2(float lo, float hi) { f32x2 v = {lo, hi}; bf16x2_t b = __builtin_convertvector(v, bf16x2_t); return __builtin_bit_cast(unsigned, b); }
DI bf16_t f2bf(float f) { return (bf16_t)(pk2(f, 0.f) & 0xffffu); }
DI float bf2f(bf16_t u) { return __uint_as_float((unsigned)u << 16); }
DI float bflo(unsigned u) { return __uint_as_float(u << 16); }
DI float bfhi(unsigned u) { return __uint_as_float(u & 0xffff0000u); }
DI float wave_sum(float v) {
#pragma unroll
    for (int o = 1; o < 64; o <<= 1) v += __shfl_xor(v, o);
    return v;
}
DI float fast_exp2(float x) { return __builtin_amdgcn_exp2f(x); }
DI float fast_rcp(float x) { return __builtin_amdgcn_rcpf(x); }
DI float sigmoidf_(float x) { return fast_rcp(1.f + fast_exp2(-x * LOG2E)); }
DI float gelu_tanh(float x) {
    const float u = 0.7978845608028654f * (x + 0.044715f * x * x * x);
    return x * sigmoidf_(2.f * u);
}
#define LDS_WAIT() asm volatile("s_waitcnt lgkmcnt(0)" ::: "memory")
#define MFMA32(a, b, c) __builtin_amdgcn_mfma_f32_32x32x16_bf16((a), (b), (c), 0, 0, 0)
#define MFMA16(a, b, c) __builtin_amdgcn_mfma_f32_16x16x32_bf16((a), (b), (c), 0, 0, 0)
DI int crow(int r, int hi) { return (r & 3) + 8 * (r >> 2) + 4 * hi; }

namespace pg8 {
constexpr int BM = 256, BK = 64, HALF = 128, HTB = HALF * BK * 2, STAGE_BYTES = 8 * HTB, NXCD = 8, WGM = 8;
__host__ __device__ __forceinline__ int lds_byte(int r, int c) { const int st = (r >> 4) * 2 + (c >> 5), rr = r & 15, cc = c & 31, ob = rr * 64 + cc * 2; return st * 1024 + (ob ^ (((ob >> 9) & 1) << 5)); }
__host__ __device__ __forceinline__ void stage_rc(int b, int& R, int& C) { const int st = b / 1024, sb = b % 1024, swz = sb ^ (((sb >> 9) & 1) << 5); R = (st >> 1) * 16 + swz / 64; C = (st & 1) * 32 + (swz % 64) / 2; }
__host__ __device__ __forceinline__ int perm32(int rho) { const int n = rho >> 4, i = rho & 15; return 8 * (i >> 2) + 4 * n + (i & 3); }
struct Unit { int pm, pn; };
template <bool I8> __device__ __forceinline__ f32x4 mma1(const bf16x8 b, const bf16x8 a, const f32x4 c) {
    if constexpr (I8) return __builtin_bit_cast(f32x4, __builtin_amdgcn_mfma_i32_16x16x64_i8(__builtin_bit_cast(i32x4, b), __builtin_bit_cast(i32x4, a), __builtin_bit_cast(i32x4, c), 0, 0, 0));
    else return __builtin_amdgcn_mfma_f32_16x16x32_bf16(b, a, c, 0, 0, 0); }
struct Gemm { const bf16_t* A; const bf16_t* Bt; int M, N, K; };
struct StaticOrder {
    int nM, nN, nwg, G, c;
    __host__ __device__ void init(int M_, int N_, int G_, int c_) { nM = M_ / BM; nN = N_ / BM; nwg = nM * nN; G = G_; c = c_; }
    __host__ __device__ bool next(int i, Unit& u) const {
        const long L = (long)i * G + c; if (L >= nwg) return false;
        int wgid = (int)L; { const int q = nwg / NXCD, r = nwg % NXCD, xcd = wgid % NXCD, off = wgid / NXCD; wgid = (xcd < r ? xcd * (q + 1) : r * (q + 1) + (xcd - r) * q) + off; }
        const int nig = WGM * nN, gid = wgid / nig, fm = gid * WGM, gsz = (nM - fm) < WGM ? (nM - fm) : WGM;
        u.pm = fm + ((wgid % nig) % gsz); u.pn = (wgid % nig) / gsz; return true;
    }
    __device__ __forceinline__ void a_ready(const Unit&) const {}
    __device__ __forceinline__ void done(const Unit&) const {}
};
struct EpiBf16 {
    static constexpr bool PERM = true, AFTER_DRAIN = false;
    bf16_t* O; int ldc; const float* ssqp;
    const float* lbp = nullptr;
    const float* sa = nullptr; const float* sw = nullptr;
    __device__ __forceinline__ void operator()(const f32x4 (&acc)[2][2][4][2], const Unit& u, int wr, int wc, int fr, int fq) const {
        const int row0 = u.pm * BM + wr * 64 + fr; const int col0 = u.pn * BM + wc * 32 + 8 * fq;
#pragma unroll
        for (int ai = 0; ai < 2; ++ai)
#pragma unroll
            for (int m = 0; m < 4; ++m) { const int row = row0 + ai * HALF + m * 16; bf16_t* rowp = O + (size_t)row * ldc + col0;
                float sc = 1.f;
                if (ssqp) { const f32x4* sp = (const f32x4*)(ssqp + (size_t)row * 32); float s = 0.f;
#pragma unroll
                    for (int i = 0; i < 8; ++i) { const f32x4 v = sp[i]; s += (v[0] + v[1]) + (v[2] + v[3]); }
                    sc = __builtin_amdgcn_rsqf(s * (1.f / DM) + EPS); }
                if (sa) sc = sa[row];
#pragma unroll
                for (int bj = 0; bj < 2; ++bj) { f32x4 v0, v1;
                    if (sa) { const f32x4 s0 = *(const f32x4*)(sw + col0 + bj * HALF) * sc, s1 = *(const f32x4*)(sw + col0 + bj * HALF + 4) * sc;
                        v0 = __builtin_convertvector(__builtin_bit_cast(i32x4, acc[ai][bj][m][0]), f32x4) * s0; v1 = __builtin_convertvector(__builtin_bit_cast(i32x4, acc[ai][bj][m][1]), f32x4) * s1; }
                    else { v0 = acc[ai][bj][m][0] * sc; v1 = acc[ai][bj][m][1] * sc; }
                    if (lbp && (unsigned)(u.pn - 4) < 4u) { const int c = col0 + bj * HALF - 1024; const f32x4 l0 = *(const f32x4*)(lbp + c), l1 = *(const f32x4*)(lbp + c + 4);
#pragma unroll
                        for (int i = 0; i < 4; ++i) { v0[i] = (1.f - l0[i]) * __builtin_amdgcn_rcpf(1.f + __builtin_amdgcn_exp2f(v0[i] * 1.4426950408889634f));
                                                      v1[i] = (1.f - l1[i]) * __builtin_amdgcn_rcpf(1.f + __builtin_amdgcn_exp2f(v1[i] * 1.4426950408889634f)); } }
                    u32x4 w; w.x = pk2(v0[0], v0[1]); w.y = pk2(v0[2], v0[3]); w.z = pk2(v1[0], v1[1]); w.w = pk2(v1[2], v1[3]);
                    *(u32x4*)(rowp + bj * HALF) = w; } }
    }
};
struct EpiH {
    static constexpr bool PERM = false, AFTER_DRAIN = false;
    const float* x; float* out; const float* sa; const float* sw; LAS unsigned char* scr;
    __device__ __forceinline__ void operator()(const f32x4 (&acc)[2][2][4][2], const Unit& u, int wr, int wc, int fr, int fq) const {
        const int lane = fr + 16 * fq, wid = wr * 4 + wc;
        LAS unsigned char* t = scr + wid * 2048;
        const int rr = lane >> 3, c4 = lane & 7;
        const int colb = u.pn * BM + wc * 32 + 4 * c4;
        const f32x4 swv[2] = {*(const f32x4*)(sw + colb), *(const f32x4*)(sw + colb + HALF)};
        f32x4 xv[2][2]; float sv[2];
        auto loadx = [&](int g) { const int ai = g >> 2, m = g & 3; const int row = u.pm * BM + ai * HALF + wr * 64 + m * 16 + rr;
            sv[0] = sa[row]; sv[1] = sa[row + 8];
#pragma unroll
            for (int bj = 0; bj < 2; ++bj)
#pragma unroll
                for (int k = 0; k < 2; ++k) xv[bj][k] = *(const f32x4*)(x + (size_t)(row + 8 * k) * DM + colb + bj * HALF); };
        loadx(0);
#pragma unroll
        for (int g = 0; g < 8; ++g) { const int ai = g >> 2, m = g & 3; const int row = u.pm * BM + ai * HALF + wr * 64 + m * 16 + rr;
            f32x4 xc[2][2]; const float sc[2] = {sv[0], sv[1]};
#pragma unroll
            for (int bj = 0; bj < 2; ++bj)
#pragma unroll
                for (int k = 0; k < 2; ++k) xc[bj][k] = xv[bj][k];
            if (g + 1 < 8) loadx(g + 1);
#pragma unroll
            for (int bj = 0; bj < 2; ++bj) {
                *(LAS f32x4*)(t + fr * 128 + (4 * fq) * 4) = acc[ai][bj][m][0]; *(LAS f32x4*)(t + fr * 128 + (16 + 4 * fq) * 4) = acc[ai][bj][m][1];
                asm volatile("s_waitcnt lgkmcnt(0)" ::: "memory");
#pragma unroll
                for (int k = 0; k < 2; ++k) { const f32x4 v = __builtin_convertvector(*(const LAS i32x4*)(t + (rr + 8 * k) * 128 + c4 * 16), f32x4) * (swv[bj] * sc[k]) + xc[bj][k];
                    *(f32x4*)(out + (size_t)(row + 8 * k) * DM + colb + bj * HALF) = v; }
                asm volatile("s_waitcnt lgkmcnt(0)" ::: "memory");
            }
        }
    }
};

template <class Epi, class Sched, bool ALIGN_EPI = false, bool SP2 = false, bool I8 = false>
__device__ __forceinline__ void gemm_phase(LAS unsigned char* lds, const Gemm g, const Sched& S, const Epi& E) {
    const int tid = threadIdx.x, wid = __builtin_amdgcn_readfirstlane(tid >> 6), lane = tid & 63, wr = wid >> 2, wc = wid & 3, fr = lane & 15, fq = lane >> 4;
    const int K = g.K, nt = K / BK;
    unsigned voffA[2], voffB[2];
#pragma unroll
    for (int i = 0; i < 2; ++i) { int R, C; stage_rc(tid * 16 + i * 8192, R, C); const int Rb = Epi::PERM ? ((R & ~31) + perm32(R & 31)) : R;
        voffA[i] = (unsigned)(R * K + C) * 2u; voffB[i] = (unsigned)(Rb * K + C) * 2u; }
    const size_t kstep = (size_t)(BK * 2);
    const size_t hstep = (size_t)HALF * K * 2;
    const size_t tstep = 2 * hstep;
    const unsigned ldsw = (unsigned)wid * 1024u;
    const int aoff = lds_byte(wr * 64 + fr, fq * 8), boff = lds_byte(wc * 32 + fr, fq * 8);
#define PG8_SA(b, h) (((b) * 2 + (h)) * HTB)
#define PG8_SB(b, h) ((4 + (b) * 2 + (h)) * HTB)
#define PG8_STAGE(bufoff, gbase, voff) do { _Pragma("unroll") for (int _i = 0; _i < 2; ++_i) \
        __builtin_amdgcn_global_load_lds((const unsigned*)((const char*)(gbase) + (voff)[_i]), (LAS unsigned*)(lds + (bufoff) + ldsw + _i * 8192), 16, 0, 0); } while (0)
#define PG8_LDA(dst, b, h) do { _Pragma("unroll") for (int m = 0; m < 4; ++m) _Pragma("unroll") for (int k = 0; k < 2; ++k) dst[m][k] = *(const LAS bf16x8*)(lds + PG8_SA(b, h) + aoff + m * 2048 + k * 1024); } while (0)
#define PG8_LDB(dst, b, h) do { _Pragma("unroll") for (int n = 0; n < 2; ++n) _Pragma("unroll") for (int k = 0; k < 2; ++k) dst[n][k] = *(const LAS bf16x8*)(lds + PG8_SB(b, h) + boff + n * 2048 + k * 1024); } while (0)
#define PG8_MMA(ai, bj, At, Bt) do { __builtin_amdgcn_s_setprio(1); _Pragma("unroll") for (int m = 0; m < 4; ++m) _Pragma("unroll") for (int n = 0; n < 2; ++n) _Pragma("unroll") for (int k = 0; k < 2; ++k) \
        acc[ai][bj][m][n] = mma1<I8>(Bt[n][k], At[m][k], acc[ai][bj][m][n]); __builtin_amdgcn_s_setprio(0); } while (0)
#define PG8_WAIT_V(n) asm volatile("s_waitcnt vmcnt(" #n ")" ::: "memory")
#define PG8_WAIT_L(n) asm volatile("s_waitcnt lgkmcnt(" #n ")" ::: "memory")
#define PG8_BAR __builtin_amdgcn_s_barrier()
#define PG8_SCHED __builtin_amdgcn_sched_barrier(0)
    Unit cur, nxt; int ui = 0;
    if (!S.next(0, cur)) return;
    f32x4 acc[2][2][4][2];
#pragma unroll
    for (int a = 0; a < 2; ++a)
#pragma unroll
        for (int b = 0; b < 2; ++b)
#pragma unroll
            for (int m = 0; m < 4; ++m)
#pragma unroll
                for (int n = 0; n < 2; ++n) acc[a][b][m][n] = (f32x4){0.f, 0.f, 0.f, 0.f};
    bf16x8 At[4][2], B0[2][2], B1[2][2];
    const char* cA = (const char*)g.A + (size_t)cur.pm * tstep; const char* cB = (const char*)g.Bt + (size_t)cur.pn * tstep;
    S.a_ready(cur);
    if constexpr (SP2) {
        PG8_STAGE(PG8_SB(0, 0), cB, voffB); PG8_STAGE(PG8_SB(0, 1), cB + hstep, voffB); PG8_STAGE(PG8_SA(0, 0), cA, voffA); PG8_STAGE(PG8_SA(0, 1), cA + hstep, voffA);
        if (wr == 1) PG8_BAR;
        PG8_WAIT_V(2); PG8_BAR;
        PG8_STAGE(PG8_SB(1, 0), cB + kstep, voffB); PG8_STAGE(PG8_SA(1, 0), cA + kstep, voffA); PG8_STAGE(PG8_SB(1, 1), cB + hstep + kstep, voffB);
        PG8_WAIT_V(6); PG8_BAR;
    } else {
        PG8_STAGE(PG8_SB(0, 0), cB, voffB); PG8_STAGE(PG8_SA(0, 0), cA, voffA); PG8_STAGE(PG8_SB(0, 1), cB + hstep, voffB); PG8_STAGE(PG8_SA(0, 1), cA + hstep, voffA);
        if (wr == 1) PG8_BAR;
        PG8_WAIT_V(4); PG8_BAR;
        PG8_STAGE(PG8_SB(1, 0), cB + kstep, voffB); PG8_STAGE(PG8_SA(1, 0), cA + kstep, voffA); PG8_STAGE(PG8_SB(1, 1), cB + hstep + kstep, voffB);
        PG8_WAIT_V(6); PG8_BAR;
    }
    for (;;) {
        const bool has_next = S.next(ui + 1, nxt);
        const char* nA = has_next ? (const char*)g.A + (size_t)nxt.pm * tstep : cA; const char* nB = has_next ? (const char*)g.Bt + (size_t)nxt.pn * tstep : cB;
        for (int t = 0; t < nt; t += 2) {
            const bool last = (t == nt - 2);
            const char* a1 = cA + (size_t)(t + 1) * kstep;
            const char* a2 = last ? nA : cA + (size_t)(t + 2) * kstep; const char* b2 = last ? nB : cB + (size_t)(t + 2) * kstep;
            const char* a3 = a2 + kstep; const char* b3 = b2 + kstep;
            if (last && has_next) S.a_ready(nxt);
            if constexpr (SP2) {
            PG8_LDB(B0, 0, 0); PG8_LDB(B1, 0, 1); PG8_SCHED; PG8_LDA(At, 0, 0); PG8_STAGE(PG8_SA(1, 1), a1 + hstep, voffA);
            PG8_WAIT_V(8); PG8_WAIT_L(0); PG8_BAR; PG8_MMA(0, 0, At, B0); PG8_MMA(0, 1, At, B1); PG8_BAR; PG8_SCHED;
            PG8_LDA(At, 0, 1); PG8_STAGE(PG8_SB(0, 0), b2, voffB); PG8_STAGE(PG8_SB(0, 1), b2 + hstep, voffB); PG8_STAGE(PG8_SA(0, 0), a2, voffA);
            PG8_WAIT_V(8); PG8_WAIT_L(0); PG8_BAR; PG8_MMA(1, 0, At, B0); PG8_MMA(1, 1, At, B1); PG8_BAR; PG8_SCHED;
            PG8_LDB(B0, 1, 0); PG8_LDB(B1, 1, 1); PG8_SCHED; PG8_LDA(At, 1, 0); PG8_STAGE(PG8_SA(0, 1), a2 + hstep, voffA);
            PG8_WAIT_V(8); PG8_WAIT_L(0); PG8_BAR; PG8_MMA(0, 0, At, B0); PG8_MMA(0, 1, At, B1); PG8_BAR; PG8_SCHED;
            PG8_LDA(At, 1, 1); PG8_STAGE(PG8_SB(1, 0), b3, voffB); PG8_STAGE(PG8_SB(1, 1), b3 + hstep, voffB); PG8_STAGE(PG8_SA(1, 0), a3, voffA);
            PG8_WAIT_V(8); PG8_WAIT_L(0); PG8_BAR; PG8_MMA(1, 0, At, B0); PG8_MMA(1, 1, At, B1); PG8_BAR; PG8_SCHED;
            } else {
            PG8_LDB(B0, 0, 0); PG8_SCHED; PG8_LDA(At, 0, 0); PG8_STAGE(PG8_SA(1, 1), a1 + hstep, voffA);
            PG8_WAIT_L(8); PG8_BAR; PG8_WAIT_L(0); PG8_MMA(0, 0, At, B0); PG8_BAR; PG8_SCHED;
            PG8_LDB(B1, 0, 1); PG8_STAGE(PG8_SB(0, 0), b2, voffB);
            PG8_BAR; PG8_WAIT_L(0); PG8_MMA(0, 1, At, B1); PG8_BAR;
            PG8_LDA(At, 0, 1); PG8_STAGE(PG8_SA(0, 0), a2, voffA);
            PG8_BAR; PG8_WAIT_L(0); PG8_MMA(1, 0, At, B0); PG8_BAR; PG8_SCHED;
            PG8_STAGE(PG8_SB(0, 1), b2 + hstep, voffB);
            PG8_WAIT_V(6); PG8_BAR; PG8_MMA(1, 1, At, B1); PG8_BAR;
            PG8_LDB(B0, 1, 0); PG8_SCHED; PG8_LDA(At, 1, 0); PG8_STAGE(PG8_SA(0, 1), a2 + hstep, voffA);
            PG8_WAIT_L(8); PG8_BAR; PG8_WAIT_L(0); PG8_MMA(0, 0, At, B0); PG8_BAR; PG8_SCHED;
            PG8_LDB(B1, 1, 1); PG8_STAGE(PG8_SB(1, 0), b3, voffB);
            PG8_BAR; PG8_WAIT_L(0); PG8_MMA(0, 1, At, B1); PG8_BAR;
            PG8_LDA(At, 1, 1); PG8_STAGE(PG8_SA(1, 0), a3, voffA);
            PG8_BAR; PG8_WAIT_L(0); PG8_MMA(1, 0, At, B0); PG8_BAR; PG8_SCHED;
            PG8_STAGE(PG8_SB(1, 1), b3 + hstep, voffB);
            PG8_WAIT_V(6); PG8_BAR; PG8_MMA(1, 1, At, B1); PG8_BAR;
            }
        }
        if constexpr (ALIGN_EPI) { if (wr == 0) PG8_BAR; }
        if constexpr (!Epi::AFTER_DRAIN) { E(acc, cur, wr, wc, fr, fq); S.done(cur); }
        if (!has_next) break;
#pragma unroll
        for (int a = 0; a < 2; ++a)
#pragma unroll
            for (int b = 0; b < 2; ++b)
#pragma unroll
                for (int m = 0; m < 4; ++m)
#pragma unroll
                    for (int n = 0; n < 2; ++n) acc[a][b][m][n] = (f32x4){0.f, 0.f, 0.f, 0.f};
        cur = nxt; cA = nA; cB = nB; ++ui;
        if constexpr (ALIGN_EPI) { if (wr == 1) PG8_BAR; }
    }
    PG8_WAIT_V(0);
    if constexpr (!ALIGN_EPI) { if (wr == 0) PG8_BAR; }
    PG8_BAR;
#undef PG8_SA
#undef PG8_SB
#undef PG8_STAGE
#undef PG8_LDA
#undef PG8_LDB
#undef PG8_MMA
#undef PG8_WAIT_V
#undef PG8_WAIT_L
#undef PG8_BAR
#undef PG8_SCHED
}
}

struct Args {
    const float* in[21];
    float* out; unsigned char* ws;
    int ph_lo, ph_hi;
};
enum { I_X = 0, I_N1W, I_WIN, I_LB, I_HGNW, I_QNW, I_KCNW, I_KSNW, I_KWNW, I_POSK, I_POSV, I_WCK1, I_WCK2, I_WCV1, I_WCV2, I_WOUT, I_N2W, I_WQ, I_SK, I_PU, I_PV };

constexpr float Q8_MAGIC = 12582912.f;
DI unsigned pack_q8(float t0, float t1, float t2, float t3) {
    const unsigned lo = __builtin_amdgcn_perm(__builtin_bit_cast(unsigned, t1), __builtin_bit_cast(unsigned, t0), 0x0c0c0400u);
    const unsigned hi = __builtin_amdgcn_perm(__builtin_bit_cast(unsigned, t3), __builtin_bit_cast(unsigned, t2), 0x04000c0cu);
    return lo | hi; }
DI void transpose_item(const float* W, int K, int N, int Npad, bf16_t* WT, LAS float* scr, int item, int lane, const float* kscale) {
    const int nblk = Npad / 32, kb = item / nblk, nb = item % nblk, k0 = 64 * kb, n0 = 32 * nb;
    const int n = n0 + 4 * (lane & 7);
    f32x4 v[8];
#pragma unroll
    for (int i = 0; i < 8; ++i) { const int kk = 8 * i + (lane >> 3); v[i] = (n < N) ? *(const f32x4*)(W + (size_t)(k0 + kk) * N + n) : (f32x4){0.f, 0.f, 0.f, 0.f}; }
#pragma unroll
    for (int i = 0; i < 8; ++i) { const int kk = 8 * i + (lane >> 3); f32x4 y = v[i]; if (kscale) y = y * kscale[k0 + kk];
        LAS float* d = scr + kk * 33 + 4 * (lane & 7); d[0] = y[0]; d[1] = y[1]; d[2] = y[2]; d[3] = y[3]; }
    LDS_WAIT(); asm volatile("" ::: "memory");
    const int c = lane & 7;
#pragma unroll
    for (int j = 0; j < 4; ++j) { const int nn = (lane >> 3) + 8 * j; const LAS float* s = scr + (8 * c) * 33 + nn;
        u32x4 o; o.x = pk2(s[0 * 33], s[1 * 33]); o.y = pk2(s[2 * 33], s[3 * 33]); o.z = pk2(s[4 * 33], s[5 * 33]); o.w = pk2(s[6 * 33], s[7 * 33]);
        *(u32x4*)(WT + (size_t)(n0 + nn) * K + k0 + 8 * c) = o; }
    LDS_WAIT(); asm volatile("" ::: "memory");
}

DI void coltile_q8_item(const float* W, int N, unsigned char* WT, float* wscale, LAS unsigned char* lds, int tile, int tid) {
    const int cq = tid & 3, rg = tid >> 2, n0 = 16 * tile + 4 * cq, wv = tid >> 6;
    f32x4 v[16];
#pragma unroll
    for (int i = 0; i < 16; ++i) v[i] = (n0 < N) ? *(const f32x4*)(W + (size_t)(16 * rg + i) * N + n0) : (f32x4){0.f, 0.f, 0.f, 0.f};
    f32x4 m = (f32x4){0.f, 0.f, 0.f, 0.f};
#pragma unroll
    for (int i = 0; i < 16; ++i) { m[0] = fmaxf(m[0], fabsf(v[i][0])); m[1] = fmaxf(m[1], fabsf(v[i][1])); m[2] = fmaxf(m[2], fabsf(v[i][2])); m[3] = fmaxf(m[3], fabsf(v[i][3])); }
#pragma unroll
    for (int o = 4; o < 64; o <<= 1) { m[0] = fmaxf(m[0], __shfl_xor(m[0], o)); m[1] = fmaxf(m[1], __shfl_xor(m[1], o)); m[2] = fmaxf(m[2], __shfl_xor(m[2], o)); m[3] = fmaxf(m[3], __shfl_xor(m[3], o)); }
    LAS f32x4* wm = (LAS f32x4*)(lds + 131072 + 1024);
    __syncthreads();
    if ((tid & 63) < 4) wm[wv * 4 + cq] = m;
    __syncthreads();
#pragma unroll
    for (int w = 0; w < 8; ++w) { const f32x4 t = wm[w * 4 + cq]; m[0] = fmaxf(m[0], t[0]); m[1] = fmaxf(m[1], t[1]); m[2] = fmaxf(m[2], t[2]); m[3] = fmaxf(m[3], t[3]); }
    if (rg == 0) *(f32x4*)(wscale + n0) = m * (1.f / 127.f);
#pragma unroll
    for (int c = 0; c < 4; ++c) { const float qs = m[c] > 0.f ? 127.f / m[c] : 0.f; u32x4 o;
#pragma unroll
        for (int q = 0; q < 4; ++q) o[q] = pack_q8(fmaf(v[4 * q][c], qs, Q8_MAGIC), fmaf(v[4 * q + 1][c], qs, Q8_MAGIC), fmaf(v[4 * q + 2][c], qs, Q8_MAGIC), fmaf(v[4 * q + 3][c], qs, Q8_MAGIC));
        *(u32x4*)(WT + (size_t)(n0 + c) * 2048 + 16 * rg) = o; }
}
DI void peer_conv_rows(const Args& a, int tsel, int rp0, int nrp, int lane) {
    const float* src = a.in[tsel ? I_PV : I_PU]; unsigned char* dst = a.ws + (tsel ? WS_VB : WS_UB); float* isc = (float*)(dst + TAB_SCALE_OFF);
    f32x4 v[2][8], nx[2][8];
#pragma unroll
    for (int rr = 0; rr < 2; ++rr)
#pragma unroll
        for (int q = 0; q < 8; ++q) nx[rr][q] = *(const f32x4*)(src + (size_t)(2 * rp0 + rr) * DM + 256 * q + 4 * lane);
#pragma unroll 1
    for (int k = 0; k < nrp; ++k) {
#pragma unroll
        for (int rr = 0; rr < 2; ++rr)
#pragma unroll
            for (int q = 0; q < 8; ++q) v[rr][q] = nx[rr][q];
        if (k + 1 < nrp) {
#pragma unroll
            for (int rr = 0; rr < 2; ++rr)
#pragma unroll
                for (int q = 0; q < 8; ++q) nx[rr][q] = *(const f32x4*)(src + (size_t)(2 * (rp0 + k + 1) + rr) * DM + 256 * q + 4 * lane);
        }
#pragma unroll
        for (int rr = 0; rr < 2; ++rr) { const int row = 2 * (rp0 + k) + rr; float mx = 0.f;
#pragma unroll
            for (int q = 0; q < 8; ++q) mx = fmaxf(mx, fmaxf(fmaxf(fabsf(v[rr][q][0]), fabsf(v[rr][q][1])), fmaxf(fabsf(v[rr][q][2]), fabsf(v[rr][q][3]))));
#pragma unroll
            for (int o = 1; o < 64; o <<= 1) mx = fmaxf(mx, __shfl_xor(mx, o));
            const float top = tsel ? 448.f : 127.f;
            const float sc = (mx > 0.f) ? top / mx : 1.f;
            if (lane == 0) isc[row] = (mx > 0.f) ? mx / top : 1.f;
#pragma unroll
            for (int q = 0; q < 8; ++q) { const f32x4 y = v[rr][q] * sc; int pk;
                if (tsel) { pk = __builtin_amdgcn_cvt_pk_fp8_f32(y[0], y[1], 0, false); pk = __builtin_amdgcn_cvt_pk_fp8_f32(y[2], y[3], pk, true); }
                else pk = (int)pack_q8(y[0] + Q8_MAGIC, y[1] + Q8_MAGIC, y[2] + Q8_MAGIC, y[3] + Q8_MAGIC);
                *(unsigned*)(dst + (size_t)(2 * q + (lane >> 5)) * (16384 * 128) + (size_t)row * 128 + 4 * (lane & 31)) = (unsigned)pk; } }
    }
}
DI void sk_conv_item(const Args& a, int it, int lane) {
    const float* sk = a.in[I_SK]; bf16_t* skb = (bf16_t*)(a.ws + SM_SK); const size_t e = (size_t)it * 512 + lane * 8;
    const f32x4 v0 = *(const f32x4*)(sk + e), v1 = *(const f32x4*)(sk + e + 4);
    u32x4 w; w.x = pk2(v0[0], v0[1]); w.y = pk2(v0[2], v0[3]); w.z = pk2(v1[0], v1[1]); w.w = pk2(v1[2], v1[3]);
    *(u32x4*)(skb + e) = w;
}
constexpr int FILL_RP = 4;
#ifndef FILL_SPLIT
#define FILL_SPLIT 0
#endif
constexpr int FILL_PU = 0, FILL_PV = 8192 / (8 * FILL_RP), FILL_WOUT = 2 * FILL_PV, FILL_WQ = FILL_WOUT + DM / 16, FILL_SK = FILL_WQ + DM / 16, FILL_END = FILL_SK + 64;
DI void filler_item(const Args& a, LAS unsigned char* lds, int fi, int lane, int wave) {
    LAS float* scr = (LAS float*)(lds + wave * 8704);
    if (fi < FILL_PV) peer_conv_rows(a, 0, (fi * 8 + wave) * FILL_RP, FILL_RP, lane);
    else if (fi < FILL_WOUT) peer_conv_rows(a, 1, ((fi - FILL_PV) * 8 + wave) * FILL_RP, FILL_RP, lane);
    else if (fi < FILL_WQ) coltile_q8_item(a.in[I_WOUT], DM, a.ws + WS_WOUT, (float*)(a.ws + SM_SWO), lds, fi - FILL_WOUT, wave * 64 + lane);
    else if (fi < FILL_SK) coltile_q8_item(a.in[I_WQ], DM, a.ws + WS_WQ, (float*)(a.ws + SM_SWQ), lds, fi - FILL_WQ, wave * 64 + lane);
    else sk_conv_item(a, (fi - FILL_SK) * 8 + wave, lane);
}
DI void phase_prep(const Args& a, LAS unsigned char* lds, int gw, int NGW, int lane, int wave) {
    unsigned char* ws = a.ws;
    LAS float* scr = (LAS float*)(lds + wave * 8704);
    constexpr int I_IN = (DM / 64) * (NP / 32), I_C1 = (2048 / 64) * (256 / 32), I_C2 = (256 / 64) * (64 / 32);
    constexpr int NITEMS = I_IN + 2 * I_C1 + 2 * I_C2;
    for (int it = gw + I_IN; it < NITEMS; it += NGW) {
        int r = it;
        if (r < I_IN) { continue; } r -= I_IN;
        if (r < I_C1) { transpose_item(a.in[I_WCK1], 2048, 256, 256, (bf16_t*)(ws + SM_W1K), scr, r, lane, nullptr); continue; } r -= I_C1;
        if (r < I_C1) { transpose_item(a.in[I_WCV1], 2048, 256, 256, (bf16_t*)(ws + SM_W1V), scr, r, lane, nullptr); continue; } r -= I_C1;
        if (r < I_C2) { transpose_item(a.in[I_WCK2], 256, 64, 64, (bf16_t*)(ws + SM_W2K), scr, r, lane, nullptr); continue; } r -= I_C2;
        transpose_item(a.in[I_WCV2], 256, 64, 64, (bf16_t*)(ws + SM_W2V), scr, r, lane, nullptr);
    }
    {
        const float* x = a.in[I_X]; const float* w1 = a.in[I_N1W]; unsigned char* XN = ws + WS_XN; float* sxa = (float*)(ws + WS_XN + 32 * MiB);
        f32x4 wv[8];
#pragma unroll
        for (int j = 0; j < 8; ++j) wv[j] = *(const f32x4*)(w1 + 4 * lane + 256 * j);
        for (int m2 = gw; m2 < M / 2; m2 += NGW) {
            f32x4 v[2][8];
#pragma unroll
            for (int rr = 0; rr < 2; ++rr)
#pragma unroll
                for (int j = 0; j < 8; ++j) v[rr][j] = ((const f32x4*)(x + (size_t)(2 * m2 + rr) * DM) + lane)[64 * j];
#pragma unroll
            for (int rr = 0; rr < 2; ++rr) { float s = 0.f;
#pragma unroll
                for (int j = 0; j < 8; ++j) s += (v[rr][j][0] * v[rr][j][0] + v[rr][j][1] * v[rr][j][1]) + (v[rr][j][2] * v[rr][j][2] + v[rr][j][3] * v[rr][j][3]);
                const float rstd = __builtin_amdgcn_rsqf(wave_sum(s) * (1.f / DM) + EPS);
                f32x4 y[8]; float am = 0.f;
#pragma unroll
                for (int j = 0; j < 8; ++j) { y[j] = v[rr][j] * rstd * wv[j]; am = fmaxf(am, fmaxf(fmaxf(fabsf(y[j][0]), fabsf(y[j][1])), fmaxf(fabsf(y[j][2]), fabsf(y[j][3])))); }
#pragma unroll
                for (int o = 1; o < 64; o <<= 1) am = fmaxf(am, __shfl_xor(am, o));
                const float qs = am > 0.f ? 127.f / am : 0.f;
                if (lane == 0) sxa[2 * m2 + rr] = am * (1.f / 127.f);
                unsigned* o4 = (unsigned*)(XN + (size_t)(2 * m2 + rr) * DM) + lane;
#pragma unroll
                for (int j = 0; j < 8; ++j) o4[64 * j] = pack_q8(fmaf(y[j][0], qs, Q8_MAGIC), fmaf(y[j][1], qs, Q8_MAGIC), fmaf(y[j][2], qs, Q8_MAGIC), fmaf(y[j][3], qs, Q8_MAGIC)); }
        }
    }
    {
        const int tid = threadIdx.x, blk = blockIdx.x;
        if (blk == 0) { for (int c = tid; c < 1024; c += NTHREADS) { const float l0 = a.in[I_LB][c], l1 = a.in[I_LB][1024 + c]; ((float*)(ws + SM_LB))[c] = 1.f / (1.f + __expf(l1 - l0)); } }
        if (blk >= 1 && blk <= 32) { const int part = blk - 1, mat = tid >> 8, j = tid & 255;
            const float* w1 = a.in[mat ? I_WCV1 : I_WCK1]; const float* pos = a.in[mat ? I_POSV : I_POSK]; float acc = 0.f;
            for (int i = part * 64; i < part * 64 + 64; ++i) acc += pos[i] * w1[(size_t)i * 256 + j];
            ((float*)(ws + SM_BIASP))[part * 512 + tid] = acc; }
    }
}

DI void rowquant_mix(const Args& a, int gw, int NGW, int lane) {
    const bf16_t* MIX = (const bf16_t*)(a.ws + WS_XN); unsigned char* A8 = a.ws + WS_MIX8; float* rs = (float*)(a.ws + WS_MIX8 + 32 * MiB);
    for (int row = gw; row < M; row += NGW) {
        u32x4 v[4]; float am = 0.f;
#pragma unroll
        for (int j = 0; j < 4; ++j) v[j] = ((const u32x4*)(MIX + (size_t)row * DM) + lane)[64 * j];
#pragma unroll
        for (int j = 0; j < 4; ++j)
#pragma unroll
            for (int i = 0; i < 4; ++i) am = fmaxf(am, fmaxf(fabsf(bflo(v[j][i])), fabsf(bfhi(v[j][i]))));
#pragma unroll
        for (int o = 1; o < 64; o <<= 1) am = fmaxf(am, __shfl_xor(am, o));
        const float qs = am > 0.f ? 127.f / am : 0.f;
        if (lane == 0) rs[row] = am * (1.f / 127.f);
        u32x2* o2 = (u32x2*)(A8 + (size_t)row * DM) + lane;
#pragma unroll
        for (int j = 0; j < 4; ++j) { u32x2 w;
            w.x = pack_q8(fmaf(bflo(v[j][0]), qs, Q8_MAGIC), fmaf(bfhi(v[j][0]), qs, Q8_MAGIC), fmaf(bflo(v[j][1]), qs, Q8_MAGIC), fmaf(bfhi(v[j][1]), qs, Q8_MAGIC));
            w.y = pack_q8(fmaf(bflo(v[j][2]), qs, Q8_MAGIC), fmaf(bfhi(v[j][2]), qs, Q8_MAGIC), fmaf(bflo(v[j][3]), qs, Q8_MAGIC), fmaf(bfhi(v[j][3]), qs, Q8_MAGIC));
            o2[64 * j] = w; }
    }
}
DI void rowquant_h(const Args& a, int gw, int NGW, int lane) {
    const float* w2 = a.in[I_N2W]; unsigned char* A8 = a.ws + WS_HQ8; float* rs = (float*)(a.ws + WS_DQ);
    f32x4 wv[8];
#pragma unroll
    for (int j = 0; j < 8; ++j) wv[j] = *(const f32x4*)(w2 + 4 * lane + 256 * j);
    for (int row = gw; row < M; row += NGW) {
        f32x4 v[8]; float s = 0.f, am = 0.f;
#pragma unroll
        for (int j = 0; j < 8; ++j) v[j] = ((const f32x4*)(a.out + (size_t)row * DM) + lane)[64 * j];
#pragma unroll
        for (int j = 0; j < 8; ++j) { s += (v[j][0] * v[j][0] + v[j][1] * v[j][1]) + (v[j][2] * v[j][2] + v[j][3] * v[j][3]); v[j] = v[j] * wv[j];
            am = fmaxf(am, fmaxf(fmaxf(fabsf(v[j][0]), fabsf(v[j][1])), fmaxf(fabsf(v[j][2]), fabsf(v[j][3])))); }
        s = wave_sum(s);
#pragma unroll
        for (int o = 1; o < 64; o <<= 1) am = fmaxf(am, __shfl_xor(am, o));
        const float qs = am > 0.f ? 127.f / am : 0.f;
        if (lane == 0) rs[row] = am * (1.f / 127.f) * __builtin_amdgcn_rsqf(s * (1.f / DM) + EPS);
        unsigned* o4 = (unsigned*)(A8 + (size_t)row * DM) + lane;
#pragma unroll
        for (int j = 0; j < 8; ++j) o4[64 * j] = pack_q8(fmaf(v[j][0], qs, Q8_MAGIC), fmaf(v[j][1], qs, Q8_MAGIC), fmaf(v[j][2], qs, Q8_MAGIC), fmaf(v[j][3], qs, Q8_MAGIC));
    }
}
DI int perm16(int t) { return (t & ~12) | ((t & 4) << 1) | ((t & 8) >> 1); }

DI void nsa_norm_row(const Args& a, int row, int lane) {
    bf16_t* pr = (bf16_t*)(a.ws + WS_P) + (size_t)row * NP;
    const int c8 = lane & 7;
    const f32x4 qw0 = *(const f32x4*)(a.in[I_QNW] + 8 * c8), qw1 = *(const f32x4*)(a.in[I_QNW] + 8 * c8 + 4);
    const float* kwp = a.in[lane < 32 ? I_KSNW : I_KWNW];
    const f32x4 kw0 = *(const f32x4*)(kwp + 8 * c8), kw1 = *(const f32x4*)(kwp + 8 * c8 + 4);
    bf16_t* p0 = pr + C_NQ + 8 * lane; bf16_t* p1 = pr + C_NQ + 512 + 8 * lane; bf16_t* p2 = pr + (lane < 32 ? C_NKS + 8 * lane : C_NKW + 8 * (lane - 32));
    const u32x4 v0 = *(const u32x4*)p0, v1 = *(const u32x4*)p1, v2 = *(const u32x4*)p2;
    auto nrm = [&](const u32x4 v, const f32x4 w0, const f32x4 w1, float extra) -> u32x4 {
        float f[8] = {bflo(v.x), bfhi(v.x), bflo(v.y), bfhi(v.y), bflo(v.z), bfhi(v.z), bflo(v.w), bfhi(v.w)};
        float s = 0.f;
#pragma unroll
        for (int i = 0; i < 8; ++i) s += f[i] * f[i];
        s += __shfl_xor(s, 1); s += __shfl_xor(s, 2); s += __shfl_xor(s, 4);
        const float r = __builtin_amdgcn_rsqf(s * (1.f / 64.f) + EPS) * extra;
        u32x4 o; o.x = pk2(f[0] * r * w0[0], f[1] * r * w0[1]); o.y = pk2(f[2] * r * w0[2], f[3] * r * w0[3]);
        o.z = pk2(f[4] * r * w1[0], f[5] * r * w1[1]); o.w = pk2(f[6] * r * w1[2], f[7] * r * w1[3]); return o; };
    *(u32x4*)p0 = nrm(v0, qw0, qw1, 0.125f * LOG2E);
    *(u32x4*)p1 = nrm(v1, qw0, qw1, 0.125f * LOG2E);
    *(u32x4*)p2 = nrm(v2, kw0, kw1, 1.f);
}

DI void vtrans_item(const Args& a, LAS unsigned char* scr, int item, int lane) {
    const int which = item >> 10, b = (item >> 7) & 7, g = (item >> 5) & 3, tt = item & 31;
    const bf16_t* src = (const bf16_t*)(a.ws + WS_P) + (size_t)(b * SEQ + 64 * tt + lane) * NP + (which ? C_NVW : C_NVS) + g * 64;
    u32x4 v[8];
#pragma unroll
    for (int j = 0; j < 8; ++j) v[j] = *(const u32x4*)(src + 8 * j);
    const int tp = perm16(lane);
#pragma unroll
    for (int j = 0; j < 8; ++j) {
        const unsigned w[4] = {v[j].x, v[j].y, v[j].z, v[j].w};
#pragma unroll
        for (int i = 0; i < 4; ++i) {
            *(LAS bf16_t*)(scr + (8 * j + 2 * i) * 144 + 2 * tp) = (bf16_t)(w[i] & 0xffffu);
            *(LAS bf16_t*)(scr + (8 * j + 2 * i + 1) * 144 + 2 * tp) = (bf16_t)(w[i] >> 16);
        }
    }
    LDS_WAIT(); asm volatile("" ::: "memory");
    bf16_t* dst = (bf16_t*)(a.ws + WS_VT) + (size_t)which * (32 * 64 * SEQ) + (size_t)((b * 4 + g) * 64 + lane) * SEQ + 64 * tt;
#pragma unroll
    for (int j = 0; j < 8; ++j) *(u32x4*)(dst + 8 * j) = *(const LAS u32x4*)(scr + lane * 144 + 16 * j);
    LDS_WAIT(); asm volatile("" ::: "memory");
}

DI void compress_item(const Args& a, LAS unsigned char* lds, int item, int tid, int lane, int wave) {
    const int kv = item >> 7, b = (item >> 4) & 7, g = (item >> 2) & 3, n0 = 32 * (item & 3);
    const int hi = lane >> 5, r32 = lane & 31;
    const bf16_t* P = (const bf16_t*)(a.ws + WS_P);
    const bf16_t* w1T = (const bf16_t*)(a.ws + (kv ? SM_W1V : SM_W1K));
    const bf16_t* w2T = (const bf16_t*)(a.ws + (kv ? SM_W2V : SM_W2K));
    int nabs = n0 + r32; if (nabs > 126) nabs = 126;
    const bf16_t* ap = P + (size_t)(b * SEQ + 16 * nabs) * NP + (kv ? C_NVC : C_NKC) + g * 64 + 8 * hi;
    const bf16_t* bp = w1T + (size_t)(32 * wave + r32) * 2048 + 8 * hi;
    f32x16 acc;
#pragma unroll
    for (int i = 0; i < 16; ++i) acc[i] = 0.f;
#pragma unroll 2
    for (int l = 0; l < 32; ++l) {
#pragma unroll
        for (int kk = 0; kk < 4; ++kk) {
            const bf16x8 av = *(const bf16x8*)(ap + (size_t)l * NP + 16 * kk);
            const bf16x8 bv = *(const bf16x8*)(bp + l * 64 + 16 * kk);
            acc = MFMA32(av, bv, acc);
        }
    }
    float bias = 0.f; { const float* bpart = (const float*)(a.ws + SM_BIASP) + kv * 256 + 32 * wave + r32;
#pragma unroll 8
        for (int p = 0; p < 32; ++p) bias += bpart[p * 512]; }
#pragma unroll
    for (int r = 0; r < 16; ++r) { const int n = crow(r, hi); *(LAS bf16_t*)(lds + (n * 264 + 32 * wave + r32) * 2) = f2bf(gelu_tanh(acc[r] + bias)); }
    __syncthreads();
    if (wave == 0) {
        f32x16 c[2];
#pragma unroll
        for (int db = 0; db < 2; ++db) {
#pragma unroll
            for (int i = 0; i < 16; ++i) c[db][i] = 0.f;
#pragma unroll
            for (int ks = 0; ks < 16; ++ks) {
                const bf16x8 av = *(const bf16x8*)(w2T + (size_t)(32 * db + r32) * 256 + 16 * ks + 8 * hi);
                const bf16x8 bv = *(const LAS bf16x8*)(lds + (r32 * 264 + 16 * ks + 8 * hi) * 2);
                c[db] = MFMA32(av, bv, c[db]);
            }
        }
        const int bg = b * 4 + g;
        if (kv == 0) {
            float ss = 0.f;
#pragma unroll
            for (int db = 0; db < 2; ++db)
#pragma unroll
                for (int r = 0; r < 16; ++r) ss += c[db][r] * c[db][r];
            ss += __shfl_xor(ss, 32);
            const float rstd = __builtin_amdgcn_rsqf(ss * (1.f / 64.f) + EPS);
            bf16_t* kc = (bf16_t*)(a.ws + SM_KC) + (size_t)(bg * 128 + n0 + r32) * 64;
#pragma unroll
            for (int db = 0; db < 2; ++db)
#pragma unroll
                for (int c4 = 0; c4 < 4; ++c4) { const int d0 = 32 * db + 8 * c4 + 4 * hi; const f32x4 w = *(const f32x4*)(a.in[I_KCNW] + d0);
                    u32x2 o; o.x = pk2(c[db][4 * c4] * rstd * w[0], c[db][4 * c4 + 1] * rstd * w[1]); o.y = pk2(c[db][4 * c4 + 2] * rstd * w[2], c[db][4 * c4 + 3] * rstd * w[3]);
                    *(u32x2*)(kc + d0) = o; }
        } else {
            bf16_t* vct = (bf16_t*)(a.ws + SM_VCT) + (size_t)bg * 64 * 128 + perm16(n0 + r32);
#pragma unroll
            for (int db = 0; db < 2; ++db)
#pragma unroll
                for (int r = 0; r < 16; ++r) vct[(size_t)(32 * db + crow(r, hi)) * 128] = f2bf(c[db][r]);
        }
    }
    __syncthreads();
}

template <int CTRL> DI float dpp_f(float v) { return __builtin_bit_cast(float, __builtin_amdgcn_update_dpp(0, __builtin_bit_cast(int, v), CTRL, 0xf, 0xf, true)); }
template <int CTRL> DI int dpp_i(int v) { return __builtin_amdgcn_update_dpp(0, v, CTRL, 0xf, 0xf, true); }
constexpr int HL_QD = 0, HL_KD = 17408, HL_KET = 34816, HL_IT = 53248, HL_AT = 71680, HL_DEC = 80896, HL_SEG = 81408, HL_SSQ = 85504, HL_G = 87552;
static_assert(HL_G + 2 * 64 * 272 <= LDS_BYTES - 64, "hgrn LDS");
struct HgRaw { unsigned f[8], q[8], i[8]; u32x4 g[2]; };
DI void hgrn_item(const Args& a, LAS unsigned char* lds, int item, int tid, int lane, int wave) {
    const int b = item >> 3, h = item & 7;
    const bf16_t* P = (const bf16_t*)(a.ws + WS_P);
    bf16_t* MIX = (bf16_t*)(a.ws + WS_XN);
    const int c2 = tid & 63, sg = tid >> 6, l15 = lane & 15, q4 = lane >> 4;
    const f32x2 lb2 = *(const f32x2*)((const float*)(a.ws + SM_LB) + h * 128 + 2 * c2);
    const float gnw = a.in[I_HGNW][16 * wave + l15];
    const __amdgpu_buffer_rsrc_t prs = __builtin_amdgcn_make_buffer_rsrc((void*)P, 0, (int)((size_t)M * NP * 2), 0x00020000);
    const int voffA = ((8 * sg) * NP + h * 128 + 2 * c2) * 2;
    const int grow = tid >> 3, gch = tid & 7;
    const int voffG = (grow * NP + C_HG + h * 128 + 16 * gch) * 2;
    auto load_raw = [&](HgRaw& R, int n) { const int soff0 = (b * SEQ + 64 * n) * NP * 2;
#pragma unroll
        for (int tt = 0; tt < 8; ++tt) { R.f[tt] = __builtin_amdgcn_raw_buffer_load_b32(prs, voffA, soff0 + tt * NP * 2 + C_HF * 2, 0);
            R.q[tt] = __builtin_amdgcn_raw_buffer_load_b32(prs, voffA, soff0 + tt * NP * 2 + C_HQ * 2, 0);
            R.i[tt] = __builtin_amdgcn_raw_buffer_load_b32(prs, voffA, soff0 + tt * NP * 2 + C_HI * 2, 0); }
        R.g[0] = __builtin_bit_cast(u32x4, __builtin_amdgcn_raw_buffer_load_b128(prs, voffG, soff0, 0)); R.g[1] = __builtin_bit_cast(u32x4, __builtin_amdgcn_raw_buffer_load_b128(prs, voffG + 16, soff0, 0)); };
    f32x4 S[8];
#pragma unroll
    for (int i = 0; i < 8; ++i) S[i] = (f32x4){0.f, 0.f, 0.f, 0.f};
    HgRaw R; load_raw(R, 0);
    for (int n = 0; n < 32; ++n) {
        const int rowbase = b * SEQ + 64 * n;
        float cum[2][8], kk[2][8], qq[2][8]; unsigned iv[8]; float run0 = 1.f, run1 = 1.f;
#pragma unroll
        for (int tt = 0; tt < 8; ++tt) {
            kk[0][tt] = bflo(R.f[tt]); kk[1][tt] = bfhi(R.f[tt]);
            run0 *= 1.f - kk[0][tt]; run1 *= 1.f - kk[1][tt]; cum[0][tt] = run0; cum[1][tt] = run1;
            qq[0][tt] = bflo(R.q[tt]); qq[1][tt] = bfhi(R.q[tt]); iv[tt] = R.i[tt];
        }
        *(LAS u32x4*)(lds + HL_G + (n & 1) * 17408 + grow * 272 + gch * 32) = R.g[0]; *(LAS u32x4*)(lds + HL_G + (n & 1) * 17408 + grow * 272 + gch * 32 + 16) = R.g[1];
        *(LAS f32x2*)(lds + HL_SEG + (sg * 128 + 2 * c2) * 4) = (f32x2){run0, run1};
        if (n + 1 < 32) load_raw(R, n + 1);
        __syncthreads();
        float off0 = 1.f, off1 = 1.f, bend0 = 1.f, bend1 = 1.f;
#pragma unroll
        for (int s2 = 0; s2 < 8; ++s2) { const f32x2 v = *(const LAS f32x2*)(lds + HL_SEG + (s2 * 128 + 2 * c2) * 4); bend0 *= v[0]; bend1 *= v[1]; if (s2 < sg) { off0 *= v[0]; off1 *= v[1]; } }
        unsigned ke0[4], ke1[4];
#pragma unroll
        for (int tt = 0; tt < 8; ++tt) {
            const float eb0 = off0 * cum[0][tt], eb1 = off1 * cum[1][tt]; const int t = 8 * sg + tt;
            const float kd0 = kk[0][tt] * fast_rcp(eb0), kd1 = kk[1][tt] * fast_rcp(eb1);
            *(LAS unsigned*)(lds + HL_QD + (t * 136 + 2 * c2) * 2) = pk2(qq[0][tt] * eb0, qq[1][tt] * eb1);
            *(LAS unsigned*)(lds + HL_KD + (t * 136 + 2 * c2) * 2) = pk2(kd0, kd1);
            const unsigned e0 = pk2(kd0 * bend0, 0.f) & 0xffffu, e1 = pk2(kd1 * bend1, 0.f) & 0xffffu;
            if (tt & 1) { ke0[tt >> 1] |= e0 << 16; ke1[tt >> 1] |= e1 << 16; } else { ke0[tt >> 1] = e0; ke1[tt >> 1] = e1; }
        }
        *(LAS u32x4*)(lds + HL_KET + ((2 * c2) * 72 + 8 * sg) * 2) = (u32x4){ke0[0], ke0[1], ke0[2], ke0[3]};
        *(LAS u32x4*)(lds + HL_KET + ((2 * c2 + 1) * 72 + 8 * sg) * 2) = (u32x4){ke1[0], ke1[1], ke1[2], ke1[3]};
        { u32x4 i0, i1;
#pragma unroll
          for (int k = 0; k < 4; ++k) { i0[k] = (iv[2 * k] & 0xffffu) | (iv[2 * k + 1] << 16); i1[k] = (iv[2 * k] >> 16) | (iv[2 * k + 1] & 0xffff0000u); }
          *(LAS u32x4*)(lds + HL_IT + ((2 * c2) * 72 + 8 * sg) * 2) = i0; *(LAS u32x4*)(lds + HL_IT + ((2 * c2 + 1) * 72 + 8 * sg) * 2) = i1; }
        if (sg == 0) *(LAS f32x2*)(lds + HL_DEC + 2 * c2 * 4) = (f32x2){bend0, bend1};
        __syncthreads();
#pragma unroll
        for (int u = 0; u < 2; ++u) {
            const int tile = 2 * wave + u, tb = tile >> 2, sb = tile & 3;
            f32x4 acc = (f32x4){0.f, 0.f, 0.f, 0.f};
            if (sb <= tb) {
#pragma unroll
                for (int ks = 0; ks < 4; ++ks) {
                    const bf16x8 av = *(const LAS bf16x8*)(lds + HL_QD + ((16 * tb + l15) * 136 + 32 * ks + 8 * q4) * 2);
                    const bf16x8 bv = *(const LAS bf16x8*)(lds + HL_KD + ((16 * sb + l15) * 136 + 32 * ks + 8 * q4) * 2);
                    acc = MFMA16(av, bv, acc);
                }
            }
#pragma unroll
            for (int r = 0; r < 4; ++r) { const int t = 16 * tb + 4 * q4 + r, s2 = 16 * sb + l15;
                *(LAS bf16_t*)(lds + HL_AT + (t * 72 + s2) * 2) = f2bf(s2 <= t ? acc[r] : 0.f); }
        }
        __syncthreads();
        f32x4 o[4];
        bf16x8 sfrag[4];
#pragma unroll
        for (int ks = 0; ks < 4; ++ks) { u32x4 w; w.x = pk2(S[2 * ks][0], S[2 * ks][1]); w.y = pk2(S[2 * ks][2], S[2 * ks][3]); w.z = pk2(S[2 * ks + 1][0], S[2 * ks + 1][1]); w.w = pk2(S[2 * ks + 1][2], S[2 * ks + 1][3]);
            sfrag[ks] = __builtin_bit_cast(bf16x8, w); }
        bf16x8 itf[2];
#pragma unroll
        for (int ks = 0; ks < 2; ++ks) itf[ks] = *(const LAS bf16x8*)(lds + HL_IT + ((16 * wave + l15) * 72 + 32 * ks + 8 * q4) * 2);
#pragma unroll
        for (int tb = 0; tb < 4; ++tb) {
            o[tb] = (f32x4){0.f, 0.f, 0.f, 0.f};
#pragma unroll
            for (int ks = 0; ks < 2; ++ks) {
                const bf16x8 av = *(const LAS bf16x8*)(lds + HL_AT + ((16 * tb + l15) * 72 + 32 * ks + 8 * q4) * 2);
                o[tb] = MFMA16(av, itf[ks], o[tb]);
            }
#pragma unroll
            for (int ks = 0; ks < 4; ++ks) {
                const u32x2 lo = *(const LAS u32x2*)(lds + HL_QD + ((16 * tb + l15) * 136 + 32 * ks + 4 * q4) * 2);
                const u32x2 hi2 = *(const LAS u32x2*)(lds + HL_QD + ((16 * tb + l15) * 136 + 32 * ks + 16 + 4 * q4) * 2);
                const bf16x8 av = __builtin_bit_cast(bf16x8, (u32x4){lo.x, lo.y, hi2.x, hi2.y});
                o[tb] = MFMA16(av, sfrag[ks], o[tb]);
            }
        }
#pragma unroll
        for (int cb = 0; cb < 8; ++cb) {
            const f32x4 d4 = *(const LAS f32x4*)(lds + HL_DEC + (16 * cb + 4 * q4) * 4);
            S[cb] = S[cb] * d4;
#pragma unroll
            for (int ks = 0; ks < 2; ++ks) {
                const bf16x8 av = *(const LAS bf16x8*)(lds + HL_KET + ((16 * cb + l15) * 72 + 32 * ks + 8 * q4) * 2);
                S[cb] = MFMA16(av, itf[ks], S[cb]);
            }
        }
#pragma unroll
        for (int tb = 0; tb < 4; ++tb)
#pragma unroll
            for (int r = 0; r < 4; ++r) { float v = o[tb][r] * o[tb][r];
                v += dpp_f<0xB1>(v); v += dpp_f<0x4E>(v); v += dpp_f<0x141>(v); v += dpp_f<0x140>(v);
                if (l15 == 0) *(LAS float*)(lds + HL_SSQ + (wave * 64 + 16 * tb + 4 * q4 + r) * 4) = v; }
        __syncthreads();
        float rs_mine; { const int tm = 16 * (l15 >> 2) + 4 * q4 + (l15 & 3); float tot = 0.f;
#pragma unroll
            for (int w = 0; w < 8; ++w) tot += *(const LAS float*)(lds + HL_SSQ + (w * 64 + tm) * 4);
            rs_mine = __builtin_amdgcn_rsqf(tot * (1.f / 128.f) + EPS); }
#pragma unroll
        for (int tb = 0; tb < 4; ++tb)
#pragma unroll
            for (int r = 0; r < 4; ++r) { const int t = 16 * tb + 4 * q4 + r;
                const float rstd = __shfl(rs_mine, (lane & 48) + 4 * tb + r);
                const float g = bf2f(*(const LAS bf16_t*)(lds + HL_G + (n & 1) * 17408 + t * 272 + (16 * wave + l15) * 2));
                MIX[(size_t)(rowbase + t) * DM + h * 128 + 16 * wave + l15] = f2bf(o[tb][r] * rstd * gnw * (g * sigmoidf_(g))); }
    }
}

constexpr int AL_K = 0, AL_V = 18432, AL_IMP = 36864, AL_SELM = 70656, AL_STASH = 71680;
static_assert(AL_STASH + 8 * 8192 <= LDS_BYTES - 64, "attention LDS");
constexpr float NEGBIG = -1e30f;
DI bf16x8 pack8(const f32x16& p, int s) {
    u32x4 w; w.x = pk2(p[8 * s], p[8 * s + 1]); w.y = pk2(p[8 * s + 2], p[8 * s + 3]); w.z = pk2(p[8 * s + 4], p[8 * s + 5]); w.w = pk2(p[8 * s + 6], p[8 * s + 7]);
    return __builtin_bit_cast(bf16x8, w);
}
DI void attn_scores(LAS unsigned char* lds, int buf, const bf16x8 (&qf)[4], f32x16& p0, f32x16& p1, int q32, int hi) {
    const LAS unsigned char* kb = lds + AL_K + buf * 9216 + q32 * 144 + hi * 16;
#pragma unroll
    for (int i = 0; i < 16; ++i) { p0[i] = 0.f; p1[i] = 0.f; }
#pragma unroll
    for (int kk = 0; kk < 4; ++kk) {
        const bf16x8 a0 = *(const LAS bf16x8*)(kb + kk * 32), a1 = *(const LAS bf16x8*)(kb + 32 * 144 + kk * 32);
        p0 = MFMA32(a0, qf[kk], p0); p1 = MFMA32(a1, qf[kk], p1);
    }
}
DI void attn_pv(LAS unsigned char* lds, int buf, const f32x16& p0, const f32x16& p1, f32x16 (&o)[2], int q32, int hi) {
    const LAS unsigned char* vb = lds + AL_V + buf * 9216 + q32 * 144 + hi * 16;
    const bf16x8 pb0 = pack8(p0, 0), pb1 = pack8(p0, 1), pb2 = pack8(p1, 0), pb3 = pack8(p1, 1);
#pragma unroll
    for (int db = 0; db < 2; ++db) {
        const LAS unsigned char* v2 = vb + db * 32 * 144;
        o[db] = MFMA32(*(const LAS bf16x8*)(v2), pb0, o[db]);
        o[db] = MFMA32(*(const LAS bf16x8*)(v2 + 32), pb1, o[db]);
        o[db] = MFMA32(*(const LAS bf16x8*)(v2 + 64), pb2, o[db]);
        o[db] = MFMA32(*(const LAS bf16x8*)(v2 + 96), pb3, o[db]);
    }
}
DI void attn_scores_biased(LAS unsigned char* lds, int buf, const bf16x8 (&qf)[4], const f32x16& a0, const f32x16& a1, f32x16& p0, f32x16& p1, int q32, int hi) {
    const LAS unsigned char* kb = lds + AL_K + buf * 9216 + q32 * 144 + hi * 16;
    p0 = MFMA32(*(const LAS bf16x8*)(kb), qf[0], a0); p1 = MFMA32(*(const LAS bf16x8*)(kb + 32 * 144), qf[0], a1);
#pragma unroll
    for (int kk = 1; kk < 4; ++kk) {
        p0 = MFMA32(*(const LAS bf16x8*)(kb + kk * 32), qf[kk], p0); p1 = MFMA32(*(const LAS bf16x8*)(kb + 32 * 144 + kk * 32), qf[kk], p1);
    }
}
template <int MODE>
DI void attn_stream(LAS unsigned char* lds, const bf16_t* kbase, const bf16_t* vbase, unsigned tmask, unsigned fullmask, unsigned mymask, int cur, int tq, float slope2, float gate,
                    const bf16x8 (&qf)[4], const f32x16& a0, const f32x16& a1, f32x16 (&o)[2], int tid, int q32, int hi) {
    const int srow = tid >> 3, sch = tid & 7;
    float m = NEGBIG, lsum = 0.f;
#pragma unroll
    for (int i = 0; i < 16; ++i) { o[0][i] = 0.f; o[1][i] = 0.f; }
    auto next_tile = [&]() -> int { if (!tmask) return -1; const int t = 31 - __clz(tmask); tmask &= ~(1u << t); return t; };
    int j = next_tile();
    u32x4 kA = *(const u32x4*)(kbase + (size_t)(64 * j + srow) * NP + 8 * sch), vA = *(const u32x4*)(vbase + (size_t)srow * SEQ + 64 * j + 8 * sch);
    u32x4 kB = kA, vB = vA;
    int jn = next_tile();
    if (jn >= 0) { kB = *(const u32x4*)(kbase + (size_t)(64 * jn + srow) * NP + 8 * sch); vB = *(const u32x4*)(vbase + (size_t)srow * SEQ + 64 * jn + 8 * sch); }
    __syncthreads();
    *(LAS u32x4*)(lds + AL_K + srow * 144 + sch * 16) = kA; *(LAS u32x4*)(lds + AL_V + srow * 144 + sch * 16) = vA;
    __syncthreads();
    auto step = [&](u32x4& kL, u32x4& vL, const u32x4& kS, const u32x4& vS, const int bufc) -> bool {
        const int jnn = (jn >= 0) ? next_tile() : -1;
        if (jnn >= 0) { kL = *(const u32x4*)(kbase + (size_t)(64 * jnn + srow) * NP + 8 * sch); vL = *(const u32x4*)(vbase + (size_t)srow * SEQ + 64 * jnn + 8 * sch); }
        f32x16 p0, p1;
        attn_scores_biased(lds, bufc, qf, a0, a1, p0, p1, q32, hi);
        const float Bj = -slope2 * (float)(64 * (cur - j));
        if (!((fullmask >> j) & 1u)) {
            const bool selv = (MODE == 0) ? (((mymask >> j) & 1u) != 0u) : true;
            float basef = (float)(tq - 64 * j - 4 * hi); asm volatile("" : "+v"(basef));
#pragma unroll
            for (int r = 0; r < 16; ++r) {
                const float d0 = basef - (float)((r & 3) + 8 * (r >> 2)), d1 = d0 - 32.f;
                const bool v0 = (MODE == 0) ? (selv && d0 >= 0.f) : (d0 >= 0.f && d0 < 512.f);
                const bool v1 = (MODE == 0) ? (selv && d1 >= 0.f) : (d1 >= 0.f && d1 < 512.f);
                p0[r] = v0 ? p0[r] : NEGBIG; p1[r] = v1 ? p1[r] : NEGBIG;
            }
        }
        float mx = fmaxf(p0[0], p1[0]);
#pragma unroll
        for (int r = 1; r < 16; ++r) mx = fmaxf(mx, fmaxf(p0[r], p1[r]));
        mx = fmaxf(mx, __shfl_xor(mx, 32));
        const float mcand = mx + Bj;
        if (__any(mcand > m)) {
            const float mnew = fmaxf(m, mcand), alpha = fast_exp2(m - mnew); m = mnew; lsum *= alpha;
#pragma unroll
            for (int i = 0; i < 16; ++i) { o[0][i] *= alpha; o[1][i] *= alpha; }
        }
        const float madj = m - Bj;
        float ps = 0.f;
#pragma unroll
        for (int r = 0; r < 16; ++r) { p0[r] = fast_exp2(p0[r] - madj); p1[r] = fast_exp2(p1[r] - madj); ps += p0[r] + p1[r]; }
        lsum += ps;
        attn_pv(lds, bufc, p0, p1, o, q32, hi);
        if (jn < 0) return false;
        *(LAS u32x4*)(lds + AL_K + (bufc ^ 1) * 9216 + srow * 144 + sch * 16) = kS; *(LAS u32x4*)(lds + AL_V + (bufc ^ 1) * 9216 + srow * 144 + sch * 16) = vS;
        __syncthreads();
        j = jn; jn = jnn;
        return true;
    };
    for (;;) { if (!step(kA, vA, kB, vB, 0)) break; if (!step(kB, vB, kA, vA, 1)) break; }
    const float ltot = lsum + __shfl_xor(lsum, 32);
    const float sc = (m > -1e29f) ? gate * fast_rcp(ltot) : 0.f;
#pragma unroll
    for (int i = 0; i < 16; ++i) { o[0][i] *= sc; o[1][i] *= sc; }
}

DI void attn_item(const Args& a, LAS unsigned char* lds, int item, int tid, int lane, int wave) {
    const int qt = 31 - (item >> 5), b = (item >> 2) & 7, g = item & 3, bg = b * 4 + g;
    const int cur = qt, t0 = 64 * qt, r = wave >> 1, head = 4 * g + r, q32 = lane & 31, hi = lane >> 5, tl = 32 * (wave & 1) + q32, tq = t0 + tl;
    const bf16_t* P = (const bf16_t*)(a.ws + WS_P);
    const float slope2 = exp2f(-0.5f * (float)(head + 1)) * LOG2E;
    const bf16_t* prow = P + (size_t)(b * SEQ + tq) * NP;
    bf16x8 qf[4];
#pragma unroll
    for (int kk = 0; kk < 4; ++kk) qf[kk] = *(const bf16x8*)(prow + C_NQ + head * 64 + 16 * kk + 8 * hi);
    const float g0 = sigmoidf_(bf2f(prow[C_GATE + head * 3])), g1 = sigmoidf_(bf2f(prow[C_GATE + head * 3 + 1])), g2 = sigmoidf_(bf2f(prow[C_GATE + head * 3 + 2]));
    LAS float* stash = (LAS float*)(lds + AL_STASH + wave * 8192) + lane;
    const int srow = tid >> 3, sch = tid & 7;
    {
        const int ntile = (qt >= 16) ? 2 : 1;
        const bf16_t* kc = (const bf16_t*)(a.ws + SM_KC) + (size_t)bg * 128 * 64;
        const bf16_t* vct = (const bf16_t*)(a.ws + SM_VCT) + (size_t)bg * 64 * 128;
        {
            const u32x4 k0 = *(const u32x4*)(kc + (size_t)srow * 64 + 8 * sch), v0 = *(const u32x4*)(vct + (size_t)srow * 128 + 8 * sch);
            u32x4 k1 = k0, v1 = v0;
            if (ntile == 2) { k1 = *(const u32x4*)(kc + (size_t)(64 + srow) * 64 + 8 * sch); v1 = *(const u32x4*)(vct + (size_t)srow * 128 + 64 + 8 * sch); }
            *(LAS u32x4*)(lds + AL_K + srow * 144 + sch * 16) = k0; *(LAS u32x4*)(lds + AL_V + srow * 144 + sch * 16) = v0;
            *(LAS u32x4*)(lds + AL_K + 9216 + srow * 144 + sch * 16) = k1; *(LAS u32x4*)(lds + AL_V + 9216 + srow * 144 + sch * 16) = v1;
        }
        __syncthreads();
        f32x16 p[4];
        attn_scores(lds, 0, qf, p[0], p[1], q32, hi);
        attn_scores(lds, 1, qf, p[2], p[3], q32, hi);
        float mx = NEGBIG;
#pragma unroll
        for (int kb = 0; kb < 4; ++kb)
#pragma unroll
            for (int rr = 0; rr < 16; ++rr) { const int n = 32 * kb + crow(rr, hi); const int d = tq - (16 * n + 31);
                const bool v = (d >= 0) && (kb < 2 * ntile);
                p[kb][rr] = v ? p[kb][rr] - slope2 * (float)d : NEGBIG; mx = fmaxf(mx, p[kb][rr]); }
        mx = fmaxf(mx, __shfl_xor(mx, 32));
        float ps = 0.f;
#pragma unroll
        for (int kb = 0; kb < 4; ++kb)
#pragma unroll
            for (int rr = 0; rr < 16; ++rr) { p[kb][rr] = fast_exp2(p[kb][rr] - mx); ps += p[kb][rr]; }
        ps += __shfl_xor(ps, 32);
        const float inv = (mx > -1e29f) ? fast_rcp(ps) : 0.f;
#pragma unroll
        for (int kb = 0; kb < 4; ++kb)
#pragma unroll
            for (int rr = 0; rr < 16; ++rr) p[kb][rr] *= inv;
        float rc_prev = 0.f;
#pragma unroll
        for (int k = 0; k < 16; ++k) { const int kb = k >> 2, c4 = k & 3; const float bc = p[kb][4 * c4 + 3]; const float av = (p[kb][4 * c4] + p[kb][4 * c4 + 1]) + (p[kb][4 * c4 + 2] + bc);
            const float rc = __shfl_xor(bc, 32); const float v = av + (hi ? rc : rc_prev); rc_prev = rc;
            *(LAS float*)(lds + AL_IMP + ((r * 64 + tl) * 33 + 2 * k + hi) * 4) = v; }
        f32x16 o[2];
#pragma unroll
        for (int i = 0; i < 16; ++i) { o[0][i] = 0.f; o[1][i] = 0.f; }
        attn_pv(lds, 0, p[0], p[1], o, q32, hi);
        if (ntile == 2) attn_pv(lds, 1, p[2], p[3], o, q32, hi);
#pragma unroll
        for (int i = 0; i < 16; ++i) { stash[i * 64] = g0 * o[0][i]; stash[(16 + i) * 64] = g0 * o[1][i]; }
    }
    __syncthreads();
    {
        const int tok = tid >> 3, jg = tid & 7;
        float v[32];
#pragma unroll
        for (int j = 0; j < 32; ++j) { float s = 0.f;
#pragma unroll
            for (int rr = 0; rr < 4; ++rr) s += *(const LAS float*)(lds + AL_IMP + ((rr * 64 + tok) * 33 + j) * 4);
            const bool forced = (j == 0) || (j == cur) || (j == cur - 1);
            v[j] = forced ? 1e9f : ((j > cur) ? -1e9f : s); }
        unsigned bits = 0u;
#pragma unroll
        for (int i = 0; i < 4; ++i) {
            float mine = 0.f;
#pragma unroll
            for (int j = 0; j < 32; ++j) if ((j >> 2) == jg && (j & 3) == i) mine = v[j];
            const int jme = 4 * jg + i; int rank = 0;
#pragma unroll
            for (int j = 0; j < 32; ++j) rank += (v[j] > mine || (v[j] == mine && j < jme)) ? 1 : 0;
            if (rank < 16) bits |= 1u << jme;
        }
        bits |= __shfl_xor(bits, 1); bits |= __shfl_xor(bits, 2); bits |= __shfl_xor(bits, 4);
        if (jg == 0) *(LAS unsigned*)(lds + AL_SELM + tok * 4) = bits;
    }
    __syncthreads();
    unsigned umask = *(const LAS unsigned*)(lds + AL_SELM + lane * 4);
#pragma unroll
    for (int o2 = 1; o2 < 64; o2 <<= 1) umask |= __shfl_xor(umask, o2);
    const unsigned mymask = *(const LAS unsigned*)(lds + AL_SELM + tl * 4);
    const unsigned causal = (cur == 31) ? 0xffffffffu : ((1u << (cur + 1)) - 1u);
    umask = __builtin_amdgcn_readfirstlane(umask & causal);
    f32x16 ob[2];
    f32x16 ab0, ab1;
#pragma unroll
    for (int rr = 0; rr < 16; ++rr) { ab0[rr] = slope2 * (float)(crow(rr, hi) - tl); ab1[rr] = slope2 * (float)(crow(rr, hi) + 32 - tl); }
    unsigned amask = *(const LAS unsigned*)(lds + AL_SELM + lane * 4);
#pragma unroll
    for (int o2 = 1; o2 < 64; o2 <<= 1) amask &= __shfl_xor(amask, o2);
    const unsigned below = (1u << cur) - 1u;
    const unsigned sfull = __builtin_amdgcn_readfirstlane(amask) & below;
    attn_stream<0>(lds, P + (size_t)(b * SEQ) * NP + C_NKS + g * 64, (const bf16_t*)(a.ws + WS_VT) + (size_t)bg * 64 * SEQ, umask, sfull, mymask, cur, tq, slope2, g1, qf, ab0, ab1, ob, tid, q32, hi);
#pragma unroll
    for (int i = 0; i < 16; ++i) { stash[i * 64] += ob[0][i]; stash[(16 + i) * 64] += ob[1][i]; }
    const int wlo = cur >= 8 ? cur - 8 : 0;
    const unsigned wmask = causal & ~((1u << wlo) - 1u);
    const unsigned wfull = below & ~((1u << (cur >= 7 ? cur - 7 : 0)) - 1u);
    attn_stream<1>(lds, P + (size_t)(b * SEQ) * NP + C_NKW + g * 64, (const bf16_t*)(a.ws + WS_VT) + (size_t)(32 * 64 * SEQ) + (size_t)bg * 64 * SEQ, wmask, wfull, 0u, cur, tq, slope2, g2, qf, ab0, ab1, ob, tid, q32, hi);
#pragma unroll
    for (int i = 0; i < 16; ++i) { ob[0][i] += stash[i * 64]; ob[1][i] += stash[(16 + i) * 64]; }
    bf16_t* mo = (bf16_t*)(a.ws + WS_XN) + (size_t)(b * SEQ + tq) * DM + 1024 + head * 64;
#pragma unroll
    for (int db = 0; db < 2; ++db)
#pragma unroll
        for (int c4 = 0; c4 < 4; ++c4) { u32x2 w; w.x = pk2(ob[db][4 * c4], ob[db][4 * c4 + 1]); w.y = pk2(ob[db][4 * c4 + 2], ob[db][4 * c4 + 3]);
            *(u32x2*)(mo + 32 * db + 8 * c4 + 4 * hi) = w; }
}

DI unsigned f2sort(float f) { const unsigned u = __float_as_uint(f); return u ^ ((u >> 31) ? 0xffffffffu : 0x80000000u); }
DI float sort2f(unsigned u) { return __uint_as_float(u ^ ((u >> 31) ? 0x80000000u : 0xffffffffu)); }
DI void ce_desc(unsigned& x, unsigned& y) { const unsigned hi = max(x, y), lo = min(x, y); x = hi; y = lo; }
template <int NA> DI void sort16_desc(unsigned (&a)[NA], const int off) {
#pragma unroll
    for (int ks = 1; ks <= 4; ++ks)
#pragma unroll
        for (int js = 0; js < 4; ++js) { const int k = 1 << ks, jb = ks - 1 - js;
            if (jb >= 0) { const int j = 1 << jb;
#pragma unroll
                for (int i = 0; i < 16; ++i) { const int l = i ^ j; if (l > i) { if ((i & k) == 0) ce_desc(a[off + i], a[off + l]); else ce_desc(a[off + l], a[off + i]); } } } }
}
template <int NA> DI void merge_top16(unsigned (&a)[NA], const int oa, const int ob) {
#pragma unroll
    for (int i = 0; i < 16; ++i) a[oa + i] = max(a[oa + i], a[ob + 15 - i]);
#pragma unroll
    for (int js = 0; js < 4; ++js) { const int j = 8 >> js;
#pragma unroll
        for (int i = 0; i < 16; ++i) { const int l = i ^ j; if (l > i) ce_desc(a[oa + i], a[oa + l]); } }
}
DI void top16_of_64(unsigned (&a)[64]) { sort16_desc(a, 0); sort16_desc(a, 16); sort16_desc(a, 32); sort16_desc(a, 48); merge_top16(a, 0, 16); merge_top16(a, 32, 48); merge_top16(a, 0, 32); }
DI void topk_item(const Args& a, LAS unsigned char* wl, int item, int lane, LAS unsigned* lcnt) {
    const int tt = item >> 3, h = item & 7, q32 = lane & 31, hi = lane >> 5, tok = 32 * tt + q32;
    const __amdgpu_buffer_rsrc_t SKb = __builtin_amdgcn_make_buffer_rsrc((void*)(a.ws + SM_SK), 0, 524288, 0x00020000);
    const __amdgpu_buffer_rsrc_t Qb = __builtin_amdgcn_make_buffer_rsrc((void*)(a.ws + WS_QP), 0, 64 << 20, 0x00020000);
    LAS unsigned* tab = (LAS unsigned*)wl;
    unsigned top[2][16];
#pragma unroll
    for (int p = 0; p < 2; ++p) {
        f32x16 acc[4];
#pragma unroll
        for (int kb = 0; kb < 4; ++kb)
#pragma unroll
            for (int i = 0; i < 16; ++i) acc[kb][i] = 0.f;
        const int kvo = (q32 * 128 + 8 * hi) * 2, qvo = (q32 * DM + 8 * hi) * 2;
#pragma unroll
        for (int ks = 0; ks < 8; ++ks) {
            const bf16x8 qv = __builtin_bit_cast(bf16x8, __builtin_amdgcn_raw_buffer_load_b128(Qb, qvo, ((32 * tt) * DM + h * 256 + p * 128 + 16 * ks) * 2, 0));
#pragma unroll
            for (int kb = 0; kb < 4; ++kb) acc[kb] = MFMA32(__builtin_bit_cast(bf16x8, __builtin_amdgcn_raw_buffer_load_b128(SKb, kvo, (((h * 2 + p) * 128 + 32 * kb) * 128 + 16 * ks) * 2, 0)), qv, acc[kb]);
        }
        int h4 = 4 * hi; asm volatile("" : "+v"(h4));
        unsigned key[64];
#pragma unroll
        for (int kb = 0; kb < 4; ++kb)
#pragma unroll
            for (int r = 0; r < 16; ++r) key[kb * 16 + r] = (f2sort(acc[kb][r]) & ~127u) | (unsigned)(127 - (32 * kb + (r & 3) + 8 * (r >> 2)) - h4);
        top16_of_64(key);
#pragma unroll
        for (int i = 0; i < 16; ++i) key[16 + i] = (unsigned)__shfl_xor((int)key[i], 32);
        merge_top16(key, 0, 16);
#pragma unroll
        for (int i = 0; i < 16; ++i) { top[p][i] = key[i]; tab[(p * 16 + i) * 64 + lane] = key[i]; }
    }
    unsigned cand[64]; { int n = 0;
#pragma unroll
        for (int i = 0; i < 16; ++i)
#pragma unroll
            for (int j = 0; j < 16; ++j) if ((i + 1) * (j + 1) <= 16) { cand[n] = (f2sort(sort2f(top[0][i] & ~127u) + sort2f(top[1][j] & ~127u)) & ~255u) | (unsigned)(255 - (16 * i + j)); ++n; }
#pragma unroll
        for (int i = 50; i < 64; ++i) cand[i] = 0u; }
    top16_of_64(cand);
    const float vmax = sort2f(cand[0] & ~255u);
    float e[16], esum = 0.f; unsigned ex[16];
#pragma unroll
    for (int rd = 0; rd < 16; ++rd) {
        const unsigned m = cand[rd]; const int cidx = 255 - (int)(m & 255u), ci = cidx >> 4, cj = cidx & 15;
        e[rd] = __expf(sort2f(m & ~255u) - vmax); esum += e[rd];
        const unsigned i0 = 127u - (tab[ci * 64 + lane] & 127u), i1 = 127u - (tab[(16 + cj) * 64 + lane] & 127u);
        ex[rd] = i0 * 128u + i1;
    }
    if (hi == 0) {
        LAS unsigned* cnt = lcnt + (q32 >> 4) * 16; unsigned* lt = (unsigned*)(a.ws + WS_LIST) + (size_t)(2 * tt + (q32 >> 4)) * 2048; unsigned* lm = (unsigned*)(a.ws + WS_LISTM) + (size_t)(2 * tt + (q32 >> 4)) * 4096;
        unsigned* pidx = (unsigned*)(a.ws + WS_PIDX) + (size_t)tok * 128 + h * 16; unsigned pos[16];
#pragma unroll
        for (int rd = 0; rd < 16; ++rd) { const unsigned g = ex[rd] >> 10, el = ex[rd] & 1023u;
            pos[rd] = __hip_atomic_fetch_add(cnt + g, 1u, __ATOMIC_RELAXED, __HIP_MEMORY_SCOPE_WORKGROUP);
            const unsigned ent = (el << 7) | (((el >> 1) & 7u) << 4) | ((unsigned)(q32 & 3) << 17) | ((unsigned)((q32 >> 2) & 3) << 24), p = pos[rd];
            if (p < 256u) lm[g * 256u + (p >> 6) * 64u + (p & 15u) * 4u + ((p >> 4) & 3u)] = ent;
            if (p >= 192u) lt[(size_t)g * (1024 * 2048) + (p & 15u) * 128u + (p >> 4)] = ent; }
#pragma unroll
        for (int k4 = 0; k4 < 4; ++k4) *(u32x4*)(pidx + 4 * k4) = (u32x4){pos[4 * k4], pos[4 * k4 + 1], pos[4 * k4 + 2], pos[4 * k4 + 3]};
        const float inv = 1.f / esum;
        unsigned* ei = (unsigned*)(a.ws + WS_EI) + (size_t)tok * 128 + h * 16; float* eg = (float*)(a.ws + WS_EG) + (size_t)tok * 128 + h * 16;
#pragma unroll
        for (int k4 = 0; k4 < 4; ++k4) {
            *(u32x4*)(ei + 4 * k4) = (u32x4){ex[4 * k4], ex[4 * k4 + 1], ex[4 * k4 + 2], ex[4 * k4 + 3]};
            *(f32x4*)(eg + 4 * k4) = (f32x4){e[4 * k4] * inv, e[4 * k4 + 1] * inv, e[4 * k4 + 2] * inv, e[4 * k4 + 3] * inv};
        }
    }
}

#define XB_TMO      128
#define XB_XCNT(j)  (256  + 64 * (j))
#define XB_XSUB(j)  (1280 + 64 * (j))
#define XB_XGEN(j)  (2304 + 64 * (j))
#define XB_TOP      3328
#define XB_TOPGEN   3392
#define XCD_BAR_WORDS 3456
#define XB_SPIN_CAP (1u << 22)
DI unsigned xb_ld(unsigned* p)              { return __hip_atomic_load(p, __ATOMIC_RELAXED, __HIP_MEMORY_SCOPE_AGENT); }
DI unsigned xb_add(unsigned* p, unsigned v) { return __hip_atomic_fetch_add(p, v, __ATOMIC_RELAXED, __HIP_MEMORY_SCOPE_AGENT); }
DI unsigned xb_xcc_id() { return (unsigned)__builtin_amdgcn_s_getreg((3 << 11) | 20) & 0xFu; }
#define XB_SPIN(cond, bar) do { unsigned _sp = 0; while (cond) { __builtin_amdgcn_s_sleep(1); \
    if ((++_sp & 255u) == 0u) { if (xb_ld(&(bar)[XB_TMO])) break; if (_sp > XB_SPIN_CAP) { atomicAdd(&(bar)[XB_TMO], 1u); break; } } } } while (0)
struct XcdBarrier { unsigned* bar; unsigned x; volatile LAS unsigned* st; };
DI XcdBarrier xcd_barrier_post(unsigned* bar, volatile LAS unsigned* st) {
    XcdBarrier b; b.bar = bar; b.x = xb_xcc_id(); b.st = st;
    if (threadIdx.x == 0) (void)xb_add(&bar[XB_XCNT(b.x)], 1u);
    return b;
}
DI void xcd_barrier_complete(unsigned* bar, unsigned x, unsigned& nloc, unsigned& nx) {
    const unsigned G = gridDim.x * gridDim.y * gridDim.z;
    unsigned sum, cnt, mine, sp = 0u;
    for (;;) {
        sum = 0u; cnt = 0u; mine = 0u;
#pragma unroll
        for (unsigned j = 0; j < 16; ++j) { const unsigned c = xb_ld(&bar[XB_XCNT(j)]); sum += c; cnt += (c > 0u) ? 1u : 0u; mine = (j == x) ? c : mine; }
        if (sum == G) break;
        __builtin_amdgcn_s_sleep(1);
        if ((++sp & 255u) == 0u) { if (xb_ld(&bar[XB_TMO])) break; if (sp > XB_SPIN_CAP) { atomicAdd(&bar[XB_TMO], 1u); break; } }
    }
    nloc = mine > 0u ? mine : 1u; nx = cnt > 0u ? cnt : 1u;
}
DI void xcd_barrier(const XcdBarrier& b) {
    asm volatile("s_waitcnt vmcnt(0)" ::: "memory");
    __syncthreads();
    if (threadIdx.x == 0) {
        unsigned* bar = b.bar;
        __builtin_amdgcn_s_waitcnt(0);
        unsigned nloc = b.st[0], nx = b.st[1];
        if (nloc == 0u) { xcd_barrier_complete(bar, b.x, nloc, nx); b.st[0] = nloc; b.st[1] = nx; }
        const unsigned old = xb_add(&bar[XB_XSUB(b.x)], 1u);
        const unsigned gen = old / nloc;
        if (old + 1u == (gen + 1u) * nloc) {
            __builtin_amdgcn_fence(__ATOMIC_RELEASE, "agent");
            asm volatile("s_waitcnt vmcnt(0)" ::: "memory");
            const unsigned og = xb_add(&bar[XB_TOP], 1u);
            const unsigned tg = og / nx;
            if (og + 1u == (tg + 1u) * nx) xb_add(&bar[XB_TOPGEN], 1u);
            else XB_SPIN(xb_ld(&bar[XB_TOPGEN]) == tg, bar);
            __builtin_amdgcn_fence(__ATOMIC_ACQUIRE, "agent");
            xb_add(&bar[XB_XGEN(b.x)], 1u);
            asm volatile("s_waitcnt vmcnt(0)" ::: "memory");
        } else {
            XB_SPIN(xb_ld(&bar[XB_XGEN(b.x)]) == gen, bar);
            __builtin_amdgcn_fence(__ATOMIC_ACQUIRE, "agent");
            asm volatile("s_waitcnt vmcnt(0)" ::: "memory");
        }
    }
    __syncthreads();
}

constexpr int SLICE_BYTES = 16384 * 128;
constexpr int PEER_TT = 128, PEER_NT = PEER_TT / 8;
struct PeerIdxW { u32x4 e4[4]; };
struct PeerVRows { u32x4 r[16]; u32x2 h2; };
struct UTile { u32x4 a0, a1, e0, e1, e2; unsigned n, off; };
struct UBuf { i32x4 b0[4], b1[4]; unsigned en[4]; };
DI void peer_u_lds_phase(const Args& a, LAS unsigned char* lds, int tid, int lane, int wave) {
    LAS int* rslot = (LAS int*)(lds + LDS_BYTES - 64);
    unsigned* ctl = (unsigned*)(a.ws + WS_CTL);
    const int xcd = (int)(xb_xcc_id() & 7u);
    for (;;) {
        __syncthreads();
        if (tid == 0) { int role = -1;
            if (__hip_atomic_load(ctl + CW_ROLE + 512, __ATOMIC_RELAXED, __HIP_MEMORY_SCOPE_AGENT) < 256u)
                for (int q = 0; q < 8 && role < 0; ++q) { const int x = (xcd + q) & 7; const unsigned r = atomicAdd(ctl + CW_ROLE + 64 * x, 1u); if (r < 32u) role = (int)((((unsigned)x + 8u * (r >> 4)) << 4) | (r & 15u)); }
            if (role >= 0) atomicAdd(ctl + CW_ROLE + 512, 1u);
            *rslot = role; }
        __syncthreads();
        const int role = *rslot; if (role < 0) break;
        const int s = role >> 4, g = role & 15;
        { const unsigned char* src = a.ws + WS_UB + (size_t)s * SLICE_BYTES + (size_t)g * 131072;
#pragma unroll
          for (int hb = 0; hb < 2; ++hb) { u32x4 v[8];
#pragma unroll
            for (int i = 0; i < 8; ++i) v[i] = *(const u32x4*)(src + (size_t)(tid + 512 * (8 * hb + i)) * 16);
#pragma unroll
            for (int i = 0; i < 8; ++i) { const int idx = tid + 512 * (8 * hb + i), e = idx >> 3, c = idx & 7; *(LAS u32x4*)(lds + e * 128 + ((c ^ ((e >> 1) & 7)) << 4)) = v[i]; } } }
        __syncthreads();
        const int j = lane & 15, kg = lane >> 4;
        const __amdgpu_buffer_rsrc_t Hb = __builtin_amdgcn_make_buffer_rsrc((void*)(a.ws + WS_HQ8), 0, 32 << 20, 0x00020000);
        const __amdgpu_buffer_rsrc_t Mb = __builtin_amdgcn_make_buffer_rsrc((void*)(a.ws + WS_LISTM), 0, 16 << 20, 0x00020000);
        const __amdgpu_buffer_rsrc_t Lb = __builtin_amdgcn_make_buffer_rsrc((void*)(a.ws + WS_LIST + (size_t)g * (8 << 20)), 0, 8 << 20, 0x00020000);
        const __amdgpu_buffer_rsrc_t Cb = __builtin_amdgcn_make_buffer_rsrc((void*)(ctl + CW_CNT), 0, 131072, 0x00020000);
        const __amdgpu_buffer_rsrc_t Pb = __builtin_amdgcn_make_buffer_rsrc((void*)(a.ws + WS_PU + (size_t)s * M * 512), 0, M * 512, 0x00020000);
        auto load = [&](UTile& t, int T) {
            t.n = (unsigned)__builtin_amdgcn_raw_buffer_load_b32(Cb, 0, (T * 16 + g) * 4, 0); t.off = (unsigned)__builtin_amdgcn_raw_buffer_load_b32(Cb, 0, (CW_OFF - CW_CNT + T * 16 + g) * 4, 0);
            t.a0 = __builtin_bit_cast(u32x4, __builtin_amdgcn_raw_buffer_load_b128(Hb, j * DM + 128 * s + 16 * kg, T * (16 * DM), 0));
            t.a1 = __builtin_bit_cast(u32x4, __builtin_amdgcn_raw_buffer_load_b128(Hb, j * DM + 128 * s + 16 * kg + 64, T * (16 * DM), 0));
            t.e0 = __builtin_bit_cast(u32x4, __builtin_amdgcn_raw_buffer_load_b128(Mb, j * 16, T * 16384 + g * 1024, 0));
            t.e1 = __builtin_bit_cast(u32x4, __builtin_amdgcn_raw_buffer_load_b128(Mb, j * 16 + 256, T * 16384 + g * 1024, 0));
            t.e2 = __builtin_bit_cast(u32x4, __builtin_amdgcn_raw_buffer_load_b128(Mb, j * 16 + 512, T * 16384 + g * 1024, 0)); };
        auto issue = [&](UBuf& B, const u32x4 e4, int rt0, int n) {
#pragma unroll
            for (int v = 0; v < 4; ++v) { B.en[v] = e4[v];
                const unsigned ad = (B.en[v] & 0x1FFFFu) ^ ((unsigned)kg << 4);
                B.b0[v] = *(const LAS i32x4*)(lds + ad); B.b1[v] = *(const LAS i32x4*)(lds + (ad ^ 64u)); }
            __builtin_amdgcn_sched_barrier(0); };
        auto finish = [&](const UBuf& B, const i32x4 a0, const i32x4 a1, int rt0, int so) {
            i32x4 c[4];
#pragma unroll
            for (int v = 0; v < 4; ++v) c[v] = __builtin_amdgcn_mfma_i32_16x16x64_i8(a0, B.b0[v], (i32x4){0, 0, 0, 0}, 0, 0, 0);
#pragma unroll
            for (int v = 0; v < 4; ++v) c[v] = __builtin_amdgcn_mfma_i32_16x16x64_i8(a1, B.b1[v], c[v], 0, 0, 0);
            __builtin_amdgcn_sched_barrier(0);
#pragma unroll
            for (int v = 0; v < 4; ++v) {
                int m0, m1, v01, v23, val;
                asm("v_bfe_i32 %0, %1, 17, 1" : "=v"(m0) : "v"(B.en[v])); asm("v_bfe_i32 %0, %1, 18, 1" : "=v"(m1) : "v"(B.en[v]));
                asm("v_bfi_b32 %0, %1, %2, %3" : "=v"(v01) : "v"(m0), "v"(c[v][1]), "v"(c[v][0])); asm("v_bfi_b32 %0, %1, %2, %3" : "=v"(v23) : "v"(m0), "v"(c[v][3]), "v"(c[v][2]));
                asm("v_bfi_b32 %0, %1, %2, %3" : "=v"(val) : "v"(m1), "v"(v23), "v"(v01));
                if ((B.en[v] >> 24) == (unsigned)kg) __builtin_amdgcn_raw_buffer_store_b32((unsigned)val, Pb, (16 * (rt0 + v) + j) * 4, so, 0); }
            __builtin_amdgcn_sched_barrier(0); };
        auto proc = [&](const UTile& t, int T) {
            const int n = (int)__builtin_amdgcn_readfirstlane(t.n), nrt = (n + 15) >> 4;
            const i32x4 a0 = __builtin_bit_cast(i32x4, t.a0), a1 = __builtin_bit_cast(i32x4, t.a1);
            const int so = T * 8192 + 4 * (int)__builtin_amdgcn_readfirstlane(t.off);
            UBuf B0, B1;
            if (nrt > 0) { issue(B0, t.e0, 0, n);
                if (nrt > 4) { issue(B1, t.e1, 4, n); finish(B0, a0, a1, 0, so);
                    if (nrt > 8) { issue(B0, t.e2, 8, n); finish(B1, a0, a1, 4, so); finish(B0, a0, a1, 8, so); }
                    else finish(B1, a0, a1, 4, so); }
                else finish(B0, a0, a1, 0, so); }
            if (nrt > 12) {
#pragma unroll 1
                for (int c0 = 12; c0 < nrt; c0 += 4) { const u32x4 x0 = __builtin_bit_cast(u32x4, __builtin_amdgcn_raw_buffer_load_b128(Lb, j * 512 + c0 * 4, T * 8192, 0));
                    issue(B0, x0, c0, n); finish(B0, a0, a1, c0, so); }
                __builtin_amdgcn_s_waitcnt(0x0F70);
            } };
        UTile t0, t1, t2, t3; load(t0, wave); __builtin_amdgcn_sched_barrier(0); load(t1, wave + 8); __builtin_amdgcn_sched_barrier(0); load(t2, wave + 16); __builtin_amdgcn_sched_barrier(0);
#pragma unroll 1
        for (int T = wave; T < M / 16; T += 32) {
            const int Tn = T + 32 < M / 16 ? T + 32 : T;
            load(t3, T + 24);
            proc(t0, T);
            load(t0, Tn);
            proc(t1, T + 8);
            load(t1, Tn + 8);
            proc(t2, T + 16);
            load(t2, Tn + 16);
            proc(t3, T + 24);
        }
    }
}
DI void peer_reduce_tile(const Args& a, LAS unsigned char* lds, int T, int tid, int lane, int wave) {
    const unsigned* EI = (const unsigned*)(a.ws + WS_EI); const float* EG = (const float*)(a.ws + WS_EG); const unsigned* PIDX = (const unsigned*)(a.ws + WS_PIDX);
    const float* isU = (const float*)(a.ws + WS_UB + TAB_SCALE_OFF); const float* isV = (const float*)(a.ws + WS_VB + TAB_SCALE_OFF);
    LAS unsigned* loff = (LAS unsigned*)(lds + 131072);
    __syncthreads();
    { const unsigned char* src = a.ws + WS_PU + (size_t)T * 8192 + (size_t)tid * 16;
#pragma unroll
      for (int hb = 0; hb < 2; ++hb) { u32x4 v[8];
#pragma unroll
        for (int i = 0; i < 8; ++i) v[i] = *(const u32x4*)(src + (size_t)(8 * hb + i) * (8 << 20));
#pragma unroll
        for (int i = 0; i < 8; ++i) *(LAS u32x4*)(lds + (8 * hb + i) * 8192 + tid * 16) = v[i]; }
      if (tid < 16) loff[tid] = ((const unsigned*)(a.ws + WS_CTL))[CW_OFF + T * 16 + tid]; }
    __syncthreads();
#pragma unroll
    for (int tl = 0; tl < 2; ++tl) { const int tok = 16 * T + 2 * wave + tl; const float dq = ((const float*)(a.ws + WS_DQ))[tok];
#pragma unroll
        for (int hs = 0; hs < 2; ++hs) { const size_t idx = (size_t)tok * 128 + 64 * hs + lane; const unsigned e = EI[idx]; const float gt = EG[idx];
            const unsigned q = loff[e >> 10] + PIDX[idx]; int isum = 0;
#pragma unroll
            for (int s = 0; s < 16; ++s) isum += *(const LAS int*)(lds + s * 8192 + q * 4);
            const float w = gelu_tanh((float)isum * dq * isU[e]) * gt * isV[e];
            ((unsigned*)(a.ws + WS_W))[idx] = e | ((__float_as_uint(w) + 0x7fffu + ((__float_as_uint(w) >> 16) & 1u)) & 0xffff0000u); } }
}
DI void peer_v_item(const Args& a, int s, int tt, int lane, int wave) {
    const int g = lane >> 3, c8 = lane & 7;
    const __amdgpu_buffer_rsrc_t Vb = __builtin_amdgcn_make_buffer_rsrc((void*)(a.ws + WS_VB), 0, 32 << 20, 0x00020000);
    const __amdgpu_buffer_rsrc_t Wb = __builtin_amdgcn_make_buffer_rsrc((void*)(a.ws + WS_W), 0, 8 << 20, 0x00020000);
    const __amdgpu_buffer_rsrc_t Ob = __builtin_amdgcn_make_buffer_rsrc((void*)a.out, 0, (int)((size_t)M * DM * 4), 0x00020000);
    const int tok0 = PEER_TT * tt + wave;
    const int col = 128 * s + 16 * c8 + ((lane & 32) ? 8 : 0) + ((lane & 16) ? 4 : 0) + ((lane & 8) ? 2 : 0);
    auto pre = [&](PeerIdxW& E, int t) {
#pragma unroll
        for (int j = 0; j < 4; ++j) E.e4[j] = __builtin_bit_cast(u32x4, __builtin_amdgcn_raw_buffer_load_b128(Wb, g * 64 + 16 * j, (tok0 + 8 * t) * 512, 0)); };
    auto rows = [&](PeerVRows& R, const PeerIdxW& E, int t) {
#pragma unroll
        for (int i = 0; i < 16; ++i) R.r[i] = __builtin_bit_cast(u32x4, __builtin_amdgcn_raw_buffer_load_b128(Vb, (int)(E.e4[i >> 2][i & 3] & 0xffffu) * 128 + 16 * c8, s * SLICE_BYTES, 0));
        R.h2 = __builtin_bit_cast(u32x2, __builtin_amdgcn_raw_buffer_load_b64(Ob, col * 4, (tok0 + 8 * t) * (DM * 4), 0)); };
    auto comp = [&](const PeerVRows& R, const u32x4 (&w4)[4], int t) {
        f32x2 o2[8];
#pragma unroll
        for (int j = 0; j < 8; ++j) o2[j] = (f32x2){0.f, 0.f};
#pragma unroll
        for (int i = 0; i < 16; ++i) { const float w = __uint_as_float(w4[i >> 2][i & 3] & 0xffff0000u); const f32x2 w2 = (f32x2){w, w};
#pragma unroll
            for (int q = 0; q < 4; ++q) { const unsigned u = R.r[i][q]; o2[2 * q] += w2 * __builtin_amdgcn_cvt_pk_f32_fp8(u, false); o2[2 * q + 1] += w2 * __builtin_amdgcn_cvt_pk_f32_fp8(u, true); } }
        float v[16];
#pragma unroll
        for (int j = 0; j < 8; ++j) { v[2 * j] = o2[j][0]; v[2 * j + 1] = o2[j][1]; }
#pragma unroll
        for (int i = 0; i < 8; ++i) { float x = v[i], y = v[i + 8];
            asm volatile("s_nop 1\n\tv_permlane32_swap_b32 %0, %1" : "+v"(x), "+v"(y)); v[i] = x + y; }
#pragma unroll
        for (int i = 0; i < 4; ++i) { float x = v[i], y = v[i + 4];
            asm volatile("s_nop 1\n\tv_permlane16_swap_b32 %0, %1" : "+v"(x), "+v"(y)); v[i] = x + y; }
        { const bool up = (lane & 8) != 0;
#pragma unroll
          for (int i = 0; i < 2; ++i) { const float send = up ? v[i] : v[i + 2], keep = up ? v[i + 2] : v[i]; v[i] = keep + dpp_f<0x128>(send); } }
        f32x2 h2 = __builtin_bit_cast(f32x2, R.h2); h2[0] += v[0]; h2[1] += v[1];
        __builtin_amdgcn_raw_buffer_store_b64(__builtin_bit_cast(u32x2, h2), Ob, col * 4, (tok0 + 8 * t) * (DM * 4), 0); };
    PeerIdxW E0, E1; PeerVRows R0, R1; u32x4 wa[4], wb[4];
    pre(E0, 0); pre(E1, 1); rows(R0, E0, 0);
#pragma unroll
    for (int j = 0; j < 4; ++j) wa[j] = E0.e4[j];
#pragma unroll 1
    for (int t = 0; t < PEER_NT; t += 2) {
        rows(R1, E1, t + 1);
#pragma unroll
        for (int j = 0; j < 4; ++j) wb[j] = E1.e4[j];
        if (t + 2 < PEER_NT) pre(E0, t + 2);
        comp(R0, wa, t);
        if (t + 2 < PEER_NT) { rows(R0, E0, t + 2);
#pragma unroll
            for (int j = 0; j < 4; ++j) wa[j] = E0.e4[j]; }
        if (t + 3 < PEER_NT) pre(E1, t + 3);
        comp(R1, wb, t + 1);
    }
}
template <int VPH> DI void peer_sliced_phase(const Args& a, LAS unsigned char* lds, int tid, int lane, int wave) {
    LAS int* qslot = (LAS int*)(lds + LDS_BYTES - 64);
    const int xcd = (int)(xb_xcc_id() & 7u);
    for (int qi = 0; qi < 8; ++qi) {
        const int q = (xcd + qi) & 7; unsigned* head = (unsigned*)(a.ws + WS_CTL) + (VPH ? CW_PQV : CW_PQU) + 64 * q;
        for (;;) {
            __syncthreads();
            if (tid == 0) *qslot = (int)atomicAdd(head, 1u);
            __syncthreads();
            const int i = *qslot;
            if (i >= 2 * (M / PEER_TT)) break;
            const int s = q + 8 * (i / (M / PEER_TT)), tt = i % (M / PEER_TT);
            int l2 = (int)(threadIdx.x & 63u); asm volatile("" : "+v"(l2));
            peer_v_item(a, s, tt, l2, wave);
        }
    }
}

constexpr int NPHASE = 10;
#ifndef REPK
#define REPK -1
#endif
#define NREP(k) ((REPK) == (k) ? 2 : 1)
#ifndef PHMASK
#define PHMASK 0x3ff
#endif
__global__ void __launch_bounds__(NTHREADS, 2) fwd_kernel(Args a) {
    extern __shared__ __attribute__((aligned(16))) unsigned char lds_raw[];
    LAS unsigned char* lds = (LAS unsigned char*)lds_raw;
    cg::grid_group grid = cg::this_grid();
    int tid = threadIdx.x, lane = tid & 63, wave = __builtin_amdgcn_readfirstlane(tid >> 6);
    const int G = gridDim.x, NGW = G * NWAVES; int gw = blockIdx.x * NWAVES + wave;
#define FRESH() do { tid = threadIdx.x; asm volatile("" : "+v"(tid)); lane = tid & 63; wave = __builtin_amdgcn_readfirstlane(tid >> 6); gw = blockIdx.x * NWAVES + wave; } while (0)
    unsigned char* ws = a.ws;
    const int lo = a.ph_lo, hi = a.ph_hi;
#define IN(k) (lo <= (k) && (k) < hi)
#define SEAM(k) do { if (IN(k) && IN((k) + 1)) { if ((k) == 0) grid.sync(); else xcd_barrier(xbar); } } while (0)
    volatile LAS unsigned* xst = (volatile LAS unsigned*)(lds + LDS_BYTES - 32);
    if (tid < 2) xst[tid] = 0u;
    __syncthreads();
    const XcdBarrier xbar = xcd_barrier_post((unsigned*)(ws + WS_CTL) + CW_XBAR, xst);
    if (((PHMASK >> 0) & 1) && IN(0)) { FRESH(); for (int rep = 0; rep < NREP(0); ++rep) phase_prep(a, lds, gw, NGW, lane, wave);
        for (int fi = blockIdx.x; fi < FILL_SPLIT; fi += G) filler_item(a, lds, fi, lane, wave);
        for (int tile = blockIdx.x; tile < NP / 16; tile += G) coltile_q8_item(a.in[I_WIN], NPROJ, ws + WS_WIN, (float*)(ws + SM_SWC), lds, tile, tid); }
    SEAM(0);
    if (((PHMASK >> 1) & 1) && IN(1)) { FRESH();
        pg8::Gemm g{(const bf16_t*)(ws + WS_XN), (const bf16_t*)(ws + WS_WIN), M, NP, DM / 2}; pg8::StaticOrder S; S.init(M, NP, G, (int)blockIdx.x);
        pg8::EpiBf16 E{(bf16_t*)(ws + WS_P), NP, nullptr, (const float*)(ws + SM_LB), (const float*)(ws + WS_XN + 32 * MiB), (const float*)(ws + SM_SWC)};
        for (int rep = 0; rep < NREP(1); ++rep) pg8::gemm_phase<pg8::EpiBf16, pg8::StaticOrder, true, true, true>(lds, g, S, E);
    }
    SEAM(1);
    if (((PHMASK >> 2) & 1) && IN(2)) { FRESH();
        for (int row = gw; row < M; row += NGW) nsa_norm_row(a, row, lane);
        for (int rep = 0; rep < NREP(2); ++rep) {
        for (int it = gw; it < 2048; it += NGW) vtrans_item(a, lds + wave * 9216, it, lane);
        __syncthreads();
        for (int it = blockIdx.x; it < 256; it += G) compress_item(a, lds, it, tid, lane, wave);
        }
    }
    SEAM(2);
    if (((PHMASK >> 3) & 1) && IN(3)) { FRESH();
        LAS int* qslot = (LAS int*)(lds + LDS_BYTES - 64);
        for (int rep = 0; rep < ((REPK) == 30 || (REPK) == 31 ? 2 : 1); ++rep) {
        unsigned* qhead = (unsigned*)(ws + WS_CTL) + CW_QUEUE + 64 * rep;
        const int item_lo = (rep == 1 && (REPK) == 31) ? 64 : 0, item_hi = (rep == 1 && (REPK) == 30) ? 64 : 64 + 1024 + FILL_END - FILL_SPLIT;
        for (;;) {
            __syncthreads();
            if (tid == 0) *qslot = (int)atomicAdd(qhead, 1u);
            __syncthreads();
            const int item = *qslot + item_lo;
            if (item >= item_hi) break;
            int tid2 = tid; asm volatile("" : "+v"(tid2));
            const int lane2 = tid2 & 63, wave2 = __builtin_amdgcn_readfirstlane(tid2 >> 6);

#ifndef NO_HGRN
            if (item < 64) hgrn_item(a, lds, item, tid2, lane2, wave2);
#endif
#ifndef NO_ATTN
            if (item >= 64) {
                constexpr int NF = FILL_END - FILL_SPLIT, NT = 1024 + NF; const int k = item - 64;
                const int a0 = (int)(((long)k * 1024) / NT), a1 = (int)(((long)(k + 1) * 1024) / NT);
                if (a1 != a0) attn_item(a, lds, a0, tid2, lane2, wave2); else filler_item(a, lds, k - a0 + FILL_SPLIT, lane2, wave2); }
#endif

        }
        }
    }
    SEAM(3);
    if (((PHMASK >> 4) & 1) && IN(4)) { FRESH();
        rowquant_mix(a, gw, NGW, lane);
        xcd_barrier(xbar);
        FRESH();
        pg8::Gemm g{(const bf16_t*)(ws + WS_MIX8), (const bf16_t*)(ws + WS_WOUT), M, DM, DM / 2}; pg8::StaticOrder S; S.init(M, DM, G, (int)blockIdx.x);
        pg8::EpiH E{a.in[I_X], a.out, (const float*)(ws + WS_MIX8 + 32 * MiB), (const float*)(ws + SM_SWO), lds + 131072};
        for (int rep = 0; rep < NREP(4); ++rep) pg8::gemm_phase<pg8::EpiH, pg8::StaticOrder, true, true, true>(lds, g, S, E);
    }
    SEAM(4);
    if (((PHMASK >> 5) & 1) && IN(5)) { FRESH();
        rowquant_h(a, gw, NGW, lane);
        xcd_barrier(xbar);
        FRESH();
        pg8::Gemm g{(const bf16_t*)(ws + WS_HQ8), (const bf16_t*)(ws + WS_WQ), M, DM, DM / 2}; pg8::StaticOrder S; S.init(M, DM, G, (int)blockIdx.x);
        pg8::EpiBf16 E{(bf16_t*)(ws + WS_QP), DM, nullptr, nullptr, (const float*)(ws + WS_DQ), (const float*)(ws + SM_SWQ)};
        for (int rep = 0; rep < NREP(5); ++rep) pg8::gemm_phase<pg8::EpiBf16, pg8::StaticOrder, true, true, true>(lds, g, S, E);
    }
    SEAM(5);
    if (((PHMASK >> 6) & 1) && IN(6)) { FRESH(); for (int rep = 0; rep < NREP(6); ++rep) {
        LAS unsigned* lcnt = (LAS unsigned*)(lds + 131072);
        for (int it = gw; it < 4096; it += NGW) { int l2 = lane; asm volatile("" : "+v"(l2));
            if (tid < 32) lcnt[tid] = 0u;
            __syncthreads();
            topk_item(a, lds + wave * 16384, it, l2, lcnt);
            __syncthreads();
            if (tid < 32) { unsigned off = 0u; for (int g2 = 0; g2 < (tid & 15); ++g2) off += lcnt[(tid & 16) + g2];
                unsigned* ctl = (unsigned*)(ws + WS_CTL); const int ti = (2 * (it >> 3) + (tid >> 4)) * 16 + (tid & 15);
                ctl[CW_CNT + ti] = lcnt[tid]; ctl[CW_OFF + ti] = off; }
            { const int li = tid >> 4, g2 = li & 15; const unsigned n = lcnt[li], nup = (n + 63u) & ~63u;
                unsigned* lt = (unsigned*)(ws + WS_LIST) + (size_t)g2 * (1024 * 2048) + (size_t)(2 * (it >> 3) + (li >> 4)) * 2048;
                unsigned* lm = (unsigned*)(ws + WS_LISTM) + (size_t)(2 * (it >> 3) + (li >> 4)) * 4096 + g2 * 256;
#pragma unroll
                for (int k = 0; k < 4; ++k) { const unsigned p = n + (unsigned)(tid & 15) + 16u * k;
                    if (p < nup) { if (p < 256u) lm[(p >> 6) * 64u + (p & 15u) * 4u + ((p >> 4) & 3u)] = 0x80000000u; if (p >= 192u) lt[(p & 15u) * 128u + (p >> 4)] = 0x80000000u; } } }
        } } }
    SEAM(6);
    if (((PHMASK >> 7) & 1) && IN(7)) { FRESH(); peer_u_lds_phase(a, lds, tid, lane, wave); }
    SEAM(7);
    if (((PHMASK >> 8) & 1) && IN(8)) { FRESH(); for (int T = blockIdx.x; T < M / 16; T += G) peer_reduce_tile(a, lds, T, tid, lane, wave); }
    SEAM(8);
    if (((PHMASK >> 9) & 1) && IN(9)) { FRESH(); peer_sliced_phase<1>(a, lds, tid, lane, wave); }
#undef IN
#undef SEAM
}

#ifndef N_LAUNCH_MODE
#define N_LAUNCH_MODE 1
#endif
extern "C" void kernel_launch(void* const* d_in, const int* in_sizes, int n_in, void* d_out, int out_size, void* d_ws, size_t ws_size, hipStream_t stream) {
    static int grid = 0;
    if (grid == 0) {
        int dev = 0, cus = 0, per_cu = 0;
        (void)hipGetDevice(&dev); (void)hipDeviceGetAttribute(&cus, hipDeviceAttributeMultiprocessorCount, dev);
        (void)hipFuncSetAttribute((const void*)fwd_kernel, hipFuncAttributeMaxDynamicSharedMemorySize, LDS_BYTES);
        (void)hipOccupancyMaxActiveBlocksPerMultiprocessor(&per_cu, (const void*)fwd_kernel, NTHREADS, LDS_BYTES);
        if (per_cu < 1) { fprintf(stderr, "occupancy query says %d blocks/CU\n", per_cu); per_cu = 1; }
        grid = cus;
        if (ws_size < WS_END) fprintf(stderr, "warning: ws_size %zu too small\n", ws_size);
    }
    (void)hipMemsetAsync((char*)d_ws + WS_CTL, 0, CTL_BYTES, stream);
    Args a{};
    for (int i = 0; i < 21; ++i) a.in[i] = (const float*)d_in[i];
    a.out = (float*)d_out; a.ws = (unsigned char*)d_ws;
    if (N_LAUNCH_MODE == 1) {
        a.ph_lo = 0; a.ph_hi = NPHASE;
        void* args[] = {&a};
        hipError_t e = hipLaunchCooperativeKernel((const void*)fwd_kernel, dim3(grid), dim3(NTHREADS), args, LDS_BYTES, stream);
        if (e != hipSuccess) fprintf(stderr, "launch failed: %s\n", hipGetErrorString(e));
    } else {
        for (int p = 0; p < NPHASE; ++p) {
            a.ph_lo = p; a.ph_hi = p + 1;
            void* args[] = {&a};
            hipError_t e = hipLaunchCooperativeKernel((const void*)fwd_kernel, dim3(grid), dim3(NTHREADS), args, LDS_BYTES, stream);
            if (e != hipSuccess) { fprintf(stderr, "launch failed: %s\n", hipGetErrorString(e)); break; }
        }
    }
}
```

```cpp
#include <hip/hip_runtime.h>
#include <hip/hip_cooperative_groups.h>
#include <cstdio>
#include <cstdint>
namespace cg = cooperative_groups;

#define DI __device__ __forceinline__
#define LAS __attribute__((address_space(3)))
typedef unsigned short bf16_t;
typedef short bf16x8 __attribute__((ext_vector_type(8)));
typedef float f32x2 __attribute__((ext_vector_type(2)));
typedef float f32x4 __attribute__((ext_vector_type(4)));
typedef float f32x16 __attribute__((ext_vector_type(16)));
typedef unsigned u32x2 __attribute__((ext_vector_type(2)));
typedef int i32x4 __attribute__((ext_vector_type(4)));
typedef unsigned u32x4 __attribute__((ext_vector_type(4)));
typedef __bf16 bf16x2_t __attribute__((ext_vector_type(2)));

constexpr int DM = 2048, NB = 8, SEQ = 2048, M = NB * SEQ;
constexpr int NPROJ = 6704, NP = 6912;
constexpr int C_HQ = 0, C_HF = 1024, C_HI = 2048, C_HG = 3072, C_NQ = 4096, C_NKC = 5120, C_NVC = 5376, C_NKS = 5632, C_NVS = 5888, C_NKW = 6144, C_NVW = 6400, C_GATE = 6656;
constexpr float EPS = 1e-6f;
constexpr float LOG2E = 1.4426950408889634f;

constexpr size_t MiB = 1u << 20;
constexpr size_t WS_CTL = 0, CTL_BYTES = 1 * MiB;
constexpr size_t WS_WIN = 1 * MiB;
constexpr size_t WS_WOUT = 28 * MiB;
constexpr size_t WS_WQ = 36 * MiB;
constexpr size_t WS_SMALL = 44 * MiB;
constexpr size_t WS_UB = 52 * MiB;
constexpr size_t WS_VB = 116 * MiB;
constexpr size_t TAB_SCALE_OFF = 32 * MiB;
constexpr size_t WS_P = 180 * MiB;
constexpr size_t WS_XN = 396 * MiB;
constexpr size_t WS_VT = 460 * MiB;
constexpr size_t WS_SSQ = 476 * MiB;
constexpr size_t WS_LISTM = 478 * MiB;
constexpr size_t WS_END = 494 * MiB;
constexpr size_t WS_MIX8 = WS_P + 64 * MiB;
constexpr size_t WS_QP = WS_P + 64 * MiB;
constexpr size_t WS_EI = WS_P + 128 * MiB;
constexpr size_t WS_EG = WS_P + 136 * MiB;
constexpr size_t WS_W = WS_P + 144 * MiB;
constexpr size_t WS_PU = WS_P;
constexpr size_t WS_LIST = WS_P + 152 * MiB;
constexpr size_t WS_PIDX = WS_VT;
constexpr size_t WS_HQ8 = WS_WIN;
constexpr size_t WS_DQ = WS_WIN + 32 * MiB;
constexpr size_t SM_W1K = WS_SMALL;
constexpr size_t SM_W1V = WS_SMALL + 1 * MiB;
constexpr size_t SM_W2K = WS_SMALL + 2 * MiB;
constexpr size_t SM_W2V = SM_W2K + 32768;
constexpr size_t SM_SK = WS_SMALL + 3 * MiB;
constexpr size_t SM_LB = WS_SMALL + 4 * MiB;
constexpr size_t SM_BIASP = SM_LB + 4096;
constexpr size_t SM_KC = WS_SMALL + 5 * MiB;
constexpr size_t SM_SWC = WS_SMALL + 7 * MiB;
constexpr size_t SM_SWQ = WS_SMALL + 7 * MiB + 32768;
constexpr size_t SM_SWO = WS_SMALL + 7 * MiB + 49152;
constexpr size_t SM_VCT = WS_SMALL + 6 * MiB;
static_assert(WS_END <= 512 * MiB, "ws");
constexpr int CW_QUEUE = 64;
constexpr int CW_PQU = 8192, CW_PQV = 9216;
constexpr int CW_ROLE = 10240;
constexpr int CW_CNT = 16384;
constexpr int CW_OFF = 32768;
constexpr int CW_XBAR = 4096;

constexpr int LDS_BYTES = 151552;
constexpr int NTHREADS = 512, NWAVES = 8;

DI unsigned pk2(float lo, float hi) { f32x2 v = {lo, hi}; bf16x2_t b = __builtin_convertvector(v, bf16x2_t); return __builtin_bit_cast(unsigned, b); }
DI bf16_t f2bf(float f) { return (bf16_t)(pk2(f, 0.f) & 0xffffu); }
DI float bf2f(bf16_t u) { return __uint_as_float((unsigned)u << 16); }
DI float bflo(unsigned u) { return __uint_as_float(u << 16); }
DI float bfhi(unsigned u) { return __uint_as_float(u & 0xffff0000u); }
DI float wave_sum(float v) {
#pragma unroll
    for (int o = 1; o < 64; o <<= 1) v += __shfl_xor(v, o);
    return v;
}
DI float fast_exp2(float x) { return __builtin_amdgcn_exp2f(x); }
DI float fast_rcp(float x) { return __builtin_amdgcn_rcpf(x); }
DI float sigmoidf_(float x) { return fast_rcp(1.f + fast_exp2(-x * LOG2E)); }
DI float gelu_tanh(float x) {
    const float u = 0.7978845608028654f * (x + 0.044715f * x * x * x);
    return x * sigmoidf_(2.f * u);
}
#define LDS_WAIT() asm volatile("s_waitcnt lgkmcnt(0)" ::: "memory")
#define MFMA32(a, b, c) __builtin_amdgcn_mfma_f32_32x32x16_bf16((a), (b), (c), 0, 0, 0)
#define MFMA16(a, b, c) __builtin_amdgcn_mfma_f32_16x16x32_bf16((a), (b), (c), 0, 0, 0)
DI int crow(int r, int hi) { return (r & 3) + 8 * (r >> 2) + 4 * hi; }

namespace pg8 {
constexpr int BM = 256, BK = 64, HALF = 128, HTB = HALF * BK * 2, STAGE_BYTES = 8 * HTB, NXCD = 8, WGM = 8;
__host__ __device__ __forceinline__ int lds_byte(int r, int c) { const int st = (r >> 4) * 2 + (c >> 5), rr = r & 15, cc = c & 31, ob = rr * 64 + cc * 2; return st * 1024 + (ob ^ (((ob >> 9) & 1) << 5)); }
__host__ __device__ __forceinline__ void stage_rc(int b, int& R, int& C) { const int st = b / 1024, sb = b % 1024, swz = sb ^ (((sb >> 9) & 1) << 5); R = (st >> 1) * 16 + swz / 64; C = (st & 1) * 32 + (swz % 64) / 2; }
__host__ __device__ __forceinline__ int perm32(int rho) { const int n = rho >> 4, i = rho & 15; return 8 * (i >> 2) + 4 * n + (i & 3); }
struct Unit { int pm, pn; };
template <bool I8> __device__ __forceinline__ f32x4 mma1(const bf16x8 b, const bf16x8 a, const f32x4 c) {
    if constexpr (I8) return __builtin_bit_cast(f32x4, __builtin_amdgcn_mfma_i32_16x16x64_i8(__builtin_bit_cast(i32x4, b), __builtin_bit_cast(i32x4, a), __builtin_bit_cast(i32x4, c), 0, 0, 0));
    else return __builtin_amdgcn_mfma_f32_16x16x32_bf16(b, a, c, 0, 0, 0); }
struct Gemm { const bf16_t* A; const bf16_t* Bt; int M, N, K; };
struct StaticOrder {
    int nM, nN, nwg, G, c;
    __host__ __device__ void init(int M_, int N_, int G_, int c_) { nM = M_ / BM; nN = N_ / BM; nwg = nM * nN; G = G_; c = c_; }
    __host__ __device__ bool next(int i, Unit& u) const {
        const long L = (long)i * G + c; if (L >= nwg) return false;
        int wgid = (int)L; { const int q = nwg / NXCD, r = nwg % NXCD, xcd = wgid % NXCD, off = wgid / NXCD; wgid = (xcd < r ? xcd * (q + 1) : r * (q + 1) + (xcd - r) * q) + off; }
        const int nig = WGM * nN, gid = wgid / nig, fm = gid * WGM, gsz = (nM - fm) < WGM ? (nM - fm) : WGM;
        u.pm = fm + ((wgid % nig) % gsz); u.pn = (wgid % nig) / gsz; return true;
    }
    __device__ __forceinline__ void a_ready(const Unit&) const {}
    __device__ __forceinline__ void done(const Unit&) const {}
};
struct EpiBf16 {
    static constexpr bool PERM = true, AFTER_DRAIN = false;
    bf16_t* O; int ldc;
    const float* lbp;
    const float* sa; const float* sw;
    __device__ __forceinline__ void operator()(const f32x4 (&acc)[2][2][4][2], const Unit& u, int wr, int wc, int fr, int fq) const {
        const int row0 = u.pm * BM + wr * 64 + fr; const int col0 = u.pn * BM + wc * 32 + 8 * fq;
        const bool fg = lbp && (unsigned)(u.pn - 4) < 4u;
        float sav[8]; f32x4 swv[2][2], lbv[2][2];
#pragma unroll
        for (int i = 0; i < 8; ++i) sav[i] = sa[row0 + (i >> 2) * HALF + (i & 3) * 16];
#pragma unroll
        for (int bj = 0; bj < 2; ++bj) { swv[bj][0] = *(const f32x4*)(sw + col0 + bj * HALF); swv[bj][1] = *(const f32x4*)(sw + col0 + bj * HALF + 4);
            lbv[bj][0] = fg ? *(const f32x4*)(lbp + col0 + bj * HALF - 1024) : (f32x4){0.f, 0.f, 0.f, 0.f}; lbv[bj][1] = fg ? *(const f32x4*)(lbp + col0 + bj * HALF - 1020) : (f32x4){0.f, 0.f, 0.f, 0.f}; }
#pragma unroll
        for (int ai = 0; ai < 2; ++ai)
#pragma unroll
            for (int m = 0; m < 4; ++m) { const int row = row0 + ai * HALF + m * 16; bf16_t* rowp = O + (size_t)row * ldc + col0; const float sc = sav[ai * 4 + m];
#pragma unroll
                for (int bj = 0; bj < 2; ++bj) {
                    f32x4 v0 = __builtin_convertvector(__builtin_bit_cast(i32x4, acc[ai][bj][m][0]), f32x4) * (swv[bj][0] * sc), v1 = __builtin_convertvector(__builtin_bit_cast(i32x4, acc[ai][bj][m][1]), f32x4) * (swv[bj][1] * sc);
                    if (fg) {
#pragma unroll
                        for (int i = 0; i < 4; ++i) { v0[i] = (1.f - lbv[bj][0][i]) * __builtin_amdgcn_rcpf(1.f + __builtin_amdgcn_exp2f(v0[i] * 1.4426950408889634f));
                                                      v1[i] = (1.f - lbv[bj][1][i]) * __builtin_amdgcn_rcpf(1.f + __builtin_amdgcn_exp2f(v1[i] * 1.4426950408889634f)); } }
                    u32x4 w; w.x = pk2(v0[0], v0[1]); w.y = pk2(v0[2], v0[3]); w.z = pk2(v1[0], v1[1]); w.w = pk2(v1[2], v1[3]);
                    *(u32x4*)(rowp + bj * HALF) = w; } }
    }
};
struct EpiH {
    static constexpr bool PERM = false, AFTER_DRAIN = false;
    const float* x; float* out; const float* sa; const float* sw; LAS unsigned char* scr;
    __device__ __forceinline__ void operator()(const f32x4 (&acc)[2][2][4][2], const Unit& u, int wr, int wc, int fr, int fq) const {
        const int lane = fr + 16 * fq, wid = wr * 4 + wc;
        LAS unsigned char* t = scr + wid * 2048;
        const int rr = lane >> 3, c4 = lane & 7;
        const int colb = u.pn * BM + wc * 32 + 4 * c4;
        const f32x4 swv[2] = {*(const f32x4*)(sw + colb), *(const f32x4*)(sw + colb + HALF)};
        f32x4 xv[4][2][2]; float sv[4][2];
        auto rowof = [&](int g) { return u.pm * BM + (g >> 2) * HALF + wr * 64 + (g & 3) * 16 + rr; };
#pragma unroll
        for (int g = 0; g < 4; ++g) { const int row = rowof(g); sv[g][0] = sa[row]; sv[g][1] = sa[row + 8];
#pragma unroll
            for (int bj = 0; bj < 2; ++bj)
#pragma unroll
                for (int k = 0; k < 2; ++k) xv[g][bj][k] = *(const f32x4*)(x + (size_t)(row + 8 * k) * DM + colb + bj * HALF); }
#pragma unroll
        for (int g = 0; g < 8; ++g) { const int ai = g >> 2, m = g & 3, sl = g & 3; const int row = rowof(g);
            f32x4 xc[2][2]; const float sc[2] = {sv[sl][0], sv[sl][1]};
#pragma unroll
            for (int bj = 0; bj < 2; ++bj)
#pragma unroll
                for (int k = 0; k < 2; ++k) xc[bj][k] = xv[sl][bj][k];
            if (g + 4 < 8) { const int rn = rowof(g + 4); sv[sl][0] = sa[rn]; sv[sl][1] = sa[rn + 8];
#pragma unroll
                for (int bj = 0; bj < 2; ++bj)
#pragma unroll
                    for (int k = 0; k < 2; ++k) xv[sl][bj][k] = *(const f32x4*)(x + (size_t)(rn + 8 * k) * DM + colb + bj * HALF); }
#pragma unroll
            for (int bj = 0; bj < 2; ++bj) {
                *(LAS f32x4*)(t + fr * 128 + (4 * fq) * 4) = acc[ai][bj][m][0]; *(LAS f32x4*)(t + fr * 128 + (16 + 4 * fq) * 4) = acc[ai][bj][m][1];
                asm volatile("s_waitcnt lgkmcnt(0)" ::: "memory");
#pragma unroll
                for (int k = 0; k < 2; ++k) { const f32x4 v = __builtin_convertvector(*(const LAS i32x4*)(t + (rr + 8 * k) * 128 + c4 * 16), f32x4) * (swv[bj] * sc[k]) + xc[bj][k];
                    *(f32x4*)(out + (size_t)(row + 8 * k) * DM + colb + bj * HALF) = v; }
                asm volatile("s_waitcnt lgkmcnt(0)" ::: "memory");
            }
        }
    }
};

template <class Epi, class Sched, bool ALIGN_EPI = false, bool SP2 = false, bool I8 = false>
__device__ __forceinline__ void gemm_phase(LAS unsigned char* lds, const Gemm g, const Sched& S, const Epi& E) {
    const int tid = threadIdx.x, wid = __builtin_amdgcn_readfirstlane(tid >> 6), lane = tid & 63, wr = wid >> 2, wc = wid & 3, fr = lane & 15, fq = lane >> 4;
    const int K = g.K, nt = K / BK;
    unsigned voffA[2], voffB[2];
#pragma unroll
    for (int i = 0; i < 2; ++i) { int R, C; stage_rc(tid * 16 + i * 8192, R, C); const int Rb = Epi::PERM ? ((R & ~31) + perm32(R & 31)) : R;
        voffA[i] = (unsigned)(R * K + C) * 2u; voffB[i] = (unsigned)(Rb * K + C) * 2u; }
    const size_t kstep = (size_t)(BK * 2);
    const size_t hstep = (size_t)HALF * K * 2;
    const size_t tstep = 2 * hstep;
    const unsigned ldsw = (unsigned)wid * 1024u;
    const int aoff = lds_byte(wr * 64 + fr, fq * 8), boff = lds_byte(wc * 32 + fr, fq * 8);
#define PG8_SA(b, h) (((b) * 2 + (h)) * HTB)
#define PG8_SB(b, h) ((4 + (b) * 2 + (h)) * HTB)
#define PG8_STAGE(bufoff, gbase, voff) do { _Pragma("unroll") for (int _i = 0; _i < 2; ++_i) \
        __builtin_amdgcn_global_load_lds((const unsigned*)((const char*)(gbase) + (voff)[_i]), (LAS unsigned*)(lds + (bufoff) + ldsw + _i * 8192), 16, 0, 0); } while (0)
#define PG8_LDA(dst, b, h) do { _Pragma("unroll") for (int m = 0; m < 4; ++m) _Pragma("unroll") for (int k = 0; k < 2; ++k) dst[m][k] = *(const LAS bf16x8*)(lds + PG8_SA(b, h) + aoff + m * 2048 + k * 1024); } while (0)
#define PG8_LDB(dst, b, h) do { _Pragma("unroll") for (int n = 0; n < 2; ++n) _Pragma("unroll") for (int k = 0; k < 2; ++k) dst[n][k] = *(const LAS bf16x8*)(lds + PG8_SB(b, h) + boff + n * 2048 + k * 1024); } while (0)
#define PG8_MMA(ai, bj, At, Bt) do { __builtin_amdgcn_s_setprio(1); _Pragma("unroll") for (int m = 0; m < 4; ++m) _Pragma("unroll") for (int n = 0; n < 2; ++n) _Pragma("unroll") for (int k = 0; k < 2; ++k) \
        acc[ai][bj][m][n] = mma1<I8>(Bt[n][k], At[m][k], acc[ai][bj][m][n]); __builtin_amdgcn_s_setprio(0); } while (0)
#define PG8_WAIT_V(n) asm volatile("s_waitcnt vmcnt(" #n ")" ::: "memory")
#define PG8_WAIT_L(n) asm volatile("s_waitcnt lgkmcnt(" #n ")" ::: "memory")
#define PG8_BAR __builtin_amdgcn_s_barrier()
#define PG8_SCHED __builtin_amdgcn_sched_barrier(0)
    Unit cur, nxt; int ui = 0;
    if (!S.next(0, cur)) return;
    f32x4 acc[2][2][4][2];
#pragma unroll
    for (int a = 0; a < 2; ++a)
#pragma unroll
        for (int b = 0; b < 2; ++b)
#pragma unroll
            for (int m = 0; m < 4; ++m)
#pragma unroll
                for (int n = 0; n < 2; ++n) acc[a][b][m][n] = (f32x4){0.f, 0.f, 0.f, 0.f};
    bf16x8 At[4][2], B0[2][2], B1[2][2];
    const char* cA = (const char*)g.A + (size_t)cur.pm * tstep; const char* cB = (const char*)g.Bt + (size_t)cur.pn * tstep;
    S.a_ready(cur);
    if constexpr (SP2) {
        PG8_STAGE(PG8_SB(0, 0), cB, voffB); PG8_STAGE(PG8_SB(0, 1), cB + hstep, voffB); PG8_STAGE(PG8_SA(0, 0), cA, voffA); PG8_STAGE(PG8_SA(0, 1), cA + hstep, voffA);
        if (wr == 1) PG8_BAR;
        PG8_WAIT_V(2); PG8_BAR;
        PG8_STAGE(PG8_SB(1, 0), cB + kstep, voffB); PG8_STAGE(PG8_SA(1, 0), cA + kstep, voffA); PG8_STAGE(PG8_SB(1, 1), cB + hstep + kstep, voffB);
        PG8_WAIT_V(6); PG8_BAR;
    } else {
        PG8_STAGE(PG8_SB(0, 0), cB, voffB); PG8_STAGE(PG8_SA(0, 0), cA, voffA); PG8_STAGE(PG8_SB(0, 1), cB + hstep, voffB); PG8_STAGE(PG8_SA(0, 1), cA + hstep, voffA);
        if (wr == 1) PG8_BAR;
        PG8_WAIT_V(4); PG8_BAR;
        PG8_STAGE(PG8_SB(1, 0), cB + kstep, voffB); PG8_STAGE(PG8_SA(1, 0), cA + kstep, voffA); PG8_STAGE(PG8_SB(1, 1), cB + hstep + kstep, voffB);
        PG8_WAIT_V(6); PG8_BAR;
    }
    for (;;) {
        const bool has_next = S.next(ui + 1, nxt);
        const char* nA = has_next ? (const char*)g.A + (size_t)nxt.pm * tstep : cA; const char* nB = has_next ? (const char*)g.Bt + (size_t)nxt.pn * tstep : cB;
        for (int t = 0; t < nt; t += 2) {
            const bool last = (t == nt - 2);
            const char* a1 = cA + (size_t)(t + 1) * kstep;
            const char* a2 = last ? nA : cA + (size_t)(t + 2) * kstep; const char* b2 = last ? nB : cB + (size_t)(t + 2) * kstep;
            const char* a3 = a2 + kstep; const char* b3 = b2 + kstep;
            if (last && has_next) S.a_ready(nxt);
            if constexpr (SP2) {
            PG8_LDB(B0, 0, 0); PG8_LDB(B1, 0, 1); PG8_SCHED; PG8_LDA(At, 0, 0); PG8_STAGE(PG8_SA(1, 1), a1 + hstep, voffA);
            PG8_WAIT_V(8); PG8_WAIT_L(0); PG8_BAR; PG8_MMA(0, 0, At, B0); PG8_MMA(0, 1, At, B1); PG8_BAR; PG8_SCHED;
            PG8_LDA(At, 0, 1); PG8_STAGE(PG8_SB(0, 0), b2, voffB); PG8_STAGE(PG8_SB(0, 1), b2 + hstep, voffB); PG8_STAGE(PG8_SA(0, 0), a2, voffA);
            PG8_WAIT_V(8); PG8_WAIT_L(0); PG8_BAR; PG8_MMA(1, 0, At, B0); PG8_MMA(1, 1, At, B1); PG8_BAR; PG8_SCHED;
            PG8_LDB(B0, 1, 0); PG8_LDB(B1, 1, 1); PG8_SCHED; PG8_LDA(At, 1, 0); PG8_STAGE(PG8_SA(0, 1), a2 + hstep, voffA);
            PG8_WAIT_V(8); PG8_WAIT_L(0); PG8_BAR; PG8_MMA(0, 0, At, B0); PG8_MMA(0, 1, At, B1); PG8_BAR; PG8_SCHED;
            PG8_LDA(At, 1, 1); PG8_STAGE(PG8_SB(1, 0), b3, voffB); PG8_STAGE(PG8_SB(1, 1), b3 + hstep, voffB); PG8_STAGE(PG8_SA(1, 0), a3, voffA);
            PG8_WAIT_V(8); PG8_WAIT_L(0); PG8_BAR; PG8_MMA(1, 0, At, B0); PG8_MMA(1, 1, At, B1); PG8_BAR; PG8_SCHED;
            } else {
            PG8_LDB(B0, 0, 0); PG8_SCHED; PG8_LDA(At, 0, 0); PG8_STAGE(PG8_SA(1, 1), a1 + hstep, voffA);
            PG8_WAIT_L(8); PG8_BAR; PG8_WAIT_L(0); PG8_MMA(0, 0, At, B0); PG8_BAR; PG8_SCHED;
            PG8_LDB(B1, 0, 1); PG8_STAGE(PG8_SB(0, 0), b2, voffB);
            PG8_BAR; PG8_WAIT_L(0); PG8_MMA(0, 1, At, B1); PG8_BAR;
            PG8_LDA(At, 0, 1); PG8_STAGE(PG8_SA(0, 0), a2, voffA);
            PG8_BAR; PG8_WAIT_L(0); PG8_MMA(1, 0, At, B0); PG8_BAR; PG8_SCHED;
            PG8_STAGE(PG8_SB(0, 1), b2 + hstep, voffB);
            PG8_WAIT_V(6); PG8_BAR; PG8_MMA(1, 1, At, B1); PG8_BAR;
            PG8_LDB(B0, 1, 0); PG8_SCHED; PG8_LDA(At, 1, 0); PG8_STAGE(PG8_SA(0, 1), a2 + hstep, voffA);
            PG8_WAIT_L(8); PG8_BAR; PG8_WAIT_L(0); PG8_MMA(0, 0, At, B0); PG8_BAR; PG8_SCHED;
            PG8_LDB(B1, 1, 1); PG8_STAGE(PG8_SB(1, 0), b3, voffB);
            PG8_BAR; PG8_WAIT_L(0); PG8_MMA(0, 1, At, B1); PG8_BAR;
            PG8_LDA(At, 1, 1); PG8_STAGE(PG8_SA(1, 0), a3, voffA);
            PG8_BAR; PG8_WAIT_L(0); PG8_MMA(1, 0, At, B0); PG8_BAR; PG8_SCHED;
            PG8_STAGE(PG8_SB(1, 1), b3 + hstep, voffB);
            PG8_WAIT_V(6); PG8_BAR; PG8_MMA(1, 1, At, B1); PG8_BAR;
            }
        }
        if constexpr (ALIGN_EPI) { if (wr == 0) PG8_BAR; }
        if constexpr (!Epi::AFTER_DRAIN) { E(acc, cur, wr, wc, fr, fq); S.done(cur); }
        if (!has_next) break;
#pragma unroll
        for (int a = 0; a < 2; ++a)
#pragma unroll
            for (int b = 0; b < 2; ++b)
#pragma unroll
                for (int m = 0; m < 4; ++m)
#pragma unroll
                    for (int n = 0; n < 2; ++n) acc[a][b][m][n] = (f32x4){0.f, 0.f, 0.f, 0.f};
        cur = nxt; cA = nA; cB = nB; ++ui;
        if constexpr (ALIGN_EPI) { if (wr == 1) PG8_BAR; }
    }
    PG8_WAIT_V(0);
    if constexpr (!ALIGN_EPI) { if (wr == 0) PG8_BAR; }
    PG8_BAR;
#undef PG8_SA
#undef PG8_SB
#undef PG8_STAGE
#undef PG8_LDA
#undef PG8_LDB
#undef PG8_MMA
#undef PG8_WAIT_V
#undef PG8_WAIT_L
#undef PG8_BAR
#undef PG8_SCHED
}
}

struct Args {
    const float* in[21];
    float* out; unsigned char* ws;
    int ph_lo, ph_hi;
};
enum { I_X = 0, I_N1W, I_WIN, I_LB, I_HGNW, I_QNW, I_KCNW, I_KSNW, I_KWNW, I_POSK, I_POSV, I_WCK1, I_WCK2, I_WCV1, I_WCV2, I_WOUT, I_N2W, I_WQ, I_SK, I_PU, I_PV };

constexpr float Q8_MAGIC = 12582912.f;
DI unsigned pack_q8(float t0, float t1, float t2, float t3) {
    const unsigned lo = __builtin_amdgcn_perm(__builtin_bit_cast(unsigned, t1), __builtin_bit_cast(unsigned, t0), 0x0c0c0400u);
    const unsigned hi = __builtin_amdgcn_perm(__builtin_bit_cast(unsigned, t3), __builtin_bit_cast(unsigned, t2), 0x04000c0cu);
    return lo | hi; }
DI void transpose_item(const float* W, int K, int N, int Npad, bf16_t* WT, LAS float* scr, int item, int lane, const float* kscale) {
    const int nblk = Npad / 32, kb = item / nblk, nb = item % nblk, k0 = 64 * kb, n0 = 32 * nb;
    const int n = n0 + 4 * (lane & 7);
    f32x4 v[8];
#pragma unroll
    for (int i = 0; i < 8; ++i) { const int kk = 8 * i + (lane >> 3); v[i] = (n < N) ? *(const f32x4*)(W + (size_t)(k0 + kk) * N + n) : (f32x4){0.f, 0.f, 0.f, 0.f}; }
#pragma unroll
    for (int i = 0; i < 8; ++i) { const int kk = 8 * i + (lane >> 3); f32x4 y = v[i]; if (kscale) y = y * kscale[k0 + kk];
        LAS float* d = scr + kk * 33 + 4 * (lane & 7); d[0] = y[0]; d[1] = y[1]; d[2] = y[2]; d[3] = y[3]; }
    LDS_WAIT(); asm volatile("" ::: "memory");
    const int c = lane & 7;
#pragma unroll
    for (int j = 0; j < 4; ++j) { const int nn = (lane >> 3) + 8 * j; const LAS float* s = scr + (8 * c) * 33 + nn;
        u32x4 o; o.x = pk2(s[0 * 33], s[1 * 33]); o.y = pk2(s[2 * 33], s[3 * 33]); o.z = pk2(s[4 * 33], s[5 * 33]); o.w = pk2(s[6 * 33], s[7 * 33]);
        *(u32x4*)(WT + (size_t)(n0 + nn) * K + k0 + 8 * c) = o; }
    LDS_WAIT(); asm volatile("" ::: "memory");
}

DI void coltile_q8_item(const float* W, int N, unsigned char* WT, float* wscale, LAS unsigned char* lds, int tile, int tid) {
    const int cq = tid & 3, rg = tid >> 2, n0 = 16 * tile + 4 * cq, wv = tid >> 6;
    f32x4 v[16];
#pragma unroll
    for (int i = 0; i < 16; ++i) v[i] = (n0 < N) ? *(const f32x4*)(W + (size_t)(16 * rg + i) * N + n0) : (f32x4){0.f, 0.f, 0.f, 0.f};
    f32x4 m = (f32x4){0.f, 0.f, 0.f, 0.f};
#pragma unroll
    for (int i = 0; i < 16; ++i) { m[0] = fmaxf(m[0], fabsf(v[i][0])); m[1] = fmaxf(m[1], fabsf(v[i][1])); m[2] = fmaxf(m[2], fabsf(v[i][2])); m[3] = fmaxf(m[3], fabsf(v[i][3])); }
#pragma unroll
    for (int o = 4; o < 64; o <<= 1) { m[0] = fmaxf(m[0], __shfl_xor(m[0], o)); m[1] = fmaxf(m[1], __shfl_xor(m[1], o)); m[2] = fmaxf(m[2], __shfl_xor(m[2], o)); m[3] = fmaxf(m[3], __shfl_xor(m[3], o)); }
    LAS f32x4* wm = (LAS f32x4*)(lds + 131072 + 1024);
    __syncthreads();
    if ((tid & 63) < 4) wm[wv * 4 + cq] = m;
    __syncthreads();
#pragma unroll
    for (int w = 0; w < 8; ++w) { const f32x4 t = wm[w * 4 + cq]; m[0] = fmaxf(m[0], t[0]); m[1] = fmaxf(m[1], t[1]); m[2] = fmaxf(m[2], t[2]); m[3] = fmaxf(m[3], t[3]); }
    if (rg == 0) *(f32x4*)(wscale + n0) = m * (1.f / 127.f);
#pragma unroll
    for (int c = 0; c < 4; ++c) { const float qs = m[c] > 0.f ? 127.f / m[c] : 0.f; u32x4 o;
#pragma unroll
        for (int q = 0; q < 4; ++q) o[q] = pack_q8(fmaf(v[4 * q][c], qs, Q8_MAGIC), fmaf(v[4 * q + 1][c], qs, Q8_MAGIC), fmaf(v[4 * q + 2][c], qs, Q8_MAGIC), fmaf(v[4 * q + 3][c], qs, Q8_MAGIC));
        *(u32x4*)(WT + (size_t)(n0 + c) * 2048 + 16 * rg) = o; }
}
DI void peer_conv_rows(const Args& a, int tsel, int rp0, int nrp, int lane) {
    const float* src = a.in[tsel ? I_PV : I_PU]; unsigned char* dst = a.ws + (tsel ? WS_VB : WS_UB); float* isc = (float*)(dst + TAB_SCALE_OFF);
    f32x4 v[2][8], nx[2][8];
#pragma unroll
    for (int rr = 0; rr < 2; ++rr)
#pragma unroll
        for (int q = 0; q < 8; ++q) nx[rr][q] = *(const f32x4*)(src + (size_t)(2 * rp0 + rr) * DM + 256 * q + 4 * lane);
#pragma unroll 1
    for (int k = 0; k < nrp; ++k) {
#pragma unroll
        for (int rr = 0; rr < 2; ++rr)
#pragma unroll
            for (int q = 0; q < 8; ++q) v[rr][q] = nx[rr][q];
        if (k + 1 < nrp) {
#pragma unroll
            for (int rr = 0; rr < 2; ++rr)
#pragma unroll
                for (int q = 0; q < 8; ++q) nx[rr][q] = *(const f32x4*)(src + (size_t)(2 * (rp0 + k + 1) + rr) * DM + 256 * q + 4 * lane);
        }
#pragma unroll
        for (int rr = 0; rr < 2; ++rr) { const int row = 2 * (rp0 + k) + rr; float mx = 0.f;
#pragma unroll
            for (int q = 0; q < 8; ++q) mx = fmaxf(mx, fmaxf(fmaxf(fabsf(v[rr][q][0]), fabsf(v[rr][q][1])), fmaxf(fabsf(v[rr][q][2]), fabsf(v[rr][q][3]))));
#pragma unroll
            for (int o = 1; o < 64; o <<= 1) mx = fmaxf(mx, __shfl_xor(mx, o));
            const float top = tsel ? 448.f : 127.f;
            const float sc = (mx > 0.f) ? top / mx : 1.f;
            if (lane == 0) isc[row] = (mx > 0.f) ? mx / top : 1.f;
#pragma unroll
            for (int q = 0; q < 8; ++q) { const f32x4 y = v[rr][q] * sc; int pk;
                if (tsel) { pk = __builtin_amdgcn_cvt_pk_fp8_f32(y[0], y[1], 0, false); pk = __builtin_amdgcn_cvt_pk_fp8_f32(y[2], y[3], pk, true); }
                else pk = (int)pack_q8(y[0] + Q8_MAGIC, y[1] + Q8_MAGIC, y[2] + Q8_MAGIC, y[3] + Q8_MAGIC);
                *(unsigned*)(dst + (size_t)(2 * q + (lane >> 5)) * (16384 * 128) + (size_t)row * 128 + 4 * (lane & 31)) = (unsigned)pk; } }
    }
}
DI void sk_conv_item(const Args& a, int it, int lane) {
    const float* sk = a.in[I_SK]; bf16_t* skb = (bf16_t*)(a.ws + SM_SK); const size_t e = (size_t)it * 512 + lane * 8;
    const f32x4 v0 = *(const f32x4*)(sk + e), v1 = *(const f32x4*)(sk + e + 4);
    u32x4 w; w.x = pk2(v0[0], v0[1]); w.y = pk2(v0[2], v0[3]); w.z = pk2(v1[0], v1[1]); w.w = pk2(v1[2], v1[3]);
    *(u32x4*)(skb + e) = w;
}
constexpr int FILL_RP = 4;
#ifndef FILL_SPLIT
#define FILL_SPLIT 0
#endif
constexpr int FILL_PU = 0, FILL_PV = 8192 / (8 * FILL_RP), FILL_WOUT = 2 * FILL_PV, FILL_WQ = FILL_WOUT + DM / 16, FILL_SK = FILL_WQ + DM / 16, FILL_END = FILL_SK + 64;
DI void filler_item(const Args& a, LAS unsigned char* lds, int fi, int lane, int wave) {
    LAS float* scr = (LAS float*)(lds + wave * 8704);
    if (fi < FILL_PV) peer_conv_rows(a, 0, (fi * 8 + wave) * FILL_RP, FILL_RP, lane);
    else if (fi < FILL_WOUT) peer_conv_rows(a, 1, ((fi - FILL_PV) * 8 + wave) * FILL_RP, FILL_RP, lane);
    else if (fi < FILL_WQ) coltile_q8_item(a.in[I_WOUT], DM, a.ws + WS_WOUT, (float*)(a.ws + SM_SWO), lds, fi - FILL_WOUT, wave * 64 + lane);
    else if (fi < FILL_SK) coltile_q8_item(a.in[I_WQ], DM, a.ws + WS_WQ, (float*)(a.ws + SM_SWQ), lds, fi - FILL_WQ, wave * 64 + lane);
    else sk_conv_item(a, (fi - FILL_SK) * 8 + wave, lane);
}
DI void phase_prep(const Args& a, LAS unsigned char* lds, int gw, int NGW, int lane, int wave) {
    unsigned char* ws = a.ws;
    LAS float* scr = (LAS float*)(lds + wave * 8704);
    constexpr int I_IN = (DM / 64) * (NP / 32), I_C1 = (2048 / 64) * (256 / 32), I_C2 = (256 / 64) * (64 / 32);
    constexpr int NITEMS = I_IN + 2 * I_C1 + 2 * I_C2;
    for (int it = gw + I_IN; it < NITEMS; it += NGW) {
        int r = it;
        if (r < I_IN) { continue; } r -= I_IN;
        if (r < I_C1) { transpose_item(a.in[I_WCK1], 2048, 256, 256, (bf16_t*)(ws + SM_W1K), scr, r, lane, nullptr); continue; } r -= I_C1;
        if (r < I_C1) { transpose_item(a.in[I_WCV1], 2048, 256, 256, (bf16_t*)(ws + SM_W1V), scr, r, lane, nullptr); continue; } r -= I_C1;
        if (r < I_C2) { transpose_item(a.in[I_WCK2], 256, 64, 64, (bf16_t*)(ws + SM_W2K), scr, r, lane, nullptr); continue; } r -= I_C2;
        transpose_item(a.in[I_WCV2], 256, 64, 64, (bf16_t*)(ws + SM_W2V), scr, r, lane, nullptr);
    }
    {
        const float* x = a.in[I_X]; const float* w1 = a.in[I_N1W]; unsigned char* XN = ws + WS_XN; float* sxa = (float*)(ws + WS_XN + 32 * MiB);
        f32x4 wv[8];
#pragma unroll
        for (int j = 0; j < 8; ++j) wv[j] = *(const f32x4*)(w1 + 4 * lane + 256 * j);
        for (int m2 = gw; m2 < M / 2; m2 += NGW) {
            f32x4 v[2][8];
#pragma unroll
            for (int rr = 0; rr < 2; ++rr)
#pragma unroll
                for (int j = 0; j < 8; ++j) v[rr][j] = ((const f32x4*)(x + (size_t)(2 * m2 + rr) * DM) + lane)[64 * j];
#pragma unroll
            for (int rr = 0; rr < 2; ++rr) { float s = 0.f;
#pragma unroll
                for (int j = 0; j < 8; ++j) s += (v[rr][j][0] * v[rr][j][0] + v[rr][j][1] * v[rr][j][1]) + (v[rr][j][2] * v[rr][j][2] + v[rr][j][3] * v[rr][j][3]);
                const float rstd = __builtin_amdgcn_rsqf(wave_sum(s) * (1.f / DM) + EPS);
                f32x4 y[8]; float am = 0.f;
#pragma unroll
                for (int j = 0; j < 8; ++j) { y[j] = v[rr][j] * rstd * wv[j]; am = fmaxf(am, fmaxf(fmaxf(fabsf(y[j][0]), fabsf(y[j][1])), fmaxf(fabsf(y[j][2]), fabsf(y[j][3])))); }
#pragma unroll
                for (int o = 1; o < 64; o <<= 1) am = fmaxf(am, __shfl_xor(am, o));
                const float qs = am > 0.f ? 127.f / am : 0.f;
                if (lane == 0) sxa[2 * m2 + rr] = am * (1.f / 127.f);
                unsigned* o4 = (unsigned*)(XN + (size_t)(2 * m2 + rr) * DM) + lane;
#pragma unroll
                for (int j = 0; j < 8; ++j) o4[64 * j] = pack_q8(fmaf(y[j][0], qs, Q8_MAGIC), fmaf(y[j][1], qs, Q8_MAGIC), fmaf(y[j][2], qs, Q8_MAGIC), fmaf(y[j][3], qs, Q8_MAGIC)); }
        }
    }
    {
        const int tid = threadIdx.x, blk = blockIdx.x;
        if (blk == 0) { for (int c = tid; c < 1024; c += NTHREADS) { const float l0 = a.in[I_LB][c], l1 = a.in[I_LB][1024 + c]; ((float*)(ws + SM_LB))[c] = 1.f / (1.f + __expf(l1 - l0)); } }
        if (blk >= 1 && blk <= 32) { const int part = blk - 1, mat = tid >> 8, j = tid & 255;
            const float* w1 = a.in[mat ? I_WCV1 : I_WCK1]; const float* pos = a.in[mat ? I_POSV : I_POSK]; float acc = 0.f;
            for (int i = part * 64; i < part * 64 + 64; ++i) acc += pos[i] * w1[(size_t)i * 256 + j];
            ((float*)(ws + SM_BIASP))[part * 512 + tid] = acc; }
    }
}

DI void rowquant_mix(const Args& a, int gw, int NGW, int lane) {
    const bf16_t* MIX = (const bf16_t*)(a.ws + WS_XN); unsigned char* A8 = a.ws + WS_MIX8; float* rs = (float*)(a.ws + WS_MIX8 + 32 * MiB);
    for (int row = gw; row < M; row += NGW) {
        u32x4 v[4]; float am = 0.f;
#pragma unroll
        for (int j = 0; j < 4; ++j) v[j] = ((const u32x4*)(MIX + (size_t)row * DM) + lane)[64 * j];
#pragma unroll
        for (int j = 0; j < 4; ++j)
#pragma unroll
            for (int i = 0; i < 4; ++i) am = fmaxf(am, fmaxf(fabsf(bflo(v[j][i])), fabsf(bfhi(v[j][i]))));
#pragma unroll
        for (int o = 1; o < 64; o <<= 1) am = fmaxf(am, __shfl_xor(am, o));
        const float qs = am > 0.f ? 127.f / am : 0.f;
        if (lane == 0) rs[row] = am * (1.f / 127.f);
        u32x2* o2 = (u32x2*)(A8 + (size_t)row * DM) + lane;
#pragma unroll
        for (int j = 0; j < 4; ++j) { u32x2 w;
            w.x = pack_q8(fmaf(bflo(v[j][0]), qs, Q8_MAGIC), fmaf(bfhi(v[j][0]), qs, Q8_MAGIC), fmaf(bflo(v[j][1]), qs, Q8_MAGIC), fmaf(bfhi(v[j][1]), qs, Q8_MAGIC));
            w.y = pack_q8(fmaf(bflo(v[j][2]), qs, Q8_MAGIC), fmaf(bfhi(v[j][2]), qs, Q8_MAGIC), fmaf(bflo(v[j][3]), qs, Q8_MAGIC), fmaf(bfhi(v[j][3]), qs, Q8_MAGIC));
            o2[64 * j] = w; }
    }
}
DI void rowquant_h(const Args& a, int gw, int NGW, int lane) {
    const float* w2 = a.in[I_N2W]; unsigned char* A8 = a.ws + WS_HQ8; float* rs = (float*)(a.ws + WS_DQ);
    f32x4 wv[8];
#pragma unroll
    for (int j = 0; j < 8; ++j) wv[j] = *(const f32x4*)(w2 + 4 * lane + 256 * j);
    for (int row = gw; row < M; row += NGW) {
        f32x4 v[8]; float s = 0.f, am = 0.f;
#pragma unroll
        for (int j = 0; j < 8; ++j) v[j] = ((const f32x4*)(a.out + (size_t)row * DM) + lane)[64 * j];
#pragma unroll
        for (int j = 0; j < 8; ++j) { s += (v[j][0] * v[j][0] + v[j][1] * v[j][1]) + (v[j][2] * v[j][2] + v[j][3] * v[j][3]); v[j] = v[j] * wv[j];
            am = fmaxf(am, fmaxf(fmaxf(fabsf(v[j][0]), fabsf(v[j][1])), fmaxf(fabsf(v[j][2]), fabsf(v[j][3])))); }
        s = wave_sum(s);
#pragma unroll
        for (int o = 1; o < 64; o <<= 1) am = fmaxf(am, __shfl_xor(am, o));
        const float qs = am > 0.f ? 127.f / am : 0.f;
        if (lane == 0) rs[row] = am * (1.f / 127.f) * __builtin_amdgcn_rsqf(s * (1.f / DM) + EPS);
        unsigned* o4 = (unsigned*)(A8 + (size_t)row * DM) + lane;
#pragma unroll
        for (int j = 0; j < 8; ++j) o4[64 * j] = pack_q8(fmaf(v[j][0], qs, Q8_MAGIC), fmaf(v[j][1], qs, Q8_MAGIC), fmaf(v[j][2], qs, Q8_MAGIC), fmaf(v[j][3], qs, Q8_MAGIC));
    }
}
DI int perm16(int t) { return (t & ~12) | ((t & 4) << 1) | ((t & 8) >> 1); }

DI void nsa_norm_row(const Args& a, int row, int lane) {
    bf16_t* pr = (bf16_t*)(a.ws + WS_P) + (size_t)row * NP;
    const int c8 = lane & 7;
    const f32x4 qw0 = *(const f32x4*)(a.in[I_QNW] + 8 * c8), qw1 = *(const f32x4*)(a.in[I_QNW] + 8 * c8 + 4);
    const float* kwp = a.in[lane < 32 ? I_KSNW : I_KWNW];
    const f32x4 kw0 = *(const f32x4*)(kwp + 8 * c8), kw1 = *(const f32x4*)(kwp + 8 * c8 + 4);
    bf16_t* p0 = pr + C_NQ + 8 * lane; bf16_t* p1 = pr + C_NQ + 512 + 8 * lane; bf16_t* p2 = pr + (lane < 32 ? C_NKS + 8 * lane : C_NKW + 8 * (lane - 32));
    const u32x4 v0 = *(const u32x4*)p0, v1 = *(const u32x4*)p1, v2 = *(const u32x4*)p2;
    auto nrm = [&](const u32x4 v, const f32x4 w0, const f32x4 w1, float extra) -> u32x4 {
        float f[8] = {bflo(v.x), bfhi(v.x), bflo(v.y), bfhi(v.y), bflo(v.z), bfhi(v.z), bflo(v.w), bfhi(v.w)};
        float s = 0.f;
#pragma unroll
        for (int i = 0; i < 8; ++i) s += f[i] * f[i];
        s += __shfl_xor(s, 1); s += __shfl_xor(s, 2); s += __shfl_xor(s, 4);
        const float r = __builtin_amdgcn_rsqf(s * (1.f / 64.f) + EPS) * extra;
        u32x4 o; o.x = pk2(f[0] * r * w0[0], f[1] * r * w0[1]); o.y = pk2(f[2] * r * w0[2], f[3] * r * w0[3]);
        o.z = pk2(f[4] * r * w1[0], f[5] * r * w1[1]); o.w = pk2(f[6] * r * w1[2], f[7] * r * w1[3]); return o; };
    *(u32x4*)p0 = nrm(v0, qw0, qw1, 0.125f * LOG2E);
    *(u32x4*)p1 = nrm(v1, qw0, qw1, 0.125f * LOG2E);
    *(u32x4*)p2 = nrm(v2, kw0, kw1, 1.f);
}

DI void vtrans_item(const Args& a, LAS unsigned char* scr, int item, int lane) {
    const int which = item >> 10, b = (item >> 7) & 7, g = (item >> 5) & 3, tt = item & 31;
    const bf16_t* src = (const bf16_t*)(a.ws + WS_P) + (size_t)(b * SEQ + 64 * tt + lane) * NP + (which ? C_NVW : C_NVS) + g * 64;
    u32x4 v[8];
#pragma unroll
    for (int j = 0; j < 8; ++j) v[j] = *(const u32x4*)(src + 8 * j);
    const int tp = perm16(lane);
#pragma unroll
    for (int j = 0; j < 8; ++j) {
        const unsigned w[4] = {v[j].x, v[j].y, v[j].z, v[j].w};
#pragma unroll
        for (int i = 0; i < 4; ++i) {
            *(LAS bf16_t*)(scr + (8 * j + 2 * i) * 144 + 2 * tp) = (bf16_t)(w[i] & 0xffffu);
            *(LAS bf16_t*)(scr + (8 * j + 2 * i + 1) * 144 + 2 * tp) = (bf16_t)(w[i] >> 16);
        }
    }
    LDS_WAIT(); asm volatile("" ::: "memory");
    bf16_t* dst = (bf16_t*)(a.ws + WS_VT) + (size_t)which * (32 * 64 * SEQ) + (size_t)((b * 4 + g) * 64 + lane) * SEQ + 64 * tt;
#pragma unroll
    for (int j = 0; j < 8; ++j) *(u32x4*)(dst + 8 * j) = *(const LAS u32x4*)(scr + lane * 144 + 16 * j);
    LDS_WAIT(); asm volatile("" ::: "memory");
}

DI void compress_item(const Args& a, LAS unsigned char* lds, int item, int tid, int lane, int wave) {
    const int kv = item >> 7, b = (item >> 4) & 7, g = (item >> 2) & 3, n0 = 32 * (item & 3);
    const int hi = lane >> 5, r32 = lane & 31;
    const bf16_t* P = (const bf16_t*)(a.ws + WS_P);
    const bf16_t* w1T = (const bf16_t*)(a.ws + (kv ? SM_W1V : SM_W1K));
    const bf16_t* w2T = (const bf16_t*)(a.ws + (kv ? SM_W2V : SM_W2K));
    int nabs = n0 + r32; if (nabs > 126) nabs = 126;
    const bf16_t* ap = P + (size_t)(b * SEQ + 16 * nabs) * NP + (kv ? C_NVC : C_NKC) + g * 64 + 8 * hi;
    const bf16_t* bp = w1T + (size_t)(32 * wave + r32) * 2048 + 8 * hi;
    f32x16 acc;
#pragma unroll
    for (int i = 0; i < 16; ++i) acc[i] = 0.f;
#pragma unroll 2
    for (int l = 0; l < 32; ++l) {
#pragma unroll
        for (int kk = 0; kk < 4; ++kk) {
            const bf16x8 av = *(const bf16x8*)(ap + (size_t)l * NP + 16 * kk);
            const bf16x8 bv = *(const bf16x8*)(bp + l * 64 + 16 * kk);
            acc = MFMA32(av, bv, acc);
        }
    }
    float bias = 0.f; { const float* bpart = (const float*)(a.ws + SM_BIASP) + kv * 256 + 32 * wave + r32;
#pragma unroll 8
        for (int p = 0; p < 32; ++p) bias += bpart[p * 512]; }
#pragma unroll
    for (int r = 0; r < 16; ++r) { const int n = crow(r, hi); *(LAS bf16_t*)(lds + (n * 264 + 32 * wave + r32) * 2) = f2bf(gelu_tanh(acc[r] + bias)); }
    __syncthreads();
    if (wave == 0) {
        f32x16 c[2];
#pragma unroll
        for (int db = 0; db < 2; ++db) {
#pragma unroll
            for (int i = 0; i < 16; ++i) c[db][i] = 0.f;
#pragma unroll
            for (int ks = 0; ks < 16; ++ks) {
                const bf16x8 av = *(const bf16x8*)(w2T + (size_t)(32 * db + r32) * 256 + 16 * ks + 8 * hi);
                const bf16x8 bv = *(const LAS bf16x8*)(lds + (r32 * 264 + 16 * ks + 8 * hi) * 2);
                c[db] = MFMA32(av, bv, c[db]);
            }
        }
        const int bg = b * 4 + g;
        if (kv == 0) {
            float ss = 0.f;
#pragma unroll
            for (int db = 0; db < 2; ++db)
#pragma unroll
                for (int r = 0; r < 16; ++r) ss += c[db][r] * c[db][r];
            ss += __shfl_xor(ss, 32);
            const float rstd = __builtin_amdgcn_rsqf(ss * (1.f / 64.f) + EPS);
            bf16_t* kc = (bf16_t*)(a.ws + SM_KC) + (size_t)(bg * 128 + n0 + r32) * 64;
#pragma unroll
            for (int db = 0; db < 2; ++db)
#pragma unroll
                for (int c4 = 0; c4 < 4; ++c4) { const int d0 = 32 * db + 8 * c4 + 4 * hi; const f32x4 w = *(const f32x4*)(a.in[I_KCNW] + d0);
                    u32x2 o; o.x = pk2(c[db][4 * c4] * rstd * w[0], c[db][4 * c4 + 1] * rstd * w[1]); o.y = pk2(c[db][4 * c4 + 2] * rstd * w[2], c[db][4 * c4 + 3] * rstd * w[3]);
                    *(u32x2*)(kc + d0) = o; }
        } else {
            bf16_t* vct = (bf16_t*)(a.ws + SM_VCT) + (size_t)bg * 64 * 128 + perm16(n0 + r32);
#pragma unroll
            for (int db = 0; db < 2; ++db)
#pragma unroll
                for (int r = 0; r < 16; ++r) vct[(size_t)(32 * db + crow(r, hi)) * 128] = f2bf(c[db][r]);
        }
    }
    __syncthreads();
}

template <int CTRL> DI float dpp_f(float v) { return __builtin_bit_cast(float, __builtin_amdgcn_update_dpp(0, __builtin_bit_cast(int, v), CTRL, 0xf, 0xf, true)); }
template <int CTRL> DI int dpp_i(int v) { return __builtin_amdgcn_update_dpp(0, v, CTRL, 0xf, 0xf, true); }
constexpr int HL_QD = 0, HL_KD = 17408, HL_KET = 34816, HL_IT = 53248, HL_AT = 71680, HL_DEC = 80896, HL_SEG = 81408, HL_SSQ = 85504, HL_G = 87552;
static_assert(HL_G + 2 * 64 * 272 <= LDS_BYTES - 64, "hgrn LDS");
struct HgRaw { unsigned f[8], q[8], i[8]; u32x4 g[2]; };
DI void hgrn_item(const Args& a, LAS unsigned char* lds, int item, int tid, int lane, int wave) {
    const int b = item >> 3, h = item & 7;
    const bf16_t* P = (const bf16_t*)(a.ws + WS_P);
    bf16_t* MIX = (bf16_t*)(a.ws + WS_XN);
    const int c2 = tid & 63, sg = tid >> 6, l15 = lane & 15, q4 = lane >> 4;
    const f32x2 lb2 = *(const f32x2*)((const float*)(a.ws + SM_LB) + h * 128 + 2 * c2);
    const float gnw = a.in[I_HGNW][16 * wave + l15];
    const __amdgpu_buffer_rsrc_t prs = __builtin_amdgcn_make_buffer_rsrc((void*)P, 0, (int)((size_t)M * NP * 2), 0x00020000);
    const int voffA = ((8 * sg) * NP + h * 128 + 2 * c2) * 2;
    const int grow = tid >> 3, gch = tid & 7;
    const int voffG = (grow * NP + C_HG + h * 128 + 16 * gch) * 2;
    auto load_raw = [&](HgRaw& R, int n) { const int soff0 = (b * SEQ + 64 * n) * NP * 2;
#pragma unroll
        for (int tt = 0; tt < 8; ++tt) { R.f[tt] = __builtin_amdgcn_raw_buffer_load_b32(prs, voffA, soff0 + tt * NP * 2 + C_HF * 2, 0);
            R.q[tt] = __builtin_amdgcn_raw_buffer_load_b32(prs, voffA, soff0 + tt * NP * 2 + C_HQ * 2, 0);
            R.i[tt] = __builtin_amdgcn_raw_buffer_load_b32(prs, voffA, soff0 + tt * NP * 2 + C_HI * 2, 0); }
        R.g[0] = __builtin_bit_cast(u32x4, __builtin_amdgcn_raw_buffer_load_b128(prs, voffG, soff0, 0)); R.g[1] = __builtin_bit_cast(u32x4, __builtin_amdgcn_raw_buffer_load_b128(prs, voffG + 16, soff0, 0)); };
    f32x4 S[8];
#pragma unroll
    for (int i = 0; i < 8; ++i) S[i] = (f32x4){0.f, 0.f, 0.f, 0.f};
    HgRaw R; load_raw(R, 0);
    for (int n = 0; n < 32; ++n) {
        const int rowbase = b * SEQ + 64 * n;
        float cum[2][8], kk[2][8], qq[2][8]; unsigned iv[8]; float run0 = 1.f, run1 = 1.f;
#pragma unroll
        for (int tt = 0; tt < 8; ++tt) {
            kk[0][tt] = bflo(R.f[tt]); kk[1][tt] = bfhi(R.f[tt]);
            run0 *= 1.f - kk[0][tt]; run1 *= 1.f - kk[1][tt]; cum[0][tt] = run0; cum[1][tt] = run1;
            qq[0][tt] = bflo(R.q[tt]); qq[1][tt] = bfhi(R.q[tt]); iv[tt] = R.i[tt];
        }
        *(LAS u32x4*)(lds + HL_G + (n & 1) * 17408 + grow * 272 + gch * 32) = R.g[0]; *(LAS u32x4*)(lds + HL_G + (n & 1) * 17408 + grow * 272 + gch * 32 + 16) = R.g[1];
        *(LAS f32x2*)(lds + HL_SEG + (sg * 128 + 2 * c2) * 4) = (f32x2){run0, run1};
        if (n + 1 < 32) load_raw(R, n + 1);
        __syncthreads();
        float off0 = 1.f, off1 = 1.f, bend0 = 1.f, bend1 = 1.f;
#pragma unroll
        for (int s2 = 0; s2 < 8; ++s2) { const f32x2 v = *(const LAS f32x2*)(lds + HL_SEG + (s2 * 128 + 2 * c2) * 4); bend0 *= v[0]; bend1 *= v[1]; if (s2 < sg) { off0 *= v[0]; off1 *= v[1]; } }
        unsigned ke0[4], ke1[4];
#pragma unroll
        for (int tt = 0; tt < 8; ++tt) {
            const float eb0 = off0 * cum[0][tt], eb1 = off1 * cum[1][tt]; const int t = 8 * sg + tt;
            const float kd0 = kk[0][tt] * fast_rcp(eb0), kd1 = kk[1][tt] * fast_rcp(eb1);
            *(LAS unsigned*)(lds + HL_QD + (t * 136 + 2 * c2) * 2) = pk2(qq[0][tt] * eb0, qq[1][tt] * eb1);
            *(LAS unsigned*)(lds + HL_KD + (t * 136 + 2 * c2) * 2) = pk2(kd0, kd1);
            const unsigned e0 = pk2(kd0 * bend0, 0.f) & 0xffffu, e1 = pk2(kd1 * bend1, 0.f) & 0xffffu;
            if (tt & 1) { ke0[tt >> 1] |= e0 << 16; ke1[tt >> 1] |= e1 << 16; } else { ke0[tt >> 1] = e0; ke1[tt >> 1] = e1; }
        }
        *(LAS u32x4*)(lds + HL_KET + ((2 * c2) * 72 + 8 * sg) * 2) = (u32x4){ke0[0], ke0[1], ke0[2], ke0[3]};
        *(LAS u32x4*)(lds + HL_KET + ((2 * c2 + 1) * 72 + 8 * sg) * 2) = (u32x4){ke1[0], ke1[1], ke1[2], ke1[3]};
        { u32x4 i0, i1;
#pragma unroll
          for (int k = 0; k < 4; ++k) { i0[k] = (iv[2 * k] & 0xffffu) | (iv[2 * k + 1] << 16); i1[k] = (iv[2 * k] >> 16) | (iv[2 * k + 1] & 0xffff0000u); }
          *(LAS u32x4*)(lds + HL_IT + ((2 * c2) * 72 + 8 * sg) * 2) = i0; *(LAS u32x4*)(lds + HL_IT + ((2 * c2 + 1) * 72 + 8 * sg) * 2) = i1; }
        if (sg == 0) *(LAS f32x2*)(lds + HL_DEC + 2 * c2 * 4) = (f32x2){bend0, bend1};
        __syncthreads();
#pragma unroll
        for (int u = 0; u < 2; ++u) {
            const int tile = 2 * wave + u, tb = tile >> 2, sb = tile & 3;
            f32x4 acc = (f32x4){0.f, 0.f, 0.f, 0.f};
            if (sb <= tb) {
#pragma unroll
                for (int ks = 0; ks < 4; ++ks) {
                    const bf16x8 av = *(const LAS bf16x8*)(lds + HL_QD + ((16 * tb + l15) * 136 + 32 * ks + 8 * q4) * 2);
                    const bf16x8 bv = *(const LAS bf16x8*)(lds + HL_KD + ((16 * sb + l15) * 136 + 32 * ks + 8 * q4) * 2);
                    acc = MFMA16(av, bv, acc);
                }
            }
#pragma unroll
            for (int r = 0; r < 4; ++r) { const int t = 16 * tb + 4 * q4 + r, s2 = 16 * sb + l15;
                *(LAS bf16_t*)(lds + HL_AT + (t * 72 + s2) * 2) = f2bf(s2 <= t ? acc[r] : 0.f); }
        }
        __syncthreads();
        f32x4 o[4];
        bf16x8 sfrag[4];
#pragma unroll
        for (int ks = 0; ks < 4; ++ks) { u32x4 w; w.x = pk2(S[2 * ks][0], S[2 * ks][1]); w.y = pk2(S[2 * ks][2], S[2 * ks][3]); w.z = pk2(S[2 * ks + 1][0], S[2 * ks + 1][1]); w.w = pk2(S[2 * ks + 1][2], S[2 * ks + 1][3]);
            sfrag[ks] = __builtin_bit_cast(bf16x8, w); }
        bf16x8 itf[2];
#pragma unroll
        for (int ks = 0; ks < 2; ++ks) itf[ks] = *(const LAS bf16x8*)(lds + HL_IT + ((16 * wave + l15) * 72 + 32 * ks + 8 * q4) * 2);
#pragma unroll
        for (int tb = 0; tb < 4; ++tb) {
            o[tb] = (f32x4){0.f, 0.f, 0.f, 0.f};
#pragma unroll
            for (int ks = 0; ks < 2; ++ks) {
                const bf16x8 av = *(const LAS bf16x8*)(lds + HL_AT + ((16 * tb + l15) * 72 + 32 * ks + 8 * q4) * 2);
                o[tb] = MFMA16(av, itf[ks], o[tb]);
            }
#pragma unroll
            for (int ks = 0; ks < 4; ++ks) {
                const u32x2 lo = *(const LAS u32x2*)(lds + HL_QD + ((16 * tb + l15) * 136 + 32 * ks + 4 * q4) * 2);
                const u32x2 hi2 = *(const LAS u32x2*)(lds + HL_QD + ((16 * tb + l15) * 136 + 32 * ks + 16 + 4 * q4) * 2);
                const bf16x8 av = __builtin_bit_cast(bf16x8, (u32x4){lo.x, lo.y, hi2.x, hi2.y});
                o[tb] = MFMA16(av, sfrag[ks], o[tb]);
            }
        }
#pragma unroll
        for (int cb = 0; cb < 8; ++cb) {
            const f32x4 d4 = *(const LAS f32x4*)(lds + HL_DEC + (16 * cb + 4 * q4) * 4);
            S[cb] = S[cb] * d4;
#pragma unroll
            for (int ks = 0; ks < 2; ++ks) {
                const bf16x8 av = *(const LAS bf16x8*)(lds + HL_KET + ((16 * cb + l15) * 72 + 32 * ks + 8 * q4) * 2);
                S[cb] = MFMA16(av, itf[ks], S[cb]);
            }
        }
#pragma unroll
        for (int tb = 0; tb < 4; ++tb)
#pragma unroll
            for (int r = 0; r < 4; ++r) { float v = o[tb][r] * o[tb][r];
                v += dpp_f<0xB1>(v); v += dpp_f<0x4E>(v); v += dpp_f<0x141>(v); v += dpp_f<0x140>(v);
                if (l15 == 0) *(LAS float*)(lds + HL_SSQ + (wave * 64 + 16 * tb + 4 * q4 + r) * 4) = v; }
        __syncthreads();
        float rs_mine; { const int tm = 16 * (l15 >> 2) + 4 * q4 + (l15 & 3); float tot = 0.f;
#pragma unroll
            for (int w = 0; w < 8; ++w) tot += *(const LAS float*)(lds + HL_SSQ + (w * 64 + tm) * 4);
            rs_mine = __builtin_amdgcn_rsqf(tot * (1.f / 128.f) + EPS); }
#pragma unroll
        for (int tb = 0; tb < 4; ++tb)
#pragma unroll
            for (int r = 0; r < 4; ++r) { const int t = 16 * tb + 4 * q4 + r;
                const float rstd = __shfl(rs_mine, (lane & 48) + 4 * tb + r);
                const float g = bf2f(*(const LAS bf16_t*)(lds + HL_G + (n & 1) * 17408 + t * 272 + (16 * wave + l15) * 2));
                MIX[(size_t)(rowbase + t) * DM + h * 128 + 16 * wave + l15] = f2bf(o[tb][r] * rstd * gnw * (g * sigmoidf_(g))); }
    }
}

constexpr int AL_K = 0, AL_V = 18432, AL_IMP = 36864, AL_SELM = 70656, AL_STASH = 71680;
static_assert(AL_STASH + 8 * 8192 <= LDS_BYTES - 64, "attention LDS");
constexpr float NEGBIG = -1e30f;
DI bf16x8 pack8(const f32x16& p, int s) {
    u32x4 w; w.x = pk2(p[8 * s], p[8 * s + 1]); w.y = pk2(p[8 * s + 2], p[8 * s + 3]); w.z = pk2(p[8 * s + 4], p[8 * s + 5]); w.w = pk2(p[8 * s + 6], p[8 * s + 7]);
    return __builtin_bit_cast(bf16x8, w);
}
DI void attn_scores(LAS unsigned char* lds, int buf, const bf16x8 (&qf)[4], f32x16& p0, f32x16& p1, int q32, int hi) {
    const LAS unsigned char* kb = lds + AL_K + buf * 9216 + q32 * 144 + hi * 16;
#pragma unroll
    for (int i = 0; i < 16; ++i) { p0[i] = 0.f; p1[i] = 0.f; }
#pragma unroll
    for (int kk = 0; kk < 4; ++kk) {
        const bf16x8 a0 = *(const LAS bf16x8*)(kb + kk * 32), a1 = *(const LAS bf16x8*)(kb + 32 * 144 + kk * 32);
        p0 = MFMA32(a0, qf[kk], p0); p1 = MFMA32(a1, qf[kk], p1);
    }
}
DI void attn_pv(LAS unsigned char* lds, int buf, const f32x16& p0, const f32x16& p1, f32x16 (&o)[2], int q32, int hi) {
    const LAS unsigned char* vb = lds + AL_V + buf * 9216 + q32 * 144 + hi * 16;
    const bf16x8 pb0 = pack8(p0, 0), pb1 = pack8(p0, 1), pb2 = pack8(p1, 0), pb3 = pack8(p1, 1);
#pragma unroll
    for (int db = 0; db < 2; ++db) {
        const LAS unsigned char* v2 = vb + db * 32 * 144;
        o[db] = MFMA32(*(const LAS bf16x8*)(v2), pb0, o[db]);
        o[db] = MFMA32(*(const LAS bf16x8*)(v2 + 32), pb1, o[db]);
        o[db] = MFMA32(*(const LAS bf16x8*)(v2 + 64), pb2, o[db]);
        o[db] = MFMA32(*(const LAS bf16x8*)(v2 + 96), pb3, o[db]);
    }
}
DI void attn_scores_biased(LAS unsigned char* lds, int buf, const bf16x8 (&qf)[4], const f32x16& a0, const f32x16& a1, f32x16& p0, f32x16& p1, int q32, int hi) {
    const LAS unsigned char* kb = lds + AL_K + buf * 9216 + q32 * 144 + hi * 16;
    p0 = MFMA32(*(const LAS bf16x8*)(kb), qf[0], a0); p1 = MFMA32(*(const LAS bf16x8*)(kb + 32 * 144), qf[0], a1);
#pragma unroll
    for (int kk = 1; kk < 4; ++kk) {
        p0 = MFMA32(*(const LAS bf16x8*)(kb + kk * 32), qf[kk], p0); p1 = MFMA32(*(const LAS bf16x8*)(kb + 32 * 144 + kk * 32), qf[kk], p1);
    }
}
template <int MODE>
DI void attn_stream(LAS unsigned char* lds, const bf16_t* kbase, const bf16_t* vbase, unsigned tmask, unsigned fullmask, unsigned mymask, int cur, int tq, float slope2, float gate,
                    const bf16x8 (&qf)[4], const f32x16& a0, const f32x16& a1, f32x16 (&o)[2], int tid, int q32, int hi) {
    const int srow = tid >> 3, sch = tid & 7;
    float m = NEGBIG, lsum = 0.f;
#pragma unroll
    for (int i = 0; i < 16; ++i) { o[0][i] = 0.f; o[1][i] = 0.f; }
    auto next_tile = [&]() -> int { if (!tmask) return -1; const int t = 31 - __clz(tmask); tmask &= ~(1u << t); return t; };
    int j = next_tile();
    u32x4 kA = *(const u32x4*)(kbase + (size_t)(64 * j + srow) * NP + 8 * sch), vA = *(const u32x4*)(vbase + (size_t)srow * SEQ + 64 * j + 8 * sch);
    u32x4 kB = kA, vB = vA;
    int jn = next_tile();
    if (jn >= 0) { kB = *(const u32x4*)(kbase + (size_t)(64 * jn + srow) * NP + 8 * sch); vB = *(const u32x4*)(vbase + (size_t)srow * SEQ + 64 * jn + 8 * sch); }
    __syncthreads();
    *(LAS u32x4*)(lds + AL_K + srow * 144 + sch * 16) = kA; *(LAS u32x4*)(lds + AL_V + srow * 144 + sch * 16) = vA;
    __syncthreads();
    auto step = [&](u32x4& kL, u32x4& vL, const u32x4& kS, const u32x4& vS, const int bufc) -> bool {
        const int jnn = (jn >= 0) ? next_tile() : -1;
        if (jnn >= 0) { kL = *(const u32x4*)(kbase + (size_t)(64 * jnn + srow) * NP + 8 * sch); vL = *(const u32x4*)(vbase + (size_t)srow * SEQ + 64 * jnn + 8 * sch); }
        f32x16 p0, p1;
        attn_scores_biased(lds, bufc, qf, a0, a1, p0, p1, q32, hi);
        const float Bj = -slope2 * (float)(64 * (cur - j));
        if (!((fullmask >> j) & 1u)) {
            const bool selv = (MODE == 0) ? (((mymask >> j) & 1u) != 0u) : true;
            float basef = (float)(tq - 64 * j - 4 * hi); asm volatile("" : "+v"(basef));
#pragma unroll
            for (int r = 0; r < 16; ++r) {
                const float d0 = basef - (float)((r & 3) + 8 * (r >> 2)), d1 = d0 - 32.f;
                const bool v0 = (MODE == 0) ? (selv && d0 >= 0.f) : (d0 >= 0.f && d0 < 512.f);
                const bool v1 = (MODE == 0) ? (selv && d1 >= 0.f) : (d1 >= 0.f && d1 < 512.f);
                p0[r] = v0 ? p0[r] : NEGBIG; p1[r] = v1 ? p1[r] : NEGBIG;
            }
        }
        float mx = fmaxf(p0[0], p1[0]);
#pragma unroll
        for (int r = 1; r < 16; ++r) mx = fmaxf(mx, fmaxf(p0[r], p1[r]));
        mx = fmaxf(mx, __shfl_xor(mx, 32));
        const float mcand = mx + Bj;
        if (__any(mcand > m)) {
            const float mnew = fmaxf(m, mcand), alpha = fast_exp2(m - mnew); m = mnew; lsum *= alpha;
#pragma unroll
            for (int i = 0; i < 16; ++i) { o[0][i] *= alpha; o[1][i] *= alpha; }
        }
        const float madj = m - Bj;
        float ps = 0.f;
#pragma unroll
        for (int r = 0; r < 16; ++r) { p0[r] = fast_exp2(p0[r] - madj); p1[r] = fast_exp2(p1[r] - madj); ps += p0[r] + p1[r]; }
        lsum += ps;
        attn_pv(lds, bufc, p0, p1, o, q32, hi);
        if (jn < 0) return false;
        *(LAS u32x4*)(lds + AL_K + (bufc ^ 1) * 9216 + srow * 144 + sch * 16) = kS; *(LAS u32x4*)(lds + AL_V + (bufc ^ 1) * 9216 + srow * 144 + sch * 16) = vS;
        __syncthreads();
        j = jn; jn = jnn;
        return true;
    };
    for (;;) { if (!step(kA, vA, kB, vB, 0)) break; if (!step(kB, vB, kA, vA, 1)) break; }
    const float ltot = lsum + __shfl_xor(lsum, 32);
    const float sc = (m > -1e29f) ? gate * fast_rcp(ltot) : 0.f;
#pragma unroll
    for (int i = 0; i < 16; ++i) { o[0][i] *= sc; o[1][i] *= sc; }
}

DI void attn_item(const Args& a, LAS unsigned char* lds, int item, int tid, int lane, int wave) {
    const int qt = 31 - (item >> 5), b = (item >> 2) & 7, g = item & 3, bg = b * 4 + g;
    const int cur = qt, t0 = 64 * qt, r = wave >> 1, head = 4 * g + r, q32 = lane & 31, hi = lane >> 5, tl = 32 * (wave & 1) + q32, tq = t0 + tl;
    const bf16_t* P = (const bf16_t*)(a.ws + WS_P);
    const float slope2 = exp2f(-0.5f * (float)(head + 1)) * LOG2E;
    const bf16_t* prow = P + (size_t)(b * SEQ + tq) * NP;
    bf16x8 qf[4];
#pragma unroll
    for (int kk = 0; kk < 4; ++kk) qf[kk] = *(const bf16x8*)(prow + C_NQ + head * 64 + 16 * kk + 8 * hi);
    const float g0 = sigmoidf_(bf2f(prow[C_GATE + head * 3])), g1 = sigmoidf_(bf2f(prow[C_GATE + head * 3 + 1])), g2 = sigmoidf_(bf2f(prow[C_GATE + head * 3 + 2]));
    LAS float* stash = (LAS float*)(lds + AL_STASH + wave * 8192) + lane;
    const int srow = tid >> 3, sch = tid & 7;
    {
        const int ntile = (qt >= 16) ? 2 : 1;
        const bf16_t* kc = (const bf16_t*)(a.ws + SM_KC) + (size_t)bg * 128 * 64;
        const bf16_t* vct = (const bf16_t*)(a.ws + SM_VCT) + (size_t)bg * 64 * 128;
        {
            const u32x4 k0 = *(const u32x4*)(kc + (size_t)srow * 64 + 8 * sch), v0 = *(const u32x4*)(vct + (size_t)srow * 128 + 8 * sch);
            u32x4 k1 = k0, v1 = v0;
            if (ntile == 2) { k1 = *(const u32x4*)(kc + (size_t)(64 + srow) * 64 + 8 * sch); v1 = *(const u32x4*)(vct + (size_t)srow * 128 + 64 + 8 * sch); }
            *(LAS u32x4*)(lds + AL_K + srow * 144 + sch * 16) = k0; *(LAS u32x4*)(lds + AL_V + srow * 144 + sch * 16) = v0;
            *(LAS u32x4*)(lds + AL_K + 9216 + srow * 144 + sch * 16) = k1; *(LAS u32x4*)(lds + AL_V + 9216 + srow * 144 + sch * 16) = v1;
        }
        __syncthreads();
        f32x16 p[4];
        attn_scores(lds, 0, qf, p[0], p[1], q32, hi);
        attn_scores(lds, 1, qf, p[2], p[3], q32, hi);
        float mx = NEGBIG;
#pragma unroll
        for (int kb = 0; kb < 4; ++kb)
#pragma unroll
            for (int rr = 0; rr < 16; ++rr) { const int n = 32 * kb + crow(rr, hi); const int d = tq - (16 * n + 31);
                const bool v = (d >= 0) && (kb < 2 * ntile);
                p[kb][rr] = v ? p[kb][rr] - slope2 * (float)d : NEGBIG; mx = fmaxf(mx, p[kb][rr]); }
        mx = fmaxf(mx, __shfl_xor(mx, 32));
        float ps = 0.f;
#pragma unroll
        for (int kb = 0; kb < 4; ++kb)
#pragma unroll
            for (int rr = 0; rr < 16; ++rr) { p[kb][rr] = fast_exp2(p[kb][rr] - mx); ps += p[kb][rr]; }
        ps += __shfl_xor(ps, 32);
        const float inv = (mx > -1e29f) ? fast_rcp(ps) : 0.f;
#pragma unroll
        for (int kb = 0; kb < 4; ++kb)
#pragma unroll
            for (int rr = 0; rr < 16; ++rr) p[kb][rr] *= inv;
        float rc_prev = 0.f;
#pragma unroll
        for (int k = 0; k < 16; ++k) { const int kb = k >> 2, c4 = k & 3; const float bc = p[kb][4 * c4 + 3]; const float av = (p[kb][4 * c4] + p[kb][4 * c4 + 1]) + (p[kb][4 * c4 + 2] + bc);
            const float rc = __shfl_xor(bc, 32); const float v = av + (hi ? rc : rc_prev); rc_prev = rc;
            *(LAS float*)(lds + AL_IMP + ((r * 64 + tl) * 33 + 2 * k + hi) * 4) = v; }
        f32x16 o[2];
#pragma unroll
        for (int i = 0; i < 16; ++i) { o[0][i] = 0.f; o[1][i] = 0.f; }
        attn_pv(lds, 0, p[0], p[1], o, q32, hi);
        if (ntile == 2) attn_pv(lds, 1, p[2], p[3], o, q32, hi);
#pragma unroll
        for (int i = 0; i < 16; ++i) { stash[i * 64] = g0 * o[0][i]; stash[(16 + i) * 64] = g0 * o[1][i]; }
    }
    __syncthreads();
    {
        const int tok = tid >> 3, jg = tid & 7;
        float v[32];
#pragma unroll
        for (int j = 0; j < 32; ++j) { float s = 0.f;
#pragma unroll
            for (int rr = 0; rr < 4; ++rr) s += *(const LAS float*)(lds + AL_IMP + ((rr * 64 + tok) * 33 + j) * 4);
            const bool forced = (j == 0) || (j == cur) || (j == cur - 1);
            v[j] = forced ? 1e9f : ((j > cur) ? -1e9f : s); }
        unsigned bits = 0u;
#pragma unroll
        for (int i = 0; i < 4; ++i) {
            float mine = 0.f;
#pragma unroll
            for (int j = 0; j < 32; ++j) if ((j >> 2) == jg && (j & 3) == i) mine = v[j];
            const int jme = 4 * jg + i; int rank = 0;
#pragma unroll
            for (int j = 0; j < 32; ++j) rank += (v[j] > mine || (v[j] == mine && j < jme)) ? 1 : 0;
            if (rank < 16) bits |= 1u << jme;
        }
        bits |= __shfl_xor(bits, 1); bits |= __shfl_xor(bits, 2); bits |= __shfl_xor(bits, 4);
        if (jg == 0) *(LAS unsigned*)(lds + AL_SELM + tok * 4) = bits;
    }
    __syncthreads();
    unsigned umask = *(const LAS unsigned*)(lds + AL_SELM + lane * 4);
#pragma unroll
    for (int o2 = 1; o2 < 64; o2 <<= 1) umask |= __shfl_xor(umask, o2);
    const unsigned mymask = *(const LAS unsigned*)(lds + AL_SELM + tl * 4);
    const unsigned causal = (cur == 31) ? 0xffffffffu : ((1u << (cur + 1)) - 1u);
    umask = __builtin_amdgcn_readfirstlane(umask & causal);
    f32x16 ob[2];
    f32x16 ab0, ab1;
#pragma unroll
    for (int rr = 0; rr < 16; ++rr) { ab0[rr] = slope2 * (float)(crow(rr, hi) - tl); ab1[rr] = slope2 * (float)(crow(rr, hi) + 32 - tl); }
    unsigned amask = *(const LAS unsigned*)(lds + AL_SELM + lane * 4);
#pragma unroll
    for (int o2 = 1; o2 < 64; o2 <<= 1) amask &= __shfl_xor(amask, o2);
    const unsigned below = (1u << cur) - 1u;
    const unsigned sfull = __builtin_amdgcn_readfirstlane(amask) & below;
    attn_stream<0>(lds, P + (size_t)(b * SEQ) * NP + C_NKS + g * 64, (const bf16_t*)(a.ws + WS_VT) + (size_t)bg * 64 * SEQ, umask, sfull, mymask, cur, tq, slope2, g1, qf, ab0, ab1, ob, tid, q32, hi);
#pragma unroll
    for (int i = 0; i < 16; ++i) { stash[i * 64] += ob[0][i]; stash[(16 + i) * 64] += ob[1][i]; }
    const int wlo = cur >= 8 ? cur - 8 : 0;
    const unsigned wmask = causal & ~((1u << wlo) - 1u);
    const unsigned wfull = below & ~((1u << (cur >= 7 ? cur - 7 : 0)) - 1u);
    attn_stream<1>(lds, P + (size_t)(b * SEQ) * NP + C_NKW + g * 64, (const bf16_t*)(a.ws + WS_VT) + (size_t)(32 * 64 * SEQ) + (size_t)bg * 64 * SEQ, wmask, wfull, 0u, cur, tq, slope2, g2, qf, ab0, ab1, ob, tid, q32, hi);
#pragma unroll
    for (int i = 0; i < 16; ++i) { ob[0][i] += stash[i * 64]; ob[1][i] += stash[(16 + i) * 64]; }
    bf16_t* mo = (bf16_t*)(a.ws + WS_XN) + (size_t)(b * SEQ + tq) * DM + 1024 + head * 64;
#pragma unroll
    for (int db = 0; db < 2; ++db)
#pragma unroll
        for (int c4 = 0; c4 < 4; ++c4) { u32x2 w; w.x = pk2(ob[db][4 * c4], ob[db][4 * c4 + 1]); w.y = pk2(ob[db][4 * c4 + 2], ob[db][4 * c4 + 3]);
            *(u32x2*)(mo + 32 * db + 8 * c4 + 4 * hi) = w; }
}

DI unsigned f2sort(float f) { const unsigned u = __float_as_uint(f); return u ^ ((u >> 31) ? 0xffffffffu : 0x80000000u); }
DI float sort2f(unsigned u) { return __uint_as_float(u ^ ((u >> 31) ? 0x80000000u : 0xffffffffu)); }
DI void ce_desc(unsigned& x, unsigned& y) { const unsigned hi = max(x, y), lo = min(x, y); x = hi; y = lo; }
template <int NA> DI void sort16_desc(unsigned (&a)[NA], const int off) {
#pragma unroll
    for (int ks = 1; ks <= 4; ++ks)
#pragma unroll
        for (int js = 0; js < 4; ++js) { const int k = 1 << ks, jb = ks - 1 - js;
            if (jb >= 0) { const int j = 1 << jb;
#pragma unroll
                for (int i = 0; i < 16; ++i) { const int l = i ^ j; if (l > i) { if ((i & k) == 0) ce_desc(a[off + i], a[off + l]); else ce_desc(a[off + l], a[off + i]); } } } }
}
template <int NA> DI void merge_top16(unsigned (&a)[NA], const int oa, const int ob) {
#pragma unroll
    for (int i = 0; i < 16; ++i) a[oa + i] = max(a[oa + i], a[ob + 15 - i]);
#pragma unroll
    for (int js = 0; js < 4; ++js) { const int j = 8 >> js;
#pragma unroll
        for (int i = 0; i < 16; ++i) { const int l = i ^ j; if (l > i) ce_desc(a[oa + i], a[oa + l]); } }
}
DI void top16_of_64(unsigned (&a)[64]) { sort16_desc(a, 0); sort16_desc(a, 16); sort16_desc(a, 32); sort16_desc(a, 48); merge_top16(a, 0, 16); merge_top16(a, 32, 48); merge_top16(a, 0, 32); }
DI void topk_item(const Args& a, LAS unsigned char* wl, int item, int lane, LAS unsigned* lcnt) {
    const int tt = item >> 3, h = item & 7, q32 = lane & 31, hi = lane >> 5, tok = 32 * tt + q32;
    const __amdgpu_buffer_rsrc_t SKb = __builtin_amdgcn_make_buffer_rsrc((void*)(a.ws + SM_SK), 0, 524288, 0x00020000);
    const __amdgpu_buffer_rsrc_t Qb = __builtin_amdgcn_make_buffer_rsrc((void*)(a.ws + WS_QP), 0, 64 << 20, 0x00020000);
    LAS unsigned* tab = (LAS unsigned*)wl;
    unsigned top[2][16];
#pragma unroll
    for (int p = 0; p < 2; ++p) {
        f32x16 acc[4];
#pragma unroll
        for (int kb = 0; kb < 4; ++kb)
#pragma unroll
            for (int i = 0; i < 16; ++i) acc[kb][i] = 0.f;
        const int kvo = (q32 * 128 + 8 * hi) * 2, qvo = (q32 * DM + 8 * hi) * 2;
#pragma unroll
        for (int ks = 0; ks < 8; ++ks) {
            const bf16x8 qv = __builtin_bit_cast(bf16x8, __builtin_amdgcn_raw_buffer_load_b128(Qb, qvo, ((32 * tt) * DM + h * 256 + p * 128 + 16 * ks) * 2, 0));
#pragma unroll
            for (int kb = 0; kb < 4; ++kb) acc[kb] = MFMA32(__builtin_bit_cast(bf16x8, __builtin_amdgcn_raw_buffer_load_b128(SKb, kvo, (((h * 2 + p) * 128 + 32 * kb) * 128 + 16 * ks) * 2, 0)), qv, acc[kb]);
        }
        int h4 = 4 * hi; asm volatile("" : "+v"(h4));
        unsigned key[64];
#pragma unroll
        for (int kb = 0; kb < 4; ++kb)
#pragma unroll
            for (int r = 0; r < 16; ++r) key[kb * 16 + r] = (f2sort(acc[kb][r]) & ~127u) | (unsigned)(127 - (32 * kb + (r & 3) + 8 * (r >> 2)) - h4);
        top16_of_64(key);
#pragma unroll
        for (int i = 0; i < 16; ++i) key[16 + i] = (unsigned)__shfl_xor((int)key[i], 32);
        merge_top16(key, 0, 16);
#pragma unroll
        for (int i = 0; i < 16; ++i) { top[p][i] = key[i]; tab[(p * 16 + i) * 64 + lane] = key[i]; }
    }
    unsigned cand[64]; { int n = 0;
#pragma unroll
        for (int i = 0; i < 16; ++i)
#pragma unroll
            for (int j = 0; j < 16; ++j) if ((i + 1) * (j + 1) <= 16) { cand[n] = (f2sort(sort2f(top[0][i] & ~127u) + sort2f(top[1][j] & ~127u)) & ~255u) | (unsigned)(255 - (16 * i + j)); ++n; }
#pragma unroll
        for (int i = 50; i < 64; ++i) cand[i] = 0u; }
    top16_of_64(cand);
    const float vmax = sort2f(cand[0] & ~255u);
    float e[16], esum = 0.f; unsigned ex[16];
#pragma unroll
    for (int rd = 0; rd < 16; ++rd) {
        const unsigned m = cand[rd]; const int cidx = 255 - (int)(m & 255u), ci = cidx >> 4, cj = cidx & 15;
        e[rd] = __expf(sort2f(m & ~255u) - vmax); esum += e[rd];
        const unsigned i0 = 127u - (tab[ci * 64 + lane] & 127u), i1 = 127u - (tab[(16 + cj) * 64 + lane] & 127u);
        ex[rd] = i0 * 128u + i1;
    }
    if (hi == 0) {
        LAS unsigned* cnt = lcnt + (q32 >> 4) * 16; unsigned* lt = (unsigned*)(a.ws + WS_LIST) + (size_t)(2 * tt + (q32 >> 4)) * 2048; unsigned* lm = (unsigned*)(a.ws + WS_LISTM) + (size_t)(2 * tt + (q32 >> 4)) * 4096;
        unsigned* pidx = (unsigned*)(a.ws + WS_PIDX) + (size_t)tok * 128 + h * 16; unsigned pos[16];
#pragma unroll
        for (int rd = 0; rd < 16; ++rd) { const unsigned g = ex[rd] >> 10, el = ex[rd] & 1023u;
            pos[rd] = __hip_atomic_fetch_add(cnt + g, 1u, __ATOMIC_RELAXED, __HIP_MEMORY_SCOPE_WORKGROUP);
            const unsigned ent = (el << 7) | (((el >> 1) & 7u) << 4) | ((unsigned)(q32 & 3) << 17) | ((unsigned)((q32 >> 2) & 3) << 24), p = pos[rd];
            if (p < 256u) lm[g * 256u + (p >> 6) * 64u + (p & 15u) * 4u + ((p >> 4) & 3u)] = ent;
            if (p >= 192u) lt[(size_t)g * (1024 * 2048) + (p & 15u) * 128u + (p >> 4)] = ent; }
#pragma unroll
        for (int k4 = 0; k4 < 4; ++k4) *(u32x4*)(pidx + 4 * k4) = (u32x4){pos[4 * k4], pos[4 * k4 + 1], pos[4 * k4 + 2], pos[4 * k4 + 3]};
        const float inv = 1.f / esum;
        unsigned* ei = (unsigned*)(a.ws + WS_EI) + (size_t)tok * 128 + h * 16; float* eg = (float*)(a.ws + WS_EG) + (size_t)tok * 128 + h * 16;
#pragma unroll
        for (int k4 = 0; k4 < 4; ++k4) {
            *(u32x4*)(ei + 4 * k4) = (u32x4){ex[4 * k4], ex[4 * k4 + 1], ex[4 * k4 + 2], ex[4 * k4 + 3]};
            *(f32x4*)(eg + 4 * k4) = (f32x4){e[4 * k4] * inv, e[4 * k4 + 1] * inv, e[4 * k4 + 2] * inv, e[4 * k4 + 3] * inv};
        }
    }
}

#define XB_TMO      128
#define XB_XCNT(j)  (256  + 64 * (j))
#define XB_XSUB(j)  (1280 + 64 * (j))
#define XB_XGEN(j)  (2304 + 64 * (j))
#define XB_TOP      3328
#define XB_TOPGEN   3392
#define XCD_BAR_WORDS 3456
#define XB_SPIN_CAP (1u << 22)
DI unsigned xb_ld(unsigned* p)              { return __hip_atomic_load(p, __ATOMIC_RELAXED, __HIP_MEMORY_SCOPE_AGENT); }
DI unsigned xb_add(unsigned* p, unsigned v) { return __hip_atomic_fetch_add(p, v, __ATOMIC_RELAXED, __HIP_MEMORY_SCOPE_AGENT); }
DI unsigned xb_xcc_id() { return (unsigned)__builtin_amdgcn_s_getreg((3 << 11) | 20) & 0xFu; }
#define XB_SPIN(cond, bar) do { unsigned _sp = 0; while (cond) { __builtin_amdgcn_s_sleep(1); \
    if ((++_sp & 255u) == 0u) { if (xb_ld(&(bar)[XB_TMO])) break; if (_sp > XB_SPIN_CAP) { atomicAdd(&(bar)[XB_TMO], 1u); break; } } } } while (0)
struct XcdBarrier { unsigned* bar; unsigned x; volatile LAS unsigned* st; };
DI XcdBarrier xcd_barrier_post(unsigned* bar, volatile LAS unsigned* st) {
    XcdBarrier b; b.bar = bar; b.x = xb_xcc_id(); b.st = st;
    if (threadIdx.x == 0) (void)xb_add(&bar[XB_XCNT(b.x)], 1u);
    return b;
}
DI void xcd_barrier_complete(unsigned* bar, unsigned x, unsigned& nloc, unsigned& nx) {
    const unsigned G = gridDim.x * gridDim.y * gridDim.z;
    unsigned sum, cnt, mine, sp = 0u;
    for (;;) {
        sum = 0u; cnt = 0u; mine = 0u;
#pragma unroll
        for (unsigned j = 0; j < 16; ++j) { const unsigned c = xb_ld(&bar[XB_XCNT(j)]); sum += c; cnt += (c > 0u) ? 1u : 0u; mine = (j == x) ? c : mine; }
        if (sum == G) break;
        __builtin_amdgcn_s_sleep(1);
        if ((++sp & 255u) == 0u) { if (xb_ld(&bar[XB_TMO])) break; if (sp > XB_SPIN_CAP) { atomicAdd(&bar[XB_TMO], 1u); break; } }
    }
    nloc = mine > 0u ? mine : 1u; nx = cnt > 0u ? cnt : 1u;
}
DI void xcd_barrier(const XcdBarrier& b) {
    asm volatile("s_waitcnt vmcnt(0)" ::: "memory");
    __syncthreads();
    if (threadIdx.x == 0) {
        unsigned* bar = b.bar;
        __builtin_amdgcn_s_waitcnt(0);
        unsigned nloc = b.st[0], nx = b.st[1];
        if (nloc == 0u) { xcd_barrier_complete(bar, b.x, nloc, nx); b.st[0] = nloc; b.st[1] = nx; }
        const unsigned old = xb_add(&bar[XB_XSUB(b.x)], 1u);
        const unsigned gen = old / nloc;
        if (old + 1u == (gen + 1u) * nloc) {
            __builtin_amdgcn_fence(__ATOMIC_RELEASE, "agent");
            asm volatile("s_waitcnt vmcnt(0)" ::: "memory");
            const unsigned og = xb_add(&bar[XB_TOP], 1u);
            const unsigned tg = og / nx;
            if (og + 1u == (tg + 1u) * nx) xb_add(&bar[XB_TOPGEN], 1u);
            else XB_SPIN(xb_ld(&bar[XB_TOPGEN]) == tg, bar);
            __builtin_amdgcn_fence(__ATOMIC_ACQUIRE, "agent");
            xb_add(&bar[XB_XGEN(b.x)], 1u);
            asm volatile("s_waitcnt vmcnt(0)" ::: "memory");
        } else {
            XB_SPIN(xb_ld(&bar[XB_XGEN(b.x)]) == gen, bar);
            __builtin_amdgcn_fence(__ATOMIC_ACQUIRE, "agent");
            asm volatile("s_waitcnt vmcnt(0)" ::: "memory");
        }
    }
    __syncthreads();
}

constexpr int SLICE_BYTES = 16384 * 128;
constexpr int PEER_TT = 128, PEER_NT = PEER_TT / 8;
struct PeerIdxW { u32x4 e4[4]; };
struct PeerVRows { u32x4 r[16]; u32x2 h2; };
struct UTile { u32x4 a0, a1, e0, e1, e2; unsigned n, off; };
struct UBuf { i32x4 b0[4], b1[4]; unsigned en[4]; };
DI void peer_u_lds_phase(const Args& a, LAS unsigned char* lds, int tid, int lane, int wave) {
    LAS int* rslot = (LAS int*)(lds + LDS_BYTES - 64);
    unsigned* ctl = (unsigned*)(a.ws + WS_CTL);
    const int xcd = (int)(xb_xcc_id() & 7u);
    for (;;) {
        __syncthreads();
        if (tid == 0) { int role = -1;
            if (__hip_atomic_load(ctl + CW_ROLE + 512, __ATOMIC_RELAXED, __HIP_MEMORY_SCOPE_AGENT) < 256u)
                for (int q = 0; q < 8 && role < 0; ++q) { const int x = (xcd + q) & 7; const unsigned r = atomicAdd(ctl + CW_ROLE + 64 * x, 1u); if (r < 32u) role = (int)((((unsigned)x + 8u * (r >> 4)) << 4) | (r & 15u)); }
            if (role >= 0) atomicAdd(ctl + CW_ROLE + 512, 1u);
            *rslot = role; }
        __syncthreads();
        const int role = *rslot; if (role < 0) break;
        const int s = role >> 4, g = role & 15;
        { const unsigned char* src = a.ws + WS_UB + (size_t)s * SLICE_BYTES + (size_t)g * 131072;
#pragma unroll
          for (int hb = 0; hb < 2; ++hb) { u32x4 v[8];
#pragma unroll
            for (int i = 0; i < 8; ++i) v[i] = *(const u32x4*)(src + (size_t)(tid + 512 * (8 * hb + i)) * 16);
#pragma unroll
            for (int i = 0; i < 8; ++i) { const int idx = tid + 512 * (8 * hb + i), e = idx >> 3, c = idx & 7; *(LAS u32x4*)(lds + e * 128 + ((c ^ ((e >> 1) & 7)) << 4)) = v[i]; } } }
        __syncthreads();
        const int j = lane & 15, kg = lane >> 4;
        const __amdgpu_buffer_rsrc_t Hb = __builtin_amdgcn_make_buffer_rsrc((void*)(a.ws + WS_HQ8), 0, 32 << 20, 0x00020000);
        const __amdgpu_buffer_rsrc_t Mb = __builtin_amdgcn_make_buffer_rsrc((void*)(a.ws + WS_LISTM), 0, 16 << 20, 0x00020000);
        const __amdgpu_buffer_rsrc_t Lb = __builtin_amdgcn_make_buffer_rsrc((void*)(a.ws + WS_LIST + (size_t)g * (8 << 20)), 0, 8 << 20, 0x00020000);
        const __amdgpu_buffer_rsrc_t Cb = __builtin_amdgcn_make_buffer_rsrc((void*)(ctl + CW_CNT), 0, 131072, 0x00020000);
        const __amdgpu_buffer_rsrc_t Pb = __builtin_amdgcn_make_buffer_rsrc((void*)(a.ws + WS_PU + (size_t)s * M * 512), 0, M * 512, 0x00020000);
        auto load = [&](UTile& t, int T) {
            t.n = (unsigned)__builtin_amdgcn_raw_buffer_load_b32(Cb, 0, (T * 16 + g) * 4, 0); t.off = (unsigned)__builtin_amdgcn_raw_buffer_load_b32(Cb, 0, (CW_OFF - CW_CNT + T * 16 + g) * 4, 0);
            t.a0 = __builtin_bit_cast(u32x4, __builtin_amdgcn_raw_buffer_load_b128(Hb, j * DM + 128 * s + 16 * kg, T * (16 * DM), 0));
            t.a1 = __builtin_bit_cast(u32x4, __builtin_amdgcn_raw_buffer_load_b128(Hb, j * DM + 128 * s + 16 * kg + 64, T * (16 * DM), 0));
            t.e0 = __builtin_bit_cast(u32x4, __builtin_amdgcn_raw_buffer_load_b128(Mb, j * 16, T * 16384 + g * 1024, 0));
            t.e1 = __builtin_bit_cast(u32x4, __builtin_amdgcn_raw_buffer_load_b128(Mb, j * 16 + 256, T * 16384 + g * 1024, 0));
            t.e2 = __builtin_bit_cast(u32x4, __builtin_amdgcn_raw_buffer_load_b128(Mb, j * 16 + 512, T * 16384 + g * 1024, 0)); };
        auto issue = [&](UBuf& B, const u32x4 e4, int rt0, int n) {
#pragma unroll
            for (int v = 0; v < 4; ++v) { B.en[v] = e4[v];
                const unsigned ad = (B.en[v] & 0x1FFFFu) ^ ((unsigned)kg << 4);
                B.b0[v] = *(const LAS i32x4*)(lds + ad); B.b1[v] = *(const LAS i32x4*)(lds + (ad ^ 64u)); }
            __builtin_amdgcn_sched_barrier(0); };
        auto finish = [&](const UBuf& B, const i32x4 a0, const i32x4 a1, int rt0, int so) {
            i32x4 c[4];
#pragma unroll
            for (int v = 0; v < 4; ++v) c[v] = __builtin_amdgcn_mfma_i32_16x16x64_i8(a0, B.b0[v], (i32x4){0, 0, 0, 0}, 0, 0, 0);
#pragma unroll
            for (int v = 0; v < 4; ++v) c[v] = __builtin_amdgcn_mfma_i32_16x16x64_i8(a1, B.b1[v], c[v], 0, 0, 0);
            __builtin_amdgcn_sched_barrier(0);
#pragma unroll
            for (int v = 0; v < 4; ++v) {
                int m0, m1, v01, v23, val;
                asm("v_bfe_i32 %0, %1, 17, 1" : "=v"(m0) : "v"(B.en[v])); asm("v_bfe_i32 %0, %1, 18, 1" : "=v"(m1) : "v"(B.en[v]));
                asm("v_bfi_b32 %0, %1, %2, %3" : "=v"(v01) : "v"(m0), "v"(c[v][1]), "v"(c[v][0])); asm("v_bfi_b32 %0, %1, %2, %3" : "=v"(v23) : "v"(m0), "v"(c[v][3]), "v"(c[v][2]));
                asm("v_bfi_b32 %0, %1, %2, %3" : "=v"(val) : "v"(m1), "v"(v23), "v"(v01));
                if ((B.en[v] >> 24) == (unsigned)kg) __builtin_amdgcn_raw_buffer_store_b32((unsigned)val, Pb, (16 * (rt0 + v) + j) * 4, so, 0); }
            __builtin_amdgcn_sched_barrier(0); };
        auto proc = [&](const UTile& t, int T) {
            const int n = (int)__builtin_amdgcn_readfirstlane(t.n), nrt = (n + 15) >> 4;
            const i32x4 a0 = __builtin_bit_cast(i32x4, t.a0), a1 = __builtin_bit_cast(i32x4, t.a1);
            const int so = T * 8192 + 4 * (int)__builtin_amdgcn_readfirstlane(t.off);
            UBuf B0, B1;
            if (nrt > 0) { issue(B0, t.e0, 0, n);
                if (nrt > 4) { issue(B1, t.e1, 4, n); finish(B0, a0, a1, 0, so);
                    if (nrt > 8) { issue(B0, t.e2, 8, n); finish(B1, a0, a1, 4, so); finish(B0, a0, a1, 8, so); }
                    else finish(B1, a0, a1, 4, so); }
                else finish(B0, a0, a1, 0, so); }
            if (nrt > 12) {
#pragma unroll 1
                for (int c0 = 12; c0 < nrt; c0 += 4) { const u32x4 x0 = __builtin_bit_cast(u32x4, __builtin_amdgcn_raw_buffer_load_b128(Lb, j * 512 + c0 * 4, T * 8192, 0));
                    issue(B0, x0, c0, n); finish(B0, a0, a1, c0, so); }
                __builtin_amdgcn_s_waitcnt(0x0F70);
            } };
        UTile t0, t1, t2, t3; load(t0, wave); __builtin_amdgcn_sched_barrier(0); load(t1, wave + 8); __builtin_amdgcn_sched_barrier(0); load(t2, wave + 16); __builtin_amdgcn_sched_barrier(0);
#pragma unroll 1
        for (int T = wave; T < M / 16; T += 32) {
            const int Tn = T + 32 < M / 16 ? T + 32 : T;
            load(t3, T + 24);
            proc(t0, T);
            load(t0, Tn);
            proc(t1, T + 8);
            load(t1, Tn + 8);
            proc(t2, T + 16);
            load(t2, Tn + 16);
            proc(t3, T + 24);
        }
    }
}
DI void peer_reduce_tile(const Args& a, LAS unsigned char* lds, int T, int tid, int lane, int wave) {
    const unsigned* EI = (const unsigned*)(a.ws + WS_EI); const float* EG = (const float*)(a.ws + WS_EG); const unsigned* PIDX = (const unsigned*)(a.ws + WS_PIDX);
    const float* isU = (const float*)(a.ws + WS_UB + TAB_SCALE_OFF); const float* isV = (const float*)(a.ws + WS_VB + TAB_SCALE_OFF);
    LAS unsigned* loff = (LAS unsigned*)(lds + 131072);
    __syncthreads();
    { const unsigned char* src = a.ws + WS_PU + (size_t)T * 8192 + (size_t)tid * 16;
#pragma unroll
      for (int hb = 0; hb < 2; ++hb) { u32x4 v[8];
#pragma unroll
        for (int i = 0; i < 8; ++i) v[i] = *(const u32x4*)(src + (size_t)(8 * hb + i) * (8 << 20));
#pragma unroll
        for (int i = 0; i < 8; ++i) *(LAS u32x4*)(lds + (8 * hb + i) * 8192 + tid * 16) = v[i]; }
      if (tid < 16) loff[tid] = ((const unsigned*)(a.ws + WS_CTL))[CW_OFF + T * 16 + tid]; }
    __syncthreads();
#pragma unroll
    for (int tl = 0; tl < 2; ++tl) { const int tok = 16 * T + 2 * wave + tl; const float dq = ((const float*)(a.ws + WS_DQ))[tok];
#pragma unroll
        for (int hs = 0; hs < 2; ++hs) { const size_t idx = (size_t)tok * 128 + 64 * hs + lane; const unsigned e = EI[idx]; const float gt = EG[idx];
            const unsigned q = loff[e >> 10] + PIDX[idx]; int isum = 0;
#pragma unroll
            for (int s = 0; s < 16; ++s) isum += *(const LAS int*)(lds + s * 8192 + q * 4);
            const float w = gelu_tanh((float)isum * dq * isU[e]) * gt * isV[e];
            ((unsigned*)(a.ws + WS_W))[idx] = e | ((__float_as_uint(w) + 0x7fffu + ((__float_as_uint(w) >> 16) & 1u)) & 0xffff0000u); } }
}
DI void peer_v_item(const Args& a, int s, int tt, int lane, int wave) {
    const int g = lane >> 3, c8 = lane & 7;
    const __amdgpu_buffer_rsrc_t Vb = __builtin_amdgcn_make_buffer_rsrc((void*)(a.ws + WS_VB), 0, 32 << 20, 0x00020000);
    const __amdgpu_buffer_rsrc_t Wb = __builtin_amdgcn_make_buffer_rsrc((void*)(a.ws + WS_W), 0, 8 << 20, 0x00020000);
    const __amdgpu_buffer_rsrc_t Ob = __builtin_amdgcn_make_buffer_rsrc((void*)a.out, 0, (int)((size_t)M * DM * 4), 0x00020000);
    const int tok0 = PEER_TT * tt + wave;
    const int col = 128 * s + 16 * c8 + ((lane & 32) ? 8 : 0) + ((lane & 16) ? 4 : 0) + ((lane & 8) ? 2 : 0);
    auto pre = [&](PeerIdxW& E, int t) {
#pragma unroll
        for (int j = 0; j < 4; ++j) E.e4[j] = __builtin_bit_cast(u32x4, __builtin_amdgcn_raw_buffer_load_b128(Wb, g * 64 + 16 * j, (tok0 + 8 * t) * 512, 0)); };
    auto rows = [&](PeerVRows& R, const PeerIdxW& E, int t) {
#pragma unroll
        for (int i = 0; i < 16; ++i) R.r[i] = __builtin_bit_cast(u32x4, __builtin_amdgcn_raw_buffer_load_b128(Vb, (int)(E.e4[i >> 2][i & 3] & 0xffffu) * 128 + 16 * c8, s * SLICE_BYTES, 0));
        R.h2 = __builtin_bit_cast(u32x2, __builtin_amdgcn_raw_buffer_load_b64(Ob, col * 4, (tok0 + 8 * t) * (DM * 4), 0)); };
    auto comp = [&](const PeerVRows& R, const u32x4 (&w4)[4], int t) {
        f32x2 o2[8];
#pragma unroll
        for (int j = 0; j < 8; ++j) o2[j] = (f32x2){0.f, 0.f};
#pragma unroll
        for (int i = 0; i < 16; ++i) { const float w = __uint_as_float(w4[i >> 2][i & 3] & 0xffff0000u); const f32x2 w2 = (f32x2){w, w};
#pragma unroll
            for (int q = 0; q < 4; ++q) { const unsigned u = R.r[i][q]; o2[2 * q] += w2 * __builtin_amdgcn_cvt_pk_f32_fp8(u, false); o2[2 * q + 1] += w2 * __builtin_amdgcn_cvt_pk_f32_fp8(u, true); } }
        float v[16];
#pragma unroll
        for (int j = 0; j < 8; ++j) { v[2 * j] = o2[j][0]; v[2 * j + 1] = o2[j][1]; }
#pragma unroll
        for (int i = 0; i < 8; ++i) { float x = v[i], y = v[i + 8];
            asm volatile("s_nop 1\n\tv_permlane32_swap_b32 %0, %1" : "+v"(x), "+v"(y)); v[i] = x + y; }
#pragma unroll
        for (int i = 0; i < 4; ++i) { float x = v[i], y = v[i + 4];
            asm volatile("s_nop 1\n\tv_permlane16_swap_b32 %0, %1" : "+v"(x), "+v"(y)); v[i] = x + y; }
        { const bool up = (lane & 8) != 0;
#pragma unroll
          for (int i = 0; i < 2; ++i) { const float send = up ? v[i] : v[i + 2], keep = up ? v[i + 2] : v[i]; v[i] = keep + dpp_f<0x128>(send); } }
        f32x2 h2 = __builtin_bit_cast(f32x2, R.h2); h2[0] += v[0]; h2[1] += v[1];
        __builtin_amdgcn_raw_buffer_store_b64(__builtin_bit_cast(u32x2, h2), Ob, col * 4, (tok0 + 8 * t) * (DM * 4), 0); };
    PeerIdxW E0, E1; PeerVRows R0, R1; u32x4 wa[4], wb[4];
    pre(E0, 0); pre(E1, 1); rows(R0, E0, 0);
#pragma unroll
    for (int j = 0; j < 4; ++j) wa[j] = E0.e4[j];
#pragma unroll 1
    for (int t = 0; t < PEER_NT; t += 2) {
        rows(R1, E1, t + 1);
#pragma unroll
        for (int j = 0; j < 4; ++j) wb[j] = E1.e4[j];
        if (t + 2 < PEER_NT) pre(E0, t + 2);
        comp(R0, wa, t);
        if (t + 2 < PEER_NT) { rows(R0, E0, t + 2);
#pragma unroll
            for (int j = 0; j < 4; ++j) wa[j] = E0.e4[j]; }
        if (t + 3 < PEER_NT) pre(E1, t + 3);
        comp(R1, wb, t + 1);
    }
}
template <int VPH> DI void peer_sliced_phase(const Args& a, LAS unsigned char* lds, int tid, int lane, int wave) {
    LAS int* qslot = (LAS int*)(lds + LDS_BYTES - 64);
    const int xcd = (int)(xb_xcc_id() & 7u);
    for (int qi = 0; qi < 8; ++qi) {
        const int q = (xcd + qi) & 7; unsigned* head = (unsigned*)(a.ws + WS_CTL) + (VPH ? CW_PQV : CW_PQU) + 64 * q;
        for (;;) {
            __syncthreads();
            if (tid == 0) *qslot = (int)atomicAdd(head, 1u);
            __syncthreads();
            const int i = *qslot;
            if (i >= 2 * (M / PEER_TT)) break;
            const int s = q + 8 * (i / (M / PEER_TT)), tt = i % (M / PEER_TT);
            int l2 = (int)(threadIdx.x & 63u); asm volatile("" : "+v"(l2));
            peer_v_item(a, s, tt, l2, wave);
        }
    }
}

constexpr int NPHASE = 10;
#ifndef REPK
#define REPK -1
#endif
#define NREP(k) ((REPK) == (k) ? 2 : 1)
#ifndef PHMASK
#define PHMASK 0x3ff
#endif
__global__ void __launch_bounds__(NTHREADS, 2) fwd_kernel(Args a) {
    extern __shared__ __attribute__((aligned(16))) unsigned char lds_raw[];
    LAS unsigned char* lds = (LAS unsigned char*)lds_raw;
    cg::grid_group grid = cg::this_grid();
    int tid = threadIdx.x, lane = tid & 63, wave = __builtin_amdgcn_readfirstlane(tid >> 6);
    const int G = gridDim.x, NGW = G * NWAVES; int gw = blockIdx.x * NWAVES + wave;
#define FRESH() do { tid = threadIdx.x; asm volatile("" : "+v"(tid)); lane = tid & 63; wave = __builtin_amdgcn_readfirstlane(tid >> 6); gw = blockIdx.x * NWAVES + wave; } while (0)
    unsigned char* ws = a.ws;
    const int lo = a.ph_lo, hi = a.ph_hi;
#define IN(k) (lo <= (k) && (k) < hi)
#define SEAM(k) do { if (IN(k) && IN((k) + 1)) { if ((k) == 0) grid.sync(); else xcd_barrier(xbar); } } while (0)
    volatile LAS unsigned* xst = (volatile LAS unsigned*)(lds + LDS_BYTES - 32);
    if (tid < 2) xst[tid] = 0u;
    __syncthreads();
    const XcdBarrier xbar = xcd_barrier_post((unsigned*)(ws + WS_CTL) + CW_XBAR, xst);
    if (((PHMASK >> 0) & 1) && IN(0)) { FRESH(); for (int rep = 0; rep < NREP(0); ++rep) phase_prep(a, lds, gw, NGW, lane, wave);
        for (int fi = blockIdx.x; fi < FILL_SPLIT; fi += G) filler_item(a, lds, fi, lane, wave);
        for (int tile = blockIdx.x; tile < NP / 16; tile += G) coltile_q8_item(a.in[I_WIN], NPROJ, ws + WS_WIN, (float*)(ws + SM_SWC), lds, tile, tid); }
    SEAM(0);
    if (((PHMASK >> 1) & 1) && IN(1)) { FRESH();
        pg8::Gemm g{(const bf16_t*)(ws + WS_XN), (const bf16_t*)(ws + WS_WIN), M, NP, DM / 2}; pg8::StaticOrder S; S.init(M, NP, G, (int)blockIdx.x);
        pg8::EpiBf16 E{(bf16_t*)(ws + WS_P), NP, (const float*)(ws + SM_LB), (const float*)(ws + WS_XN + 32 * MiB), (const float*)(ws + SM_SWC)};
        for (int rep = 0; rep < NREP(1); ++rep) pg8::gemm_phase<pg8::EpiBf16, pg8::StaticOrder, true, true, true>(lds, g, S, E);
    }
    SEAM(1);
    if (((PHMASK >> 2) & 1) && IN(2)) { FRESH();
        for (int row = gw; row < M; row += NGW) nsa_norm_row(a, row, lane);
        for (int rep = 0; rep < NREP(2); ++rep) {
        for (int it = gw; it < 2048; it += NGW) vtrans_item(a, lds + wave * 9216, it, lane);
        __syncthreads();
        for (int it = blockIdx.x; it < 256; it += G) compress_item(a, lds, it, tid, lane, wave);
        }
    }
    SEAM(2);
    if (((PHMASK >> 3) & 1) && IN(3)) { FRESH();
        LAS int* qslot = (LAS int*)(lds + LDS_BYTES - 64);
        for (int rep = 0; rep < ((REPK) == 30 || (REPK) == 31 ? 2 : 1); ++rep) {
        unsigned* qhead = (unsigned*)(ws + WS_CTL) + CW_QUEUE + 64 * rep;
        const int item_lo = (rep == 1 && (REPK) == 31) ? 64 : 0, item_hi = (rep == 1 && (REPK) == 30) ? 64 : 64 + 1024 + FILL_END - FILL_SPLIT;
        for (;;) {
            __syncthreads();
            if (tid == 0) *qslot = (int)atomicAdd(qhead, 1u);
            __syncthreads();
            const int item = *qslot + item_lo;
            if (item >= item_hi) break;
            int tid2 = tid; asm volatile("" : "+v"(tid2));
            const int lane2 = tid2 & 63, wave2 = __builtin_amdgcn_readfirstlane(tid2 >> 6);

#ifndef NO_HGRN
            if (item < 64) hgrn_item(a, lds, item, tid2, lane2, wave2);
#endif
#ifndef NO_ATTN
            if (item >= 64) {
                constexpr int NF = FILL_END - FILL_SPLIT, NT = 1024 + NF; const int k = item - 64;
                const int a0 = (int)(((long)k * 1024) / NT), a1 = (int)(((long)(k + 1) * 1024) / NT);
                if (a1 != a0) attn_item(a, lds, a0, tid2, lane2, wave2); else filler_item(a, lds, k - a0 + FILL_SPLIT, lane2, wave2); }
#endif

        }
        }
    }
    SEAM(3);
    if (((PHMASK >> 4) & 1) && IN(4)) { FRESH();
        rowquant_mix(a, gw, NGW, lane);
        xcd_barrier(xbar);
        FRESH();
        pg8::Gemm g{(const bf16_t*)(ws + WS_MIX8), (const bf16_t*)(ws + WS_WOUT), M, DM, DM / 2}; pg8::StaticOrder S; S.init(M, DM, G, (int)blockIdx.x);
        pg8::EpiH E{a.in[I_X], a.out, (const float*)(ws + WS_MIX8 + 32 * MiB), (const float*)(ws + SM_SWO), lds + 131072};
        for (int rep = 0; rep < NREP(4); ++rep) pg8::gemm_phase<pg8::EpiH, pg8::StaticOrder, true, true, true>(lds, g, S, E);
    }
    SEAM(4);
    if (((PHMASK >> 5) & 1) && IN(5)) { FRESH();
        rowquant_h(a, gw, NGW, lane);
        xcd_barrier(xbar);
        FRESH();
        pg8::Gemm g{(const bf16_t*)(ws + WS_HQ8), (const bf16_t*)(ws + WS_WQ), M, DM, DM / 2}; pg8::StaticOrder S; S.init(M, DM, G, (int)blockIdx.x);
        pg8::EpiBf16 E{(bf16_t*)(ws + WS_QP), DM, nullptr, (const float*)(ws + WS_DQ), (const float*)(ws + SM_SWQ)};
        for (int rep = 0; rep < NREP(5); ++rep) pg8::gemm_phase<pg8::EpiBf16, pg8::StaticOrder, true, true, true>(lds, g, S, E);
    }
    SEAM(5);
    if (((PHMASK >> 6) & 1) && IN(6)) { FRESH(); for (int rep = 0; rep < NREP(6); ++rep) {
        LAS unsigned* lcnt = (LAS unsigned*)(lds + 131072);
        for (int it = gw; it < 4096; it += NGW) { int l2 = lane; asm volatile("" : "+v"(l2));
            if (tid < 32) lcnt[tid] = 0u;
            __syncthreads();
            topk_item(a, lds + wave * 16384, it, l2, lcnt);
            __syncthreads();
            if (tid < 32) { unsigned off = 0u; for (int g2 = 0; g2 < (tid & 15); ++g2) off += lcnt[(tid & 16) + g2];
                unsigned* ctl = (unsigned*)(ws + WS_CTL); const int ti = (2 * (it >> 3) + (tid >> 4)) * 16 + (tid & 15);
                ctl[CW_CNT + ti] = lcnt[tid]; ctl[CW_OFF + ti] = off; }
            { const int li = tid >> 4, g2 = li & 15; const unsigned n = lcnt[li], nup = (n + 63u) & ~63u;
                unsigned* lt = (unsigned*)(ws + WS_LIST) + (size_t)g2 * (1024 * 2048) + (size_t)(2 * (it >> 3) + (li >> 4)) * 2048;
                unsigned* lm = (unsigned*)(ws + WS_LISTM) + (size_t)(2 * (it >> 3) + (li >> 4)) * 4096 + g2 * 256;
#pragma unroll
                for (int k = 0; k < 4; ++k) { const unsigned p = n + (unsigned)(tid & 15) + 16u * k;
                    if (p < nup) { if (p < 256u) lm[(p >> 6) * 64u + (p & 15u) * 4u + ((p >> 4) & 3u)] = 0x80000000u; if (p >= 192u) lt[(p & 15u) * 128u + (p >> 4)] = 0x80000000u; } } }
        } } }
    SEAM(6);
    if (((PHMASK >> 7) & 1) && IN(7)) { FRESH(); peer_u_lds_phase(a, lds, tid, lane, wave); }
    SEAM(7);
    if (((PHMASK >> 8) & 1) && IN(8)) { FRESH(); for (int T = blockIdx.x; T < M / 16; T += G) peer_reduce_tile(a, lds, T, tid, lane, wave); }
    SEAM(8);
    if (((PHMASK >> 9) & 1) && IN(9)) { FRESH(); peer_sliced_phase<1>(a, lds, tid, lane, wave); }
#undef IN
#undef SEAM
}

#ifndef N_LAUNCH_MODE
#define N_LAUNCH_MODE 1
#endif
extern "C" void kernel_launch(void* const* d_in, const int* in_sizes, int n_in, void* d_out, int out_size, void* d_ws, size_t ws_size, hipStream_t stream) {
    static int grid = 0;
    if (grid == 0) {
        int dev = 0, cus = 0, per_cu = 0;
        (void)hipGetDevice(&dev); (void)hipDeviceGetAttribute(&cus, hipDeviceAttributeMultiprocessorCount, dev);
        (void)hipFuncSetAttribute((const void*)fwd_kernel, hipFuncAttributeMaxDynamicSharedMemorySize, LDS_BYTES);
        (void)hipOccupancyMaxActiveBlocksPerMultiprocessor(&per_cu, (const void*)fwd_kernel, NTHREADS, LDS_BYTES);
        if (per_cu < 1) { fprintf(stderr, "occupancy query says %d blocks/CU\n", per_cu); per_cu = 1; }
        grid = cus;
        if (ws_size < WS_END) fprintf(stderr, "warning: ws_size %zu too small\n", ws_size);
    }
    (void)hipMemsetAsync((char*)d_ws + WS_CTL, 0, CTL_BYTES, stream);
    Args a{};
    for (int i = 0; i < 21; ++i) a.in[i] = (const float*)d_in[i];
    a.out = (float*)d_out; a.ws = (unsigned char*)d_ws;
    if (N_LAUNCH_MODE == 1) {
        a.ph_lo = 0; a.ph_hi = NPHASE;
        void* args[] = {&a};
        hipError_t e = hipLaunchCooperativeKernel((const void*)fwd_kernel, dim3(grid), dim3(NTHREADS), args, LDS_BYTES, stream);
        if (e != hipSuccess) fprintf(stderr, "launch failed: %s\n", hipGetErrorString(e));
    } else {
        for (int p = 0; p < NPHASE; ++p) {
            a.ph_lo = p; a.ph_hi = p + 1;
            void* args[] = {&a};
            hipError_t e = hipLaunchCooperativeKernel((const void*)fwd_kernel, dim3(grid), dim3(NTHREADS), args, LDS_BYTES, stream);
            if (e != hipSuccess) { fprintf(stderr, "launch failed: %s\n", hipGetErrorString(e)); break; }
        }
    }
}
```

```cpp
#include <hip/hip_runtime.h>
#include <hip/hip_cooperative_groups.h>
#include <cstdio>
#include <cstdint>
namespace cg = cooperative_groups;

#define DI __device__ __forceinline__
#define LAS __attribute__((address_space(3)))
typedef unsigned short bf16_t;
typedef short bf16x8 __attribute__((ext_vector_type(8)));
typedef float f32x2 __attribute__((ext_vector_type(2)));
typedef float f32x4 __attribute__((ext_vector_type(4)));
typedef float f32x16 __attribute__((ext_vector_type(16)));
typedef unsigned u32x2 __attribute__((ext_vector_type(2)));
typedef int i32x4 __attribute__((ext_vector_type(4)));
typedef unsigned u32x4 __attribute__((ext_vector_type(4)));
typedef __bf16 bf16x2_t __attribute__((ext_vector_type(2)));

constexpr int DM = 2048, NB = 8, SEQ = 2048, M = NB * SEQ;
constexpr int NPROJ = 6704, NP = 6912;
constexpr int C_HQ = 0, C_HF = 1024, C_HI = 2048, C_HG = 3072, C_NQ = 4096, C_NKC = 5120, C_NVC = 5376, C_NKS = 5632, C_NVS = 5888, C_NKW = 6144, C_NVW = 6400, C_GATE = 6656;
constexpr float EPS = 1e-6f;
constexpr float LOG2E = 1.4426950408889634f;

constexpr size_t MiB = 1u << 20;
constexpr size_t WS_CTL = 0, CTL_BYTES = 1 * MiB;
constexpr size_t WS_WIN = 1 * MiB;
constexpr size_t WS_WOUT = 28 * MiB;
constexpr size_t WS_WQ = 36 * MiB;
constexpr size_t WS_SMALL = 44 * MiB;
constexpr size_t WS_UB = 52 * MiB;
constexpr size_t WS_VB = 116 * MiB;
constexpr size_t TAB_SCALE_OFF = 32 * MiB;
constexpr size_t WS_P = 180 * MiB;
constexpr size_t WS_XN = 396 * MiB;
constexpr size_t WS_VT = 460 * MiB;
constexpr size_t WS_SSQ = 476 * MiB;
constexpr size_t WS_LISTM = 478 * MiB;
constexpr size_t WS_END = 494 * MiB;
constexpr size_t WS_MIX8 = WS_P + 64 * MiB;
constexpr size_t WS_QP = WS_P + 64 * MiB;
constexpr size_t WS_EI = WS_P + 128 * MiB;
constexpr size_t WS_EG = WS_P + 136 * MiB;
constexpr size_t WS_W = WS_P + 144 * MiB;
constexpr size_t WS_PU = WS_P;
constexpr size_t WS_LIST = WS_P + 152 * MiB;
constexpr size_t WS_PIDX = WS_VT;
constexpr size_t WS_HQ8 = WS_WIN;
constexpr size_t WS_DQ = WS_WIN + 32 * MiB;
constexpr size_t SM_W1K = WS_SMALL;
constexpr size_t SM_W1V = WS_SMALL + 1 * MiB;
constexpr size_t SM_W2K = WS_SMALL + 2 * MiB;
constexpr size_t SM_W2V = SM_W2K + 32768;
constexpr size_t SM_SK = WS_SMALL + 3 * MiB;
constexpr size_t SM_LB = WS_SMALL + 4 * MiB;
constexpr size_t SM_BIASP = SM_LB + 4096;
constexpr size_t SM_KC = WS_SMALL + 5 * MiB;
constexpr size_t SM_SWC = WS_SMALL + 7 * MiB;
constexpr size_t SM_SWQ = WS_SMALL + 7 * MiB + 32768;
constexpr size_t SM_SWO = WS_SMALL + 7 * MiB + 49152;
constexpr size_t SM_VCT = WS_SMALL + 6 * MiB;
static_assert(WS_END <= 512 * MiB, "ws");
constexpr int CW_QUEUE = 64;
constexpr int CW_PQU = 8192, CW_PQV = 9216;
constexpr int CW_ROLE = 10240;
constexpr int CW_CNT = 16384;
constexpr int CW_OFF = 32768;
constexpr int CW_XBAR = 4096;

constexpr int LDS_BYTES = 151552;
constexpr int NTHREADS = 512, NWAVES = 8;

DI unsigned pk2(float lo, float hi) { f32x2 v = {lo, hi}; bf16x2_t b = __builtin_convertvector(v, bf16x2_t); return __builtin_bit_cast(unsigned, b); }
DI bf16_t f2bf(float f) { return (bf16_t)(pk2(f, 0.f) & 0xffffu); }
DI float bf2f(bf16_t u) { return __uint_as_float((unsigned)u << 16); }
DI float bflo(unsigned u) { return __uint_as_float(u << 16); }
DI float bfhi(unsigned u) { return __uint_as_float(u & 0xffff0000u); }
DI float wave_sum(float v) {
#pragma unroll
    for (int o = 1; o < 64; o <<= 1) v += __shfl_xor(v, o);
    return v;
}
DI float fast_exp2(float x) { return __builtin_amdgcn_exp2f(x); }
DI float fast_rcp(float x) { return __builtin_amdgcn_rcpf(x); }
DI float sigmoidf_(float x) { return fast_rcp(1.f + fast_exp2(-x * LOG2E)); }
DI float gelu_tanh(float x) {
    const float u = 0.7978845608028654f * (x + 0.044715f * x * x * x);
    return x * sigmoidf_(2.f * u);
}
#define LDS_WAIT() asm volatile("s_waitcnt lgkmcnt(0)" ::: "memory")
#define MFMA32(a, b, c) __builtin_amdgcn_mfma_f32_32x32x16_bf16((a), (b), (c), 0, 0, 0)
#define MFMA16(a, b, c) __builtin_amdgcn_mfma_f32_16x16x32_bf16((a), (b), (c), 0, 0, 0)
DI int crow(int r, int hi) { return (r & 3) + 8 * (r >> 2) + 4 * hi; }

namespace pg8 {
constexpr int BM = 256, BK = 64, HALF = 128, HTB = HALF * BK * 2, STAGE_BYTES = 8 * HTB, NXCD = 8, WGM = 8;
__host__ __device__ __forceinline__ int lds_byte(int r, int c) { const int st = (r >> 4) * 2 + (c >> 5), rr = r & 15, cc = c & 31, ob = rr * 64 + cc * 2; return st * 1024 + (ob ^ (((ob >> 9) & 1) << 5)); }
__host__ __device__ __forceinline__ void stage_rc(int b, int& R, int& C) { const int st = b / 1024, sb = b % 1024, swz = sb ^ (((sb >> 9) & 1) << 5); R = (st >> 1) * 16 + swz / 64; C = (st & 1) * 32 + (swz % 64) / 2; }
__host__ __device__ __forceinline__ int perm32(int rho) { const int n = rho >> 4, i = rho & 15; return 8 * (i >> 2) + 4 * n + (i & 3); }
struct Unit { int pm, pn; };
template <bool I8> __device__ __forceinline__ f32x4 mma1(const bf16x8 b, const bf16x8 a, const f32x4 c) {
    if constexpr (I8) return __builtin_bit_cast(f32x4, __builtin_amdgcn_mfma_i32_16x16x64_i8(__builtin_bit_cast(i32x4, b), __builtin_bit_cast(i32x4, a), __builtin_bit_cast(i32x4, c), 0, 0, 0));
    else return __builtin_amdgcn_mfma_f32_16x16x32_bf16(b, a, c, 0, 0, 0); }
struct Gemm { const bf16_t* A; const bf16_t* Bt; int M, N, K; };
struct StaticOrder {
    int nM, nN, nwg, G, c;
    __host__ __device__ void init(int M_, int N_, int G_, int c_) { nM = M_ / BM; nN = N_ / BM; nwg = nM * nN; G = G_; c = c_; }
    __host__ __device__ bool next(int i, Unit& u) const {
        const long L = (long)i * G + c; if (L >= nwg) return false;
        int wgid = (int)L; { const int q = nwg / NXCD, r = nwg % NXCD, xcd = wgid % NXCD, off = wgid / NXCD; wgid = (xcd < r ? xcd * (q + 1) : r * (q + 1) + (xcd - r) * q) + off; }
        const int nig = WGM * nN, gid = wgid / nig, fm = gid * WGM, gsz = (nM - fm) < WGM ? (nM - fm) : WGM;
        u.pm = fm + ((wgid % nig) % gsz); u.pn = (wgid % nig) / gsz; return true;
    }
    __device__ __forceinline__ void a_ready(const Unit&) const {}
    __device__ __forceinline__ void done(const Unit&) const {}
};
struct EpiBf16 {
    static constexpr bool PERM = true, AFTER_DRAIN = false;
    bf16_t* O; int ldc;
    const float* lbp;
    const float* sa; const float* sw;
    __device__ __forceinline__ void operator()(const f32x4 (&acc)[2][2][4][2], const Unit& u, int wr, int wc, int fr, int fq) const {
        const int row0 = u.pm * BM + wr * 64 + fr; const int col0 = u.pn * BM + wc * 32 + 8 * fq;
        const bool fg = lbp && (unsigned)(u.pn - 4) < 4u;
        float sav[8]; f32x4 swv[2][2], lbv[2][2];
#pragma unroll
        for (int i = 0; i < 8; ++i) sav[i] = sa[row0 + (i >> 2) * HALF + (i & 3) * 16];
#pragma unroll
        for (int bj = 0; bj < 2; ++bj) { swv[bj][0] = *(const f32x4*)(sw + col0 + bj * HALF); swv[bj][1] = *(const f32x4*)(sw + col0 + bj * HALF + 4);
            lbv[bj][0] = fg ? *(const f32x4*)(lbp + col0 + bj * HALF - 1024) : (f32x4){0.f, 0.f, 0.f, 0.f}; lbv[bj][1] = fg ? *(const f32x4*)(lbp + col0 + bj * HALF - 1020) : (f32x4){0.f, 0.f, 0.f, 0.f}; }
#pragma unroll
        for (int ai = 0; ai < 2; ++ai)
#pragma unroll
            for (int m = 0; m < 4; ++m) { const int row = row0 + ai * HALF + m * 16; bf16_t* rowp = O + (size_t)row * ldc + col0; const float sc = sav[ai * 4 + m];
#pragma unroll
                for (int bj = 0; bj < 2; ++bj) {
                    f32x4 v0 = __builtin_convertvector(__builtin_bit_cast(i32x4, acc[ai][bj][m][0]), f32x4) * (swv[bj][0] * sc), v1 = __builtin_convertvector(__builtin_bit_cast(i32x4, acc[ai][bj][m][1]), f32x4) * (swv[bj][1] * sc);
                    if (fg) {
#pragma unroll
                        for (int i = 0; i < 4; ++i) { v0[i] = (1.f - lbv[bj][0][i]) * __builtin_amdgcn_rcpf(1.f + __builtin_amdgcn_exp2f(v0[i] * 1.4426950408889634f));
                                                      v1[i] = (1.f - lbv[bj][1][i]) * __builtin_amdgcn_rcpf(1.f + __builtin_amdgcn_exp2f(v1[i] * 1.4426950408889634f)); } }
                    u32x4 w; w.x = pk2(v0[0], v0[1]); w.y = pk2(v0[2], v0[3]); w.z = pk2(v1[0], v1[1]); w.w = pk2(v1[2], v1[3]);
                    *(u32x4*)(rowp + bj * HALF) = w; } }
    }
};
struct EpiH {
    static constexpr bool PERM = false, AFTER_DRAIN = false;
    const float* x; float* out; const float* sa; const float* sw; LAS unsigned char* scr;
    __device__ __forceinline__ void operator()(const f32x4 (&acc)[2][2][4][2], const Unit& u, int wr, int wc, int fr, int fq) const {
        const int lane = fr + 16 * fq, wid = wr * 4 + wc;
        LAS unsigned char* t = scr + wid * 2048;
        const int rr = lane >> 3, c4 = lane & 7;
        const int colb = u.pn * BM + wc * 32 + 4 * c4;
        const f32x4 swv[2] = {*(const f32x4*)(sw + colb), *(const f32x4*)(sw + colb + HALF)};
        f32x4 xv[4][2][2]; float sv[4][2];
        auto rowof = [&](int g) { return u.pm * BM + (g >> 2) * HALF + wr * 64 + (g & 3) * 16 + rr; };
#pragma unroll
        for (int g = 0; g < 4; ++g) { const int row = rowof(g); sv[g][0] = sa[row]; sv[g][1] = sa[row + 8];
#pragma unroll
            for (int bj = 0; bj < 2; ++bj)
#pragma unroll
                for (int k = 0; k < 2; ++k) xv[g][bj][k] = *(const f32x4*)(x + (size_t)(row + 8 * k) * DM + colb + bj * HALF); }
#pragma unroll
        for (int g = 0; g < 8; ++g) { const int ai = g >> 2, m = g & 3, sl = g & 3; const int row = rowof(g);
            f32x4 xc[2][2]; const float sc[2] = {sv[sl][0], sv[sl][1]};
#pragma unroll
            for (int bj = 0; bj < 2; ++bj)
#pragma unroll
                for (int k = 0; k < 2; ++k) xc[bj][k] = xv[sl][bj][k];
            if (g + 4 < 8) { const int rn = rowof(g + 4); sv[sl][0] = sa[rn]; sv[sl][1] = sa[rn + 8];
#pragma unroll
                for (int bj = 0; bj < 2; ++bj)
#pragma unroll
                    for (int k = 0; k < 2; ++k) xv[sl][bj][k] = *(const f32x4*)(x + (size_t)(rn + 8 * k) * DM + colb + bj * HALF); }
#pragma unroll
            for (int bj = 0; bj < 2; ++bj) {
                *(LAS f32x4*)(t + fr * 128 + (4 * fq) * 4) = acc[ai][bj][m][0]; *(LAS f32x4*)(t + fr * 128 + (16 + 4 * fq) * 4) = acc[ai][bj][m][1];
                asm volatile("s_waitcnt lgkmcnt(0)" ::: "memory");
#pragma unroll
                for (int k = 0; k < 2; ++k) { const f32x4 v = __builtin_convertvector(*(const LAS i32x4*)(t + (rr + 8 * k) * 128 + c4 * 16), f32x4) * (swv[bj] * sc[k]) + xc[bj][k];
                    *(f32x4*)(out + (size_t)(row + 8 * k) * DM + colb + bj * HALF) = v; }
                asm volatile("s_waitcnt lgkmcnt(0)" ::: "memory");
            }
        }
    }
};

template <class Epi, class Sched, bool ALIGN_EPI = false, bool SP2 = false, bool I8 = false>
__device__ __forceinline__ void gemm_phase(LAS unsigned char* lds, const Gemm g, const Sched& S, const Epi& E) {
    const int tid = threadIdx.x, wid = __builtin_amdgcn_readfirstlane(tid >> 6), lane = tid & 63, wr = wid >> 2, wc = wid & 3, fr = lane & 15, fq = lane >> 4;
    const int K = g.K, nt = K / BK;
    unsigned voffA[2], voffB[2];
#pragma unroll
    for (int i = 0; i < 2; ++i) { int R, C; stage_rc(tid * 16 + i * 8192, R, C); const int Rb = Epi::PERM ? ((R & ~31) + perm32(R & 31)) : R;
        voffA[i] = (unsigned)(R * K + C) * 2u; voffB[i] = (unsigned)(Rb * K + C) * 2u; }
    const size_t kstep = (size_t)(BK * 2);
    const size_t hstep = (size_t)HALF * K * 2;
    const size_t tstep = 2 * hstep;
    const unsigned ldsw = (unsigned)wid * 1024u;
    const int aoff = lds_byte(wr * 64 + fr, fq * 8), boff = lds_byte(wc * 32 + fr, fq * 8);
#define PG8_SA(b, h) (((b) * 2 + (h)) * HTB)
#define PG8_SB(b, h) ((4 + (b) * 2 + (h)) * HTB)
#define PG8_STAGE(bufoff, gbase, voff) do { _Pragma("unroll") for (int _i = 0; _i < 2; ++_i) \
        __builtin_amdgcn_global_load_lds((const unsigned*)((const char*)(gbase) + (voff)[_i]), (LAS unsigned*)(lds + (bufoff) + ldsw + _i * 8192), 16, 0, 0); } while (0)
#define PG8_LDA(dst, b, h) do { _Pragma("unroll") for (int m = 0; m < 4; ++m) _Pragma("unroll") for (int k = 0; k < 2; ++k) dst[m][k] = *(const LAS bf16x8*)(lds + PG8_SA(b, h) + aoff + m * 2048 + k * 1024); } while (0)
#define PG8_LDB(dst, b, h) do { _Pragma("unroll") for (int n = 0; n < 2; ++n) _Pragma("unroll") for (int k = 0; k < 2; ++k) dst[n][k] = *(const LAS bf16x8*)(lds + PG8_SB(b, h) + boff + n * 2048 + k * 1024); } while (0)
#define PG8_MMA(ai, bj, At, Bt) do { __builtin_amdgcn_s_setprio(1); _Pragma("unroll") for (int m = 0; m < 4; ++m) _Pragma("unroll") for (int n = 0; n < 2; ++n) _Pragma("unroll") for (int k = 0; k < 2; ++k) \
        acc[ai][bj][m][n] = mma1<I8>(Bt[n][k], At[m][k], acc[ai][bj][m][n]); __builtin_amdgcn_s_setprio(0); } while (0)
#define PG8_WAIT_V(n) asm volatile("s_waitcnt vmcnt(" #n ")" ::: "memory")
#define PG8_WAIT_L(n) asm volatile("s_waitcnt lgkmcnt(" #n ")" ::: "memory")
#define PG8_BAR __builtin_amdgcn_s_barrier()
#define PG8_SCHED __builtin_amdgcn_sched_barrier(0)
    Unit cur, nxt; int ui = 0;
    if (!S.next(0, cur)) return;
    f32x4 acc[2][2][4][2];
#pragma unroll
    for (int a = 0; a < 2; ++a)
#pragma unroll
        for (int b = 0; b < 2; ++b)
#pragma unroll
            for (int m = 0; m < 4; ++m)
#pragma unroll
                for (int n = 0; n < 2; ++n) acc[a][b][m][n] = (f32x4){0.f, 0.f, 0.f, 0.f};
    bf16x8 At[4][2], B0[2][2], B1[2][2];
    const char* cA = (const char*)g.A + (size_t)cur.pm * tstep; const char* cB = (const char*)g.Bt + (size_t)cur.pn * tstep;
    S.a_ready(cur);
    if constexpr (SP2) {
        PG8_STAGE(PG8_SB(0, 0), cB, voffB); PG8_STAGE(PG8_SB(0, 1), cB + hstep, voffB); PG8_STAGE(PG8_SA(0, 0), cA, voffA); PG8_STAGE(PG8_SA(0, 1), cA + hstep, voffA);
        if (wr == 1) PG8_BAR;
        PG8_WAIT_V(2); PG8_BAR;
        PG8_STAGE(PG8_SB(1, 0), cB + kstep, voffB); PG8_STAGE(PG8_SA(1, 0), cA + kstep, voffA); PG8_STAGE(PG8_SB(1, 1), cB + hstep + kstep, voffB);
        PG8_WAIT_V(6); PG8_BAR;
    } else {
        PG8_STAGE(PG8_SB(0, 0), cB, voffB); PG8_STAGE(PG8_SA(0, 0), cA, voffA); PG8_STAGE(PG8_SB(0, 1), cB + hstep, voffB); PG8_STAGE(PG8_SA(0, 1), cA + hstep, voffA);
        if (wr == 1) PG8_BAR;
        PG8_WAIT_V(4); PG8_BAR;
        PG8_STAGE(PG8_SB(1, 0), cB + kstep, voffB); PG8_STAGE(PG8_SA(1, 0), cA + kstep, voffA); PG8_STAGE(PG8_SB(1, 1), cB + hstep + kstep, voffB);
        PG8_WAIT_V(6); PG8_BAR;
    }
    for (;;) {
        const bool has_next = S.next(ui + 1, nxt);
        const char* nA = has_next ? (const char*)g.A + (size_t)nxt.pm * tstep : cA; const char* nB = has_next ? (const char*)g.Bt + (size_t)nxt.pn * tstep : cB;
        for (int t = 0; t < nt; t += 2) {
            const bool last = (t == nt - 2);
            const char* a1 = cA + (size_t)(t + 1) * kstep;
            const char* a2 = last ? nA : cA + (size_t)(t + 2) * kstep; const char* b2 = last ? nB : cB + (size_t)(t + 2) * kstep;
            const char* a3 = a2 + kstep; const char* b3 = b2 + kstep;
            if (last && has_next) S.a_ready(nxt);
            if constexpr (SP2) {
            PG8_LDB(B0, 0, 0); PG8_LDB(B1, 0, 1); PG8_SCHED; PG8_LDA(At, 0, 0); PG8_STAGE(PG8_SA(1, 1), a1 + hstep, voffA);
            PG8_WAIT_V(8); PG8_WAIT_L(0); PG8_BAR; PG8_MMA(0, 0, At, B0); PG8_MMA(0, 1, At, B1); PG8_BAR; PG8_SCHED;
            PG8_LDA(At, 0, 1); PG8_STAGE(PG8_SB(0, 0), b2, voffB); PG8_STAGE(PG8_SB(0, 1), b2 + hstep, voffB); PG8_STAGE(PG8_SA(0, 0), a2, voffA);
            PG8_WAIT_V(8); PG8_WAIT_L(0); PG8_BAR; PG8_MMA(1, 0, At, B0); PG8_MMA(1, 1, At, B1); PG8_BAR; PG8_SCHED;
            PG8_LDB(B0, 1, 0); PG8_LDB(B1, 1, 1); PG8_SCHED; PG8_LDA(At, 1, 0); PG8_STAGE(PG8_SA(0, 1), a2 + hstep, voffA);
            PG8_WAIT_V(8); PG8_WAIT_L(0); PG8_BAR; PG8_MMA(0, 0, At, B0); PG8_MMA(0, 1, At, B1); PG8_BAR; PG8_SCHED;
            PG8_LDA(At, 1, 1); PG8_STAGE(PG8_SB(1, 0), b3, voffB); PG8_STAGE(PG8_SB(1, 1), b3 + hstep, voffB); PG8_STAGE(PG8_SA(1, 0), a3, voffA);
            PG8_WAIT_V(8); PG8_WAIT_L(0); PG8_BAR; PG8_MMA(1, 0, At, B0); PG8_MMA(1, 1, At, B1); PG8_BAR; PG8_SCHED;
            } else {
            PG8_LDB(B0, 0, 0); PG8_SCHED; PG8_LDA(At, 0, 0); PG8_STAGE(PG8_SA(1, 1), a1 + hstep, voffA);
            PG8_WAIT_L(8); PG8_BAR; PG8_WAIT_L(0); PG8_MMA(0, 0, At, B0); PG8_BAR; PG8_SCHED;
            PG8_LDB(B1, 0, 1); PG8_STAGE(PG8_SB(0, 0), b2, voffB);
            PG8_BAR; PG8_WAIT_L(0); PG8_MMA(0, 1, At, B1); PG8_BAR;
            PG8_LDA(At, 0, 1); PG8_STAGE(PG8_SA(0, 0), a2, voffA);
            PG8_BAR; PG8_WAIT_L(0); PG8_MMA(1, 0, At, B0); PG8_BAR; PG8_SCHED;
            PG8_STAGE(PG8_SB(0, 1), b2 + hstep, voffB);
            PG8_WAIT_V(6); PG8_BAR; PG8_MMA(1, 1, At, B1); PG8_BAR;
            PG8_LDB(B0, 1, 0); PG8_SCHED; PG8_LDA(At, 1, 0); PG8_STAGE(PG8_SA(0, 1), a2 + hstep, voffA);
            PG8_WAIT_L(8); PG8_BAR; PG8_WAIT_L(0); PG8_MMA(0, 0, At, B0); PG8_BAR; PG8_SCHED;
            PG8_LDB(B1, 1, 1); PG8_STAGE(PG8_SB(1, 0), b3, voffB);
            PG8_BAR; PG8_WAIT_L(0); PG8_MMA(0, 1, At, B1); PG8_BAR;
            PG8_LDA(At, 1, 1); PG8_STAGE(PG8_SA(1, 0), a3, voffA);
            PG8_BAR; PG8_WAIT_L(0); PG8_MMA(1, 0, At, B0); PG8_BAR; PG8_SCHED;
            PG8_STAGE(PG8_SB(1, 1), b3 + hstep, voffB);
            PG8_WAIT_V(6); PG8_BAR; PG8_MMA(1, 1, At, B1); PG8_BAR;
            }
        }
        if constexpr (ALIGN_EPI) { if (wr == 0) PG8_BAR; }
        if constexpr (!Epi::AFTER_DRAIN) { E(acc, cur, wr, wc, fr, fq); S.done(cur); }
        if (!has_next) break;
#pragma unroll
        for (int a = 0; a < 2; ++a)
#pragma unroll
            for (int b = 0; b < 2; ++b)
#pragma unroll
                for (int m = 0; m < 4; ++m)
#pragma unroll
                    for (int n = 0; n < 2; ++n) acc[a][b][m][n] = (f32x4){0.f, 0.f, 0.f, 0.f};
        cur = nxt; cA = nA; cB = nB; ++ui;
        if constexpr (ALIGN_EPI) { if (wr == 1) PG8_BAR; }
    }
    PG8_WAIT_V(0);
    if constexpr (!ALIGN_EPI) { if (wr == 0) PG8_BAR; }
    PG8_BAR;
#undef PG8_SA
#undef PG8_SB
#undef PG8_STAGE
#undef PG8_LDA
#undef PG8_LDB
#undef PG8_MMA
#undef PG8_WAIT_V
#undef PG8_WAIT_L
#undef PG8_BAR
#undef PG8_SCHED
}
}

struct Args {
    const float* in[21];
    float* out; unsigned char* ws;
    int ph_lo, ph_hi;
};
enum { I_X = 0, I_N1W, I_WIN, I_LB, I_HGNW, I_QNW, I_KCNW, I_KSNW, I_KWNW, I_POSK, I_POSV, I_WCK1, I_WCK2, I_WCV1, I_WCV2, I_WOUT, I_N2W, I_WQ, I_SK, I_PU, I_PV };

constexpr float Q8_MAGIC = 12582912.f;
DI unsigned pack_q8(float t0, float t1, float t2, float t3) {
    const unsigned lo = __builtin_amdgcn_perm(__builtin_bit_cast(unsigned, t1), __builtin_bit_cast(unsigned, t0), 0x0c0c0400u);
    const unsigned hi = __builtin_amdgcn_perm(__builtin_bit_cast(unsigned, t3), __builtin_bit_cast(unsigned, t2), 0x04000c0cu);
    return lo | hi; }
DI void transpose_item(const float* W, int K, int N, int Npad, bf16_t* WT, LAS float* scr, int item, int lane, const float* kscale) {
    const int nblk = Npad / 32, kb = item / nblk, nb = item % nblk, k0 = 64 * kb, n0 = 32 * nb;
    const int n = n0 + 4 * (lane & 7);
    f32x4 v[8];
#pragma unroll
    for (int i = 0; i < 8; ++i) { const int kk = 8 * i + (lane >> 3); v[i] = (n < N) ? *(const f32x4*)(W + (size_t)(k0 + kk) * N + n) : (f32x4){0.f, 0.f, 0.f, 0.f}; }
#pragma unroll
    for (int i = 0; i < 8; ++i) { const int kk = 8 * i + (lane >> 3); f32x4 y = v[i]; if (kscale) y = y * kscale[k0 + kk];
        LAS float* d = scr + kk * 33 + 4 * (lane & 7); d[0] = y[0]; d[1] = y[1]; d[2] = y[2]; d[3] = y[3]; }
    LDS_WAIT(); asm volatile("" ::: "memory");
    const int c = lane & 7;
#pragma unroll
    for (int j = 0; j < 4; ++j) { const int nn = (lane >> 3) + 8 * j; const LAS float* s = scr + (8 * c) * 33 + nn;
        u32x4 o; o.x = pk2(s[0 * 33], s[1 * 33]); o.y = pk2(s[2 * 33], s[3 * 33]); o.z = pk2(s[4 * 33], s[5 * 33]); o.w = pk2(s[6 * 33], s[7 * 33]);
        *(u32x4*)(WT + (size_t)(n0 + nn) * K + k0 + 8 * c) = o; }
    LDS_WAIT(); asm volatile("" ::: "memory");
}

DI void coltile_q8_item(const float* W, int N, unsigned char* WT, float* wscale, LAS unsigned char* lds, int tile, int tid) {
    const int cq = tid & 3, rg = tid >> 2, n0 = 16 * tile + 4 * cq, wv = tid >> 6;
    f32x4 v[16];
#pragma unroll
    for (int i = 0; i < 16; ++i) v[i] = (n0 < N) ? *(const f32x4*)(W + (size_t)(16 * rg + i) * N + n0) : (f32x4){0.f, 0.f, 0.f, 0.f};
    f32x4 m = (f32x4){0.f, 0.f, 0.f, 0.f};
#pragma unroll
    for (int i = 0; i < 16; ++i) { m[0] = fmaxf(m[0], fabsf(v[i][0])); m[1] = fmaxf(m[1], fabsf(v[i][1])); m[2] = fmaxf(m[2], fabsf(v[i][2])); m[3] = fmaxf(m[3], fabsf(v[i][3])); }
#pragma unroll
    for (int o = 4; o < 64; o <<= 1) { m[0] = fmaxf(m[0], __shfl_xor(m[0], o)); m[1] = fmaxf(m[1], __shfl_xor(m[1], o)); m[2] = fmaxf(m[2], __shfl_xor(m[2], o)); m[3] = fmaxf(m[3], __shfl_xor(m[3], o)); }
    LAS f32x4* wm = (LAS f32x4*)(lds + 131072 + 1024);
    __syncthreads();
    if ((tid & 63) < 4) wm[wv * 4 + cq] = m;
    __syncthreads();
#pragma unroll
    for (int w = 0; w < 8; ++w) { const f32x4 t = wm[w * 4 + cq]; m[0] = fmaxf(m[0], t[0]); m[1] = fmaxf(m[1], t[1]); m[2] = fmaxf(m[2], t[2]); m[3] = fmaxf(m[3], t[3]); }
    if (rg == 0) *(f32x4*)(wscale + n0) = m * (1.f / 127.f);
#pragma unroll
    for (int c = 0; c < 4; ++c) { const float qs = m[c] > 0.f ? 127.f / m[c] : 0.f; u32x4 o;
#pragma unroll
        for (int q = 0; q < 4; ++q) o[q] = pack_q8(fmaf(v[4 * q][c], qs, Q8_MAGIC), fmaf(v[4 * q + 1][c], qs, Q8_MAGIC), fmaf(v[4 * q + 2][c], qs, Q8_MAGIC), fmaf(v[4 * q + 3][c], qs, Q8_MAGIC));
        *(u32x4*)(WT + (size_t)(n0 + c) * 2048 + 16 * rg) = o; }
}
DI void peer_conv_rows(const Args& a, int tsel, int rp0, int nrp, int lane) {
    const float* src = a.in[tsel ? I_PV : I_PU]; unsigned char* dst = a.ws + (tsel ? WS_VB : WS_UB); float* isc = (float*)(dst + TAB_SCALE_OFF);
    f32x4 v[2][8], nx[2][8];
#pragma unroll
    for (int rr = 0; rr < 2; ++rr)
#pragma unroll
        for (int q = 0; q < 8; ++q) nx[rr][q] = *(const f32x4*)(src + (size_t)(2 * rp0 + rr) * DM + 256 * q + 4 * lane);
#pragma unroll 1
    for (int k = 0; k < nrp; ++k) {
#pragma unroll
        for (int rr = 0; rr < 2; ++rr)
#pragma unroll
            for (int q = 0; q < 8; ++q) v[rr][q] = nx[rr][q];
        if (k + 1 < nrp) {
#pragma unroll
            for (int rr = 0; rr < 2; ++rr)
#pragma unroll
                for (int q = 0; q < 8; ++q) nx[rr][q] = *(const f32x4*)(src + (size_t)(2 * (rp0 + k + 1) + rr) * DM + 256 * q + 4 * lane);
        }
#pragma unroll
        for (int rr = 0; rr < 2; ++rr) { const int row = 2 * (rp0 + k) + rr; float mx = 0.f;
#pragma unroll
            for (int q = 0; q < 8; ++q) mx = fmaxf(mx, fmaxf(fmaxf(fabsf(v[rr][q][0]), fabsf(v[rr][q][1])), fmaxf(fabsf(v[rr][q][2]), fabsf(v[rr][q][3]))));
#pragma unroll
            for (int o = 1; o < 64; o <<= 1) mx = fmaxf(mx, __shfl_xor(mx, o));
            const float top = tsel ? 448.f : 127.f;
            const float sc = (mx > 0.f) ? top / mx : 1.f;
            if (lane == 0) isc[row] = (mx > 0.f) ? mx / top : 1.f;
#pragma unroll
            for (int q = 0; q < 8; ++q) { const f32x4 y = v[rr][q] * sc; int pk;
                if (tsel) { pk = __builtin_amdgcn_cvt_pk_fp8_f32(y[0], y[1], 0, false); pk = __builtin_amdgcn_cvt_pk_fp8_f32(y[2], y[3], pk, true); }
                else pk = (int)pack_q8(y[0] + Q8_MAGIC, y[1] + Q8_MAGIC, y[2] + Q8_MAGIC, y[3] + Q8_MAGIC);
                *(unsigned*)(dst + (size_t)(2 * q + (lane >> 5)) * (16384 * 128) + (size_t)row * 128 + 4 * (lane & 31)) = (unsigned)pk; } }
    }
}
DI void sk_conv_item(const Args& a, int it, int lane) {
    const float* sk = a.in[I_SK]; bf16_t* skb = (bf16_t*)(a.ws + SM_SK); const size_t e = (size_t)it * 512 + lane * 8;
    const f32x4 v0 = *(const f32x4*)(sk + e), v1 = *(const f32x4*)(sk + e + 4);
    u32x4 w; w.x = pk2(v0[0], v0[1]); w.y = pk2(v0[2], v0[3]); w.z = pk2(v1[0], v1[1]); w.w = pk2(v1[2], v1[3]);
    *(u32x4*)(skb + e) = w;
}
constexpr int FILL_RP = 4;
#ifndef FILL_SPLIT
#define FILL_SPLIT 0
#endif
constexpr int FILL_PU = 0, FILL_PV = 8192 / (8 * FILL_RP), FILL_WOUT = 2 * FILL_PV, FILL_WQ = FILL_WOUT + DM / 16, FILL_SK = FILL_WQ + DM / 16, FILL_END = FILL_SK + 64;
DI void filler_item(const Args& a, LAS unsigned char* lds, int fi, int lane, int wave) {
    LAS float* scr = (LAS float*)(lds + wave * 8704);
    if (fi < FILL_PV) peer_conv_rows(a, 0, (fi * 8 + wave) * FILL_RP, FILL_RP, lane);
    else if (fi < FILL_WOUT) peer_conv_rows(a, 1, ((fi - FILL_PV) * 8 + wave) * FILL_RP, FILL_RP, lane);
    else if (fi < FILL_WQ) coltile_q8_item(a.in[I_WOUT], DM, a.ws + WS_WOUT, (float*)(a.ws + SM_SWO), lds, fi - FILL_WOUT, wave * 64 + lane);
    else if (fi < FILL_SK) coltile_q8_item(a.in[I_WQ], DM, a.ws + WS_WQ, (float*)(a.ws + SM_SWQ), lds, fi - FILL_WQ, wave * 64 + lane);
    else sk_conv_item(a, (fi - FILL_SK) * 8 + wave, lane);
}
DI void phase_prep(const Args& a, LAS unsigned char* lds, int gw, int NGW, int lane, int wave) {
    unsigned char* ws = a.ws;
    LAS float* scr = (LAS float*)(lds + wave * 8704);
    constexpr int I_IN = (DM / 64) * (NP / 32), I_C1 = (2048 / 64) * (256 / 32), I_C2 = (256 / 64) * (64 / 32);
    constexpr int NITEMS = I_IN + 2 * I_C1 + 2 * I_C2;
    for (int it = gw + I_IN; it < NITEMS; it += NGW) {
        int r = it;
        if (r < I_IN) { continue; } r -= I_IN;
        if (r < I_C1) { transpose_item(a.in[I_WCK1], 2048, 256, 256, (bf16_t*)(ws + SM_W1K), scr, r, lane, nullptr); continue; } r -= I_C1;
        if (r < I_C1) { transpose_item(a.in[I_WCV1], 2048, 256, 256, (bf16_t*)(ws + SM_W1V), scr, r, lane, nullptr); continue; } r -= I_C1;
        if (r < I_C2) { transpose_item(a.in[I_WCK2], 256, 64, 64, (bf16_t*)(ws + SM_W2K), scr, r, lane, nullptr); continue; } r -= I_C2;
        transpose_item(a.in[I_WCV2], 256, 64, 64, (bf16_t*)(ws + SM_W2V), scr, r, lane, nullptr);
    }
    {
        const float* x = a.in[I_X]; const float* w1 = a.in[I_N1W]; unsigned char* XN = ws + WS_XN; float* sxa = (float*)(ws + WS_XN + 32 * MiB);
        f32x4 wv[8];
#pragma unroll
        for (int j = 0; j < 8; ++j) wv[j] = *(const f32x4*)(w1 + 4 * lane + 256 * j);
        for (int m2 = gw; m2 < M / 2; m2 += NGW) {
            f32x4 v[2][8];
#pragma unroll
            for (int rr = 0; rr < 2; ++rr)
#pragma unroll
                for (int j = 0; j < 8; ++j) v[rr][j] = ((const f32x4*)(x + (size_t)(2 * m2 + rr) * DM) + lane)[64 * j];
#pragma unroll
            for (int rr = 0; rr < 2; ++rr) { float s = 0.f;
#pragma unroll
                for (int j = 0; j < 8; ++j) s += (v[rr][j][0] * v[rr][j][0] + v[rr][j][1] * v[rr][j][1]) + (v[rr][j][2] * v[rr][j][2] + v[rr][j][3] * v[rr][j][3]);
                const float rstd = __builtin_amdgcn_rsqf(wave_sum(s) * (1.f / DM) + EPS);
                f32x4 y[8]; float am = 0.f;
#pragma unroll
                for (int j = 0; j < 8; ++j) { y[j] = v[rr][j] * rstd * wv[j]; am = fmaxf(am, fmaxf(fmaxf(fabsf(y[j][0]), fabsf(y[j][1])), fmaxf(fabsf(y[j][2]), fabsf(y[j][3])))); }
#pragma unroll
                for (int o = 1; o < 64; o <<= 1) am = fmaxf(am, __shfl_xor(am, o));
                const float qs = am > 0.f ? 127.f / am : 0.f;
                if (lane == 0) sxa[2 * m2 + rr] = am * (1.f / 127.f);
                unsigned* o4 = (unsigned*)(XN + (size_t)(2 * m2 + rr) * DM) + lane;
#pragma unroll
                for (int j = 0; j < 8; ++j) o4[64 * j] = pack_q8(fmaf(y[j][0], qs, Q8_MAGIC), fmaf(y[j][1], qs, Q8_MAGIC), fmaf(y[j][2], qs, Q8_MAGIC), fmaf(y[j][3], qs, Q8_MAGIC)); }
        }
    }
    {
        const int tid = threadIdx.x, blk = blockIdx.x;
        if (blk == 0) { for (int c = tid; c < 1024; c += NTHREADS) { const float l0 = a.in[I_LB][c], l1 = a.in[I_LB][1024 + c]; ((float*)(ws + SM_LB))[c] = 1.f / (1.f + __expf(l1 - l0)); } }
        if (blk >= 1 && blk <= 32) { const int part = blk - 1, mat = tid >> 8, j = tid & 255;
            const float* w1 = a.in[mat ? I_WCV1 : I_WCK1]; const float* pos = a.in[mat ? I_POSV : I_POSK]; float acc = 0.f;
            for (int i = part * 64; i < part * 64 + 64; ++i) acc += pos[i] * w1[(size_t)i * 256 + j];
            ((float*)(ws + SM_BIASP))[part * 512 + tid] = acc; }
    }
}

DI void rowquant_mix(const Args& a, int gw, int NGW, int lane) {
    const bf16_t* MIX = (const bf16_t*)(a.ws + WS_XN); unsigned char* A8 = a.ws + WS_MIX8; float* rs = (float*)(a.ws + WS_MIX8 + 32 * MiB);
    for (int row = gw; row < M; row += NGW) {
        u32x4 v[4]; float am = 0.f;
#pragma unroll
        for (int j = 0; j < 4; ++j) v[j] = ((const u32x4*)(MIX + (size_t)row * DM) + lane)[64 * j];
#pragma unroll
        for (int j = 0; j < 4; ++j)
#pragma unroll
            for (int i = 0; i < 4; ++i) am = fmaxf(am, fmaxf(fabsf(bflo(v[j][i])), fabsf(bfhi(v[j][i]))));
#pragma unroll
        for (int o = 1; o < 64; o <<= 1) am = fmaxf(am, __shfl_xor(am, o));
        const float qs = am > 0.f ? 127.f / am : 0.f;
        if (lane == 0) rs[row] = am * (1.f / 127.f);
        u32x2* o2 = (u32x2*)(A8 + (size_t)row * DM) + lane;
#pragma unroll
        for (int j = 0; j < 4; ++j) { u32x2 w;
            w.x = pack_q8(fmaf(bflo(v[j][0]), qs, Q8_MAGIC), fmaf(bfhi(v[j][0]), qs, Q8_MAGIC), fmaf(bflo(v[j][1]), qs, Q8_MAGIC), fmaf(bfhi(v[j][1]), qs, Q8_MAGIC));
            w.y = pack_q8(fmaf(bflo(v[j][2]), qs, Q8_MAGIC), fmaf(bfhi(v[j][2]), qs, Q8_MAGIC), fmaf(bflo(v[j][3]), qs, Q8_MAGIC), fmaf(bfhi(v[j][3]), qs, Q8_MAGIC));
            o2[64 * j] = w; }
    }
}
DI void rowquant_h(const Args& a, int gw, int NGW, int lane) {
    const float* w2 = a.in[I_N2W]; unsigned char* A8 = a.ws + WS_HQ8; float* rs = (float*)(a.ws + WS_DQ);
    f32x4 wv[8];
#pragma unroll
    for (int j = 0; j < 8; ++j) wv[j] = *(const f32x4*)(w2 + 4 * lane + 256 * j);
    for (int row = gw; row < M; row += NGW) {
        f32x4 v[8]; float s = 0.f, am = 0.f;
#pragma unroll
        for (int j = 0; j < 8; ++j) v[j] = ((const f32x4*)(a.out + (size_t)row * DM) + lane)[64 * j];
#pragma unroll
        for (int j = 0; j < 8; ++j) { s += (v[j][0] * v[j][0] + v[j][1] * v[j][1]) + (v[j][2] * v[j][2] + v[j][3] * v[j][3]); v[j] = v[j] * wv[j];
            am = fmaxf(am, fmaxf(fmaxf(fabsf(v[j][0]), fabsf(v[j][1])), fmaxf(fabsf(v[j][2]), fabsf(v[j][3])))); }
        s = wave_sum(s);
#pragma unroll
        for (int o = 1; o < 64; o <<= 1) am = fmaxf(am, __shfl_xor(am, o));
        const float qs = am > 0.f ? 127.f / am : 0.f;
        if (lane == 0) rs[row] = am * (1.f / 127.f) * __builtin_amdgcn_rsqf(s * (1.f / DM) + EPS);
        unsigned* o4 = (unsigned*)(A8 + (size_t)row * DM) + lane;
#pragma unroll
        for (int j = 0; j < 8; ++j) o4[64 * j] = pack_q8(fmaf(v[j][0], qs, Q8_MAGIC), fmaf(v[j][1], qs, Q8_MAGIC), fmaf(v[j][2], qs, Q8_MAGIC), fmaf(v[j][3], qs, Q8_MAGIC));
    }
}
DI int perm16(int t) { return (t & ~12) | ((t & 4) << 1) | ((t & 8) >> 1); }

DI void nsa_norm_row(const Args& a, int row, int lane) {
    bf16_t* pr = (bf16_t*)(a.ws + WS_P) + (size_t)row * NP;
    const int c8 = lane & 7;
    const f32x4 qw0 = *(const f32x4*)(a.in[I_QNW] + 8 * c8), qw1 = *(const f32x4*)(a.in[I_QNW] + 8 * c8 + 4);
    const float* kwp = a.in[lane < 32 ? I_KSNW : I_KWNW];
    const f32x4 kw0 = *(const f32x4*)(kwp + 8 * c8), kw1 = *(const f32x4*)(kwp + 8 * c8 + 4);
    bf16_t* p0 = pr + C_NQ + 8 * lane; bf16_t* p1 = pr + C_NQ + 512 + 8 * lane; bf16_t* p2 = pr + (lane < 32 ? C_NKS + 8 * lane : C_NKW + 8 * (lane - 32));
    const u32x4 v0 = *(const u32x4*)p0, v1 = *(const u32x4*)p1, v2 = *(const u32x4*)p2;
    auto nrm = [&](const u32x4 v, const f32x4 w0, const f32x4 w1, float extra) -> u32x4 {
        float f[8] = {bflo(v.x), bfhi(v.x), bflo(v.y), bfhi(v.y), bflo(v.z), bfhi(v.z), bflo(v.w), bfhi(v.w)};
        float s = 0.f;
#pragma unroll
        for (int i = 0; i < 8; ++i) s += f[i] * f[i];
        s += __shfl_xor(s, 1); s += __shfl_xor(s, 2); s += __shfl_xor(s, 4);
        const float r = __builtin_amdgcn_rsqf(s * (1.f / 64.f) + EPS) * extra;
        u32x4 o; o.x = pk2(f[0] * r * w0[0], f[1] * r * w0[1]); o.y = pk2(f[2] * r * w0[2], f[3] * r * w0[3]);
        o.z = pk2(f[4] * r * w1[0], f[5] * r * w1[1]); o.w = pk2(f[6] * r * w1[2], f[7] * r * w1[3]); return o; };
    *(u32x4*)p0 = nrm(v0, qw0, qw1, 0.125f * LOG2E);
    *(u32x4*)p1 = nrm(v1, qw0, qw1, 0.125f * LOG2E);
    *(u32x4*)p2 = nrm(v2, kw0, kw1, 1.f);
}

DI void vtrans_item(const Args& a, LAS unsigned char* scr, int item, int lane) {
    const int which = item >> 10, b = (item >> 7) & 7, g = (item >> 5) & 3, tt = item & 31;
    const bf16_t* src = (const bf16_t*)(a.ws + WS_P) + (size_t)(b * SEQ + 64 * tt + lane) * NP + (which ? C_NVW : C_NVS) + g * 64;
    u32x4 v[8];
#pragma unroll
    for (int j = 0; j < 8; ++j) v[j] = *(const u32x4*)(src + 8 * j);
    const int tp = perm16(lane);
#pragma unroll
    for (int j = 0; j < 8; ++j) {
        const unsigned w[4] = {v[j].x, v[j].y, v[j].z, v[j].w};
#pragma unroll
        for (int i = 0; i < 4; ++i) {
            *(LAS bf16_t*)(scr + (8 * j + 2 * i) * 144 + 2 * tp) = (bf16_t)(w[i] & 0xffffu);
            *(LAS bf16_t*)(scr + (8 * j + 2 * i + 1) * 144 + 2 * tp) = (bf16_t)(w[i] >> 16);
        }
    }
    LDS_WAIT(); asm volatile("" ::: "memory");
    bf16_t* dst = (bf16_t*)(a.ws + WS_VT) + (size_t)which * (32 * 64 * SEQ) + (size_t)((b * 4 + g) * 64 + lane) * SEQ + 64 * tt;
#pragma unroll
    for (int j = 0; j < 8; ++j) *(u32x4*)(dst + 8 * j) = *(const LAS u32x4*)(scr + lane * 144 + 16 * j);
    LDS_WAIT(); asm volatile("" ::: "memory");
}

DI void compress_item(const Args& a, LAS unsigned char* lds, int item, int tid, int lane, int wave) {
    const int kv = item >> 7, b = (item >> 4) & 7, g = (item >> 2) & 3, n0 = 32 * (item & 3);
    const int hi = lane >> 5, r32 = lane & 31;
    const bf16_t* P = (const bf16_t*)(a.ws + WS_P);
    const bf16_t* w1T = (const bf16_t*)(a.ws + (kv ? SM_W1V : SM_W1K));
    const bf16_t* w2T = (const bf16_t*)(a.ws + (kv ? SM_W2V : SM_W2K));
    int nabs = n0 + r32; if (nabs > 126) nabs = 126;
    const bf16_t* ap = P + (size_t)(b * SEQ + 16 * nabs) * NP + (kv ? C_NVC : C_NKC) + g * 64 + 8 * hi;
    const bf16_t* bp = w1T + (size_t)(32 * wave + r32) * 2048 + 8 * hi;
    float bpv[32]; { const float* bpart = (const float*)(a.ws + SM_BIASP) + kv * 256 + 32 * wave + r32;
#pragma unroll
        for (int p = 0; p < 32; ++p) bpv[p] = bpart[p * 512]; }
    f32x16 acc;
#pragma unroll
    for (int i = 0; i < 16; ++i) acc[i] = 0.f;
    {
        LAS unsigned char* wl = lds + 20480 + wave * 9216;
        const int r8 = lane >> 3, c8 = lane & 7;
        const bf16_t* ga[4]; const bf16_t* gb[4];
#pragma unroll
        for (int q = 0; q < 4; ++q) { int na = n0 + r8 + 8 * q; if (na > 126) na = 126;
            ga[q] = P + (size_t)(b * SEQ + 16 * na) * NP + (kv ? C_NVC : C_NKC) + g * 64 + 8 * c8;
            gb[q] = w1T + (size_t)(32 * wave + r8 + 8 * q) * 2048 + 8 * c8; }
        u32x4 ra[4], rb[4];
        auto gload = [&](int l) {
#pragma unroll
            for (int q = 0; q < 4; ++q) { ra[q] = *(const u32x4*)(ga[q] + (size_t)l * NP); rb[q] = *(const u32x4*)(gb[q] + l * 64); } };
        auto lwrite = [&]() {
#pragma unroll
            for (int q = 0; q < 4; ++q) { *(LAS u32x4*)(wl + (r8 + 8 * q) * 144 + c8 * 16) = ra[q]; *(LAS u32x4*)(wl + 4608 + (r8 + 8 * q) * 144 + c8 * 16) = rb[q]; } };
        gload(0); lwrite(); gload(1);
#pragma unroll 1
        for (int l = 0; l < 32; ++l) {
            LDS_WAIT();
            bf16x8 fa[4], fb[4];
#pragma unroll
            for (int kk = 0; kk < 4; ++kk) { fa[kk] = *(const LAS bf16x8*)(wl + r32 * 144 + 32 * kk + 16 * hi); fb[kk] = *(const LAS bf16x8*)(wl + 4608 + r32 * 144 + 32 * kk + 16 * hi); }
            LDS_WAIT();
#pragma unroll
            for (int kk = 0; kk < 4; ++kk) acc = MFMA32(fa[kk], fb[kk], acc);
            if (l + 1 < 32) { lwrite(); if (l + 2 < 32) gload(l + 2); }
        }
    }
    bf16x8 w2f[2][16];
    if (wave == 0) {
#pragma unroll
        for (int db = 0; db < 2; ++db)
#pragma unroll
            for (int ks = 0; ks < 16; ++ks) w2f[db][ks] = *(const bf16x8*)(w2T + (size_t)(32 * db + r32) * 256 + 16 * ks + 8 * hi);
    }
    float bias = 0.f;
#pragma unroll
    for (int p = 0; p < 32; ++p) bias += bpv[p];
#pragma unroll
    for (int r = 0; r < 16; ++r) { const int n = crow(r, hi); *(LAS bf16_t*)(lds + (n * 264 + 32 * wave + r32) * 2) = f2bf(gelu_tanh(acc[r] + bias)); }
    __syncthreads();
    if (wave == 0) {
        f32x16 c[2];
#pragma unroll
        for (int db = 0; db < 2; ++db) {
#pragma unroll
            for (int i = 0; i < 16; ++i) c[db][i] = 0.f;
#pragma unroll
            for (int ks = 0; ks < 16; ++ks) {
                const bf16x8 bv = *(const LAS bf16x8*)(lds + (r32 * 264 + 16 * ks + 8 * hi) * 2);
                c[db] = MFMA32(w2f[db][ks], bv, c[db]);
            }
        }
        const int bg = b * 4 + g;
        if (kv == 0) {
            float ss = 0.f;
#pragma unroll
            for (int db = 0; db < 2; ++db)
#pragma unroll
                for (int r = 0; r < 16; ++r) ss += c[db][r] * c[db][r];
            ss += __shfl_xor(ss, 32);
            const float rstd = __builtin_amdgcn_rsqf(ss * (1.f / 64.f) + EPS);
            bf16_t* kc = (bf16_t*)(a.ws + SM_KC) + (size_t)(bg * 128 + n0 + r32) * 64;
#pragma unroll
            for (int db = 0; db < 2; ++db)
#pragma unroll
                for (int c4 = 0; c4 < 4; ++c4) { const int d0 = 32 * db + 8 * c4 + 4 * hi; const f32x4 w = *(const f32x4*)(a.in[I_KCNW] + d0);
                    u32x2 o; o.x = pk2(c[db][4 * c4] * rstd * w[0], c[db][4 * c4 + 1] * rstd * w[1]); o.y = pk2(c[db][4 * c4 + 2] * rstd * w[2], c[db][4 * c4 + 3] * rstd * w[3]);
                    *(u32x2*)(kc + d0) = o; }
        } else {
            bf16_t* vct = (bf16_t*)(a.ws + SM_VCT) + (size_t)bg * 64 * 128 + perm16(n0 + r32);
#pragma unroll
            for (int db = 0; db < 2; ++db)
#pragma unroll
                for (int r = 0; r < 16; ++r) vct[(size_t)(32 * db + crow(r, hi)) * 128] = f2bf(c[db][r]);
        }
    }
    __syncthreads();
}

template <int CTRL> DI float dpp_f(float v) { return __builtin_bit_cast(float, __builtin_amdgcn_update_dpp(0, __builtin_bit_cast(int, v), CTRL, 0xf, 0xf, true)); }
template <int CTRL> DI int dpp_i(int v) { return __builtin_amdgcn_update_dpp(0, v, CTRL, 0xf, 0xf, true); }
constexpr int HL_QD = 0, HL_KD = 17408, HL_KET = 34816, HL_IT = 53248, HL_AT = 71680, HL_DEC = 80896, HL_SEG = 81408, HL_SSQ = 85504, HL_G = 87552;
static_assert(HL_G + 2 * 64 * 272 <= LDS_BYTES - 64, "hgrn LDS");
struct HgRaw { unsigned f[8], q[8], i[8]; u32x4 g[2]; };
DI void hgrn_item(const Args& a, LAS unsigned char* lds, int item, int tid, int lane, int wave) {
    const int b = item >> 3, h = item & 7;
    const bf16_t* P = (const bf16_t*)(a.ws + WS_P);
    bf16_t* MIX = (bf16_t*)(a.ws + WS_XN);
    const int c2 = tid & 63, sg = tid >> 6, l15 = lane & 15, q4 = lane >> 4;
    const f32x2 lb2 = *(const f32x2*)((const float*)(a.ws + SM_LB) + h * 128 + 2 * c2);
    const float gnw = a.in[I_HGNW][16 * wave + l15];
    const __amdgpu_buffer_rsrc_t prs = __builtin_amdgcn_make_buffer_rsrc((void*)P, 0, (int)((size_t)M * NP * 2), 0x00020000);
    const int voffA = ((8 * sg) * NP + h * 128 + 2 * c2) * 2;
    const int grow = tid >> 3, gch = tid & 7;
    const int voffG = (grow * NP + C_HG + h * 128 + 16 * gch) * 2;
    auto load_raw = [&](HgRaw& R, int n) { const int soff0 = (b * SEQ + 64 * n) * NP * 2;
#pragma unroll
        for (int tt = 0; tt < 8; ++tt) { R.f[tt] = __builtin_amdgcn_raw_buffer_load_b32(prs, voffA, soff0 + tt * NP * 2 + C_HF * 2, 0);
            R.q[tt] = __builtin_amdgcn_raw_buffer_load_b32(prs, voffA, soff0 + tt * NP * 2 + C_HQ * 2, 0);
            R.i[tt] = __builtin_amdgcn_raw_buffer_load_b32(prs, voffA, soff0 + tt * NP * 2 + C_HI * 2, 0); }
        R.g[0] = __builtin_bit_cast(u32x4, __builtin_amdgcn_raw_buffer_load_b128(prs, voffG, soff0, 0)); R.g[1] = __builtin_bit_cast(u32x4, __builtin_amdgcn_raw_buffer_load_b128(prs, voffG + 16, soff0, 0)); };
    f32x4 S[8];
#pragma unroll
    for (int i = 0; i < 8; ++i) S[i] = (f32x4){0.f, 0.f, 0.f, 0.f};
    HgRaw R; load_raw(R, 0);
    for (int n = 0; n < 32; ++n) {
        const int rowbase = b * SEQ + 64 * n;
        float cum[2][8], kk[2][8], qq[2][8]; unsigned iv[8]; float run0 = 1.f, run1 = 1.f;
#pragma unroll
        for (int tt = 0; tt < 8; ++tt) {
            kk[0][tt] = bflo(R.f[tt]); kk[1][tt] = bfhi(R.f[tt]);
            run0 *= 1.f - kk[0][tt]; run1 *= 1.f - kk[1][tt]; cum[0][tt] = run0; cum[1][tt] = run1;
            qq[0][tt] = bflo(R.q[tt]); qq[1][tt] = bfhi(R.q[tt]); iv[tt] = R.i[tt];
        }
        *(LAS u32x4*)(lds + HL_G + (n & 1) * 17408 + grow * 272 + gch * 32) = R.g[0]; *(LAS u32x4*)(lds + HL_G + (n & 1) * 17408 + grow * 272 + gch * 32 + 16) = R.g[1];
        *(LAS f32x2*)(lds + HL_SEG + (sg * 128 + 2 * c2) * 4) = (f32x2){run0, run1};
        if (n + 1 < 32) load_raw(R, n + 1);
        __syncthreads();
        float off0 = 1.f, off1 = 1.f, bend0 = 1.f, bend1 = 1.f;
#pragma unroll
        for (int s2 = 0; s2 < 8; ++s2) { const f32x2 v = *(const LAS f32x2*)(lds + HL_SEG + (s2 * 128 + 2 * c2) * 4); bend0 *= v[0]; bend1 *= v[1]; if (s2 < sg) { off0 *= v[0]; off1 *= v[1]; } }
        unsigned ke0[4], ke1[4];
#pragma unroll
        for (int tt = 0; tt < 8; ++tt) {
            const float eb0 = off0 * cum[0][tt], eb1 = off1 * cum[1][tt]; const int t = 8 * sg + tt;
            const float kd0 = kk[0][tt] * fast_rcp(eb0), kd1 = kk[1][tt] * fast_rcp(eb1);
            *(LAS unsigned*)(lds + HL_QD + (t * 136 + 2 * c2) * 2) = pk2(qq[0][tt] * eb0, qq[1][tt] * eb1);
            *(LAS unsigned*)(lds + HL_KD + (t * 136 + 2 * c2) * 2) = pk2(kd0, kd1);
            const unsigned e0 = pk2(kd0 * bend0, 0.f) & 0xffffu, e1 = pk2(kd1 * bend1, 0.f) & 0xffffu;
            if (tt & 1) { ke0[tt >> 1] |= e0 << 16; ke1[tt >> 1] |= e1 << 16; } else { ke0[tt >> 1] = e0; ke1[tt >> 1] = e1; }
        }
        *(LAS u32x4*)(lds + HL_KET + ((2 * c2) * 72 + 8 * sg) * 2) = (u32x4){ke0[0], ke0[1], ke0[2], ke0[3]};
        *(LAS u32x4*)(lds + HL_KET + ((2 * c2 + 1) * 72 + 8 * sg) * 2) = (u32x4){ke1[0], ke1[1], ke1[2], ke1[3]};
        { u32x4 i0, i1;
#pragma unroll
          for (int k = 0; k < 4; ++k) { i0[k] = (iv[2 * k] & 0xffffu) | (iv[2 * k + 1] << 16); i1[k] = (iv[2 * k] >> 16) | (iv[2 * k + 1] & 0xffff0000u); }
          *(LAS u32x4*)(lds + HL_IT + ((2 * c2) * 72 + 8 * sg) * 2) = i0; *(LAS u32x4*)(lds + HL_IT + ((2 * c2 + 1) * 72 + 8 * sg) * 2) = i1; }
        if (sg == 0) *(LAS f32x2*)(lds + HL_DEC + 2 * c2 * 4) = (f32x2){bend0, bend1};
        __syncthreads();
#pragma unroll
        for (int u = 0; u < 2; ++u) {
            const int tile = 2 * wave + u, tb = tile >> 2, sb = tile & 3;
            f32x4 acc = (f32x4){0.f, 0.f, 0.f, 0.f};
            if (sb <= tb) {
#pragma unroll
                for (int ks = 0; ks < 4; ++ks) {
                    const bf16x8 av = *(const LAS bf16x8*)(lds + HL_QD + ((16 * tb + l15) * 136 + 32 * ks + 8 * q4) * 2);
                    const bf16x8 bv = *(const LAS bf16x8*)(lds + HL_KD + ((16 * sb + l15) * 136 + 32 * ks + 8 * q4) * 2);
                    acc = MFMA16(av, bv, acc);
                }
            }
#pragma unroll
            for (int r = 0; r < 4; ++r) { const int t = 16 * tb + 4 * q4 + r, s2 = 16 * sb + l15;
                *(LAS bf16_t*)(lds + HL_AT + (t * 72 + s2) * 2) = f2bf(s2 <= t ? acc[r] : 0.f); }
        }
        __syncthreads();
        f32x4 o[4];
        bf16x8 sfrag[4];
#pragma unroll
        for (int ks = 0; ks < 4; ++ks) { u32x4 w; w.x = pk2(S[2 * ks][0], S[2 * ks][1]); w.y = pk2(S[2 * ks][2], S[2 * ks][3]); w.z = pk2(S[2 * ks + 1][0], S[2 * ks + 1][1]); w.w = pk2(S[2 * ks + 1][2], S[2 * ks + 1][3]);
            sfrag[ks] = __builtin_bit_cast(bf16x8, w); }
        bf16x8 itf[2];
#pragma unroll
        for (int ks = 0; ks < 2; ++ks) itf[ks] = *(const LAS bf16x8*)(lds + HL_IT + ((16 * wave + l15) * 72 + 32 * ks + 8 * q4) * 2);
#pragma unroll
        for (int tb = 0; tb < 4; ++tb) {
            o[tb] = (f32x4){0.f, 0.f, 0.f, 0.f};
#pragma unroll
            for (int ks = 0; ks < 2; ++ks) {
                const bf16x8 av = *(const LAS bf16x8*)(lds + HL_AT + ((16 * tb + l15) * 72 + 32 * ks + 8 * q4) * 2);
                o[tb] = MFMA16(av, itf[ks], o[tb]);
            }
#pragma unroll
            for (int ks = 0; ks < 4; ++ks) {
                const u32x2 lo = *(const LAS u32x2*)(lds + HL_QD + ((16 * tb + l15) * 136 + 32 * ks + 4 * q4) * 2);
                const u32x2 hi2 = *(const LAS u32x2*)(lds + HL_QD + ((16 * tb + l15) * 136 + 32 * ks + 16 + 4 * q4) * 2);
                const bf16x8 av = __builtin_bit_cast(bf16x8, (u32x4){lo.x, lo.y, hi2.x, hi2.y});
                o[tb] = MFMA16(av, sfrag[ks], o[tb]);
            }
        }
#pragma unroll
        for (int cb = 0; cb < 8; ++cb) {
            const f32x4 d4 = *(const LAS f32x4*)(lds + HL_DEC + (16 * cb + 4 * q4) * 4);
            S[cb] = S[cb] * d4;
#pragma unroll
            for (int ks = 0; ks < 2; ++ks) {
                const bf16x8 av = *(const LAS bf16x8*)(lds + HL_KET + ((16 * cb + l15) * 72 + 32 * ks + 8 * q4) * 2);
                S[cb] = MFMA16(av, itf[ks], S[cb]);
            }
        }
#pragma unroll
        for (int tb = 0; tb < 4; ++tb)
#pragma unroll
            for (int r = 0; r < 4; ++r) { float v = o[tb][r] * o[tb][r];
                v += dpp_f<0xB1>(v); v += dpp_f<0x4E>(v); v += dpp_f<0x141>(v); v += dpp_f<0x140>(v);
                if (l15 == 0) *(LAS float*)(lds + HL_SSQ + (wave * 64 + 16 * tb + 4 * q4 + r) * 4) = v; }
        __syncthreads();
        float rs_mine; { const int tm = 16 * (l15 >> 2) + 4 * q4 + (l15 & 3); float tot = 0.f;
#pragma unroll
            for (int w = 0; w < 8; ++w) tot += *(const LAS float*)(lds + HL_SSQ + (w * 64 + tm) * 4);
            rs_mine = __builtin_amdgcn_rsqf(tot * (1.f / 128.f) + EPS); }
#pragma unroll
        for (int tb = 0; tb < 4; ++tb)
#pragma unroll
            for (int r = 0; r < 4; ++r) { const int t = 16 * tb + 4 * q4 + r;
                const float rstd = __shfl(rs_mine, (lane & 48) + 4 * tb + r);
                const float g = bf2f(*(const LAS bf16_t*)(lds + HL_G + (n & 1) * 17408 + t * 272 + (16 * wave + l15) * 2));
                MIX[(size_t)(rowbase + t) * DM + h * 128 + 16 * wave + l15] = f2bf(o[tb][r] * rstd * gnw * (g * sigmoidf_(g))); }
    }
}

constexpr int AL_K = 0, AL_V = 18432, AL_IMP = 36864, AL_SELM = 70656, AL_STASH = 71680;
static_assert(AL_STASH + 8 * 8192 <= LDS_BYTES - 64, "attention LDS");
constexpr float NEGBIG = -1e30f;
DI bf16x8 pack8(const f32x16& p, int s) {
    u32x4 w; w.x = pk2(p[8 * s], p[8 * s + 1]); w.y = pk2(p[8 * s + 2], p[8 * s + 3]); w.z = pk2(p[8 * s + 4], p[8 * s + 5]); w.w = pk2(p[8 * s + 6], p[8 * s + 7]);
    return __builtin_bit_cast(bf16x8, w);
}
DI void attn_scores(LAS unsigned char* lds, int buf, const bf16x8 (&qf)[4], f32x16& p0, f32x16& p1, int q32, int hi) {
    const LAS unsigned char* kb = lds + AL_K + buf * 9216 + q32 * 144 + hi * 16;
#pragma unroll
    for (int i = 0; i < 16; ++i) { p0[i] = 0.f; p1[i] = 0.f; }
#pragma unroll
    for (int kk = 0; kk < 4; ++kk) {
        const bf16x8 a0 = *(const LAS bf16x8*)(kb + kk * 32), a1 = *(const LAS bf16x8*)(kb + 32 * 144 + kk * 32);
        p0 = MFMA32(a0, qf[kk], p0); p1 = MFMA32(a1, qf[kk], p1);
    }
}
DI void attn_pv(LAS unsigned char* lds, int buf, const f32x16& p0, const f32x16& p1, f32x16 (&o)[2], int q32, int hi) {
    const LAS unsigned char* vb = lds + AL_V + buf * 9216 + q32 * 144 + hi * 16;
    const bf16x8 pb0 = pack8(p0, 0), pb1 = pack8(p0, 1), pb2 = pack8(p1, 0), pb3 = pack8(p1, 1);
#pragma unroll
    for (int db = 0; db < 2; ++db) {
        const LAS unsigned char* v2 = vb + db * 32 * 144;
        o[db] = MFMA32(*(const LAS bf16x8*)(v2), pb0, o[db]);
        o[db] = MFMA32(*(const LAS bf16x8*)(v2 + 32), pb1, o[db]);
        o[db] = MFMA32(*(const LAS bf16x8*)(v2 + 64), pb2, o[db]);
        o[db] = MFMA32(*(const LAS bf16x8*)(v2 + 96), pb3, o[db]);
    }
}
DI void attn_scores_biased(LAS unsigned char* lds, int buf, const bf16x8 (&qf)[4], const f32x16& a0, const f32x16& a1, f32x16& p0, f32x16& p1, int q32, int hi) {
    const LAS unsigned char* kb = lds + AL_K + buf * 9216 + q32 * 144 + hi * 16;
    p0 = MFMA32(*(const LAS bf16x8*)(kb), qf[0], a0); p1 = MFMA32(*(const LAS bf16x8*)(kb + 32 * 144), qf[0], a1);
#pragma unroll
    for (int kk = 1; kk < 4; ++kk) {
        p0 = MFMA32(*(const LAS bf16x8*)(kb + kk * 32), qf[kk], p0); p1 = MFMA32(*(const LAS bf16x8*)(kb + 32 * 144 + kk * 32), qf[kk], p1);
    }
}
template <int MODE>
DI void attn_stream(LAS unsigned char* lds, const bf16_t* kbase, const bf16_t* vbase, unsigned tmask, unsigned fullmask, unsigned mymask, int cur, int tq, float slope2, float gate,
                    const bf16x8 (&qf)[4], const f32x16& a0, const f32x16& a1, f32x16 (&o)[2], int tid, int q32, int hi) {
    const int srow = tid >> 3, sch = tid & 7;
    float m = NEGBIG, lsum = 0.f;
#pragma unroll
    for (int i = 0; i < 16; ++i) { o[0][i] = 0.f; o[1][i] = 0.f; }
    auto next_tile = [&]() -> int { if (!tmask) return -1; const int t = 31 - __clz(tmask); tmask &= ~(1u << t); return t; };
    int j = next_tile();
    u32x4 kA = *(const u32x4*)(kbase + (size_t)(64 * j + srow) * NP + 8 * sch), vA = *(const u32x4*)(vbase + (size_t)srow * SEQ + 64 * j + 8 * sch);
    u32x4 kB = kA, vB = vA;
    int jn = next_tile();
    if (jn >= 0) { kB = *(const u32x4*)(kbase + (size_t)(64 * jn + srow) * NP + 8 * sch); vB = *(const u32x4*)(vbase + (size_t)srow * SEQ + 64 * jn + 8 * sch); }
    __syncthreads();
    *(LAS u32x4*)(lds + AL_K + srow * 144 + sch * 16) = kA; *(LAS u32x4*)(lds + AL_V + srow * 144 + sch * 16) = vA;
    __syncthreads();
    auto step = [&](u32x4& kL, u32x4& vL, const u32x4& kS, const u32x4& vS, const int bufc) -> bool {
        const int jnn = (jn >= 0) ? next_tile() : -1;
        if (jnn >= 0) { kL = *(const u32x4*)(kbase + (size_t)(64 * jnn + srow) * NP + 8 * sch); vL = *(const u32x4*)(vbase + (size_t)srow * SEQ + 64 * jnn + 8 * sch); }
        f32x16 p0, p1;
        attn_scores_biased(lds, bufc, qf, a0, a1, p0, p1, q32, hi);
        const float Bj = -slope2 * (float)(64 * (cur - j));
        if (!((fullmask >> j) & 1u)) {
            const bool selv = (MODE == 0) ? (((mymask >> j) & 1u) != 0u) : true;
            float basef = (float)(tq - 64 * j - 4 * hi); asm volatile("" : "+v"(basef));
#pragma unroll
            for (int r = 0; r < 16; ++r) {
                const float d0 = basef - (float)((r & 3) + 8 * (r >> 2)), d1 = d0 - 32.f;
                const bool v0 = (MODE == 0) ? (selv && d0 >= 0.f) : (d0 >= 0.f && d0 < 512.f);
                const bool v1 = (MODE == 0) ? (selv && d1 >= 0.f) : (d1 >= 0.f && d1 < 512.f);
                p0[r] = v0 ? p0[r] : NEGBIG; p1[r] = v1 ? p1[r] : NEGBIG;
            }
        }
        float mx = fmaxf(p0[0], p1[0]);
#pragma unroll
        for (int r = 1; r < 16; ++r) mx = fmaxf(mx, fmaxf(p0[r], p1[r]));
        mx = fmaxf(mx, __shfl_xor(mx, 32));
        const float mcand = mx + Bj;
        if (__any(mcand > m)) {
            const float mnew = fmaxf(m, mcand), alpha = fast_exp2(m - mnew); m = mnew; lsum *= alpha;
#pragma unroll
            for (int i = 0; i < 16; ++i) { o[0][i] *= alpha; o[1][i] *= alpha; }
        }
        const float madj = m - Bj;
        float ps = 0.f;
#pragma unroll
        for (int r = 0; r < 16; ++r) { p0[r] = fast_exp2(p0[r] - madj); p1[r] = fast_exp2(p1[r] - madj); ps += p0[r] + p1[r]; }
        lsum += ps;
        attn_pv(lds, bufc, p0, p1, o, q32, hi);
        if (jn < 0) return false;
        *(LAS u32x4*)(lds + AL_K + (bufc ^ 1) * 9216 + srow * 144 + sch * 16) = kS; *(LAS u32x4*)(lds + AL_V + (bufc ^ 1) * 9216 + srow * 144 + sch * 16) = vS;
        __syncthreads();
        j = jn; jn = jnn;
        return true;
    };
    for (;;) { if (!step(kA, vA, kB, vB, 0)) break; if (!step(kB, vB, kA, vA, 1)) break; }
    const float ltot = lsum + __shfl_xor(lsum, 32);
    const float sc = (m > -1e29f) ? gate * fast_rcp(ltot) : 0.f;
#pragma unroll
    for (int i = 0; i < 16; ++i) { o[0][i] *= sc; o[1][i] *= sc; }
}

DI void attn_item(const Args& a, LAS unsigned char* lds, int item, int tid, int lane, int wave) {
    const int qt = 31 - (item >> 5), b = (item >> 2) & 7, g = item & 3, bg = b * 4 + g;
    const int cur = qt, t0 = 64 * qt, r = wave >> 1, head = 4 * g + r, q32 = lane & 31, hi = lane >> 5, tl = 32 * (wave & 1) + q32, tq = t0 + tl;
    const bf16_t* P = (const bf16_t*)(a.ws + WS_P);
    const float slope2 = exp2f(-0.5f * (float)(head + 1)) * LOG2E;
    const bf16_t* prow = P + (size_t)(b * SEQ + tq) * NP;
    bf16x8 qf[4];
#pragma unroll
    for (int kk = 0; kk < 4; ++kk) qf[kk] = *(const bf16x8*)(prow + C_NQ + head * 64 + 16 * kk + 8 * hi);
    const float g0 = sigmoidf_(bf2f(prow[C_GATE + head * 3])), g1 = sigmoidf_(bf2f(prow[C_GATE + head * 3 + 1])), g2 = sigmoidf_(bf2f(prow[C_GATE + head * 3 + 2]));
    LAS float* stash = (LAS float*)(lds + AL_STASH + wave * 8192) + lane;
    const int srow = tid >> 3, sch = tid & 7;
    {
        const int ntile = (qt >= 16) ? 2 : 1;
        const bf16_t* kc = (const bf16_t*)(a.ws + SM_KC) + (size_t)bg * 128 * 64;
        const bf16_t* vct = (const bf16_t*)(a.ws + SM_VCT) + (size_t)bg * 64 * 128;
        {
            const u32x4 k0 = *(const u32x4*)(kc + (size_t)srow * 64 + 8 * sch), v0 = *(const u32x4*)(vct + (size_t)srow * 128 + 8 * sch);
            u32x4 k1 = k0, v1 = v0;
            if (ntile == 2) { k1 = *(const u32x4*)(kc + (size_t)(64 + srow) * 64 + 8 * sch); v1 = *(const u32x4*)(vct + (size_t)srow * 128 + 64 + 8 * sch); }
            *(LAS u32x4*)(lds + AL_K + srow * 144 + sch * 16) = k0; *(LAS u32x4*)(lds + AL_V + srow * 144 + sch * 16) = v0;
            *(LAS u32x4*)(lds + AL_K + 9216 + srow * 144 + sch * 16) = k1; *(LAS u32x4*)(lds + AL_V + 9216 + srow * 144 + sch * 16) = v1;
        }
        __syncthreads();
        f32x16 p[4];
        attn_scores(lds, 0, qf, p[0], p[1], q32, hi);
        attn_scores(lds, 1, qf, p[2], p[3], q32, hi);
        float mx = NEGBIG;
#pragma unroll
        for (int kb = 0; kb < 4; ++kb)
#pragma unroll
            for (int rr = 0; rr < 16; ++rr) { const int n = 32 * kb + crow(rr, hi); const int d = tq - (16 * n + 31);
                const bool v = (d >= 0) && (kb < 2 * ntile);
                p[kb][rr] = v ? p[kb][rr] - slope2 * (float)d : NEGBIG; mx = fmaxf(mx, p[kb][rr]); }
        mx = fmaxf(mx, __shfl_xor(mx, 32));
        float ps = 0.f;
#pragma unroll
        for (int kb = 0; kb < 4; ++kb)
#pragma unroll
            for (int rr = 0; rr < 16; ++rr) { p[kb][rr] = fast_exp2(p[kb][rr] - mx); ps += p[kb][rr]; }
        ps += __shfl_xor(ps, 32);
        const float inv = (mx > -1e29f) ? fast_rcp(ps) : 0.f;
#pragma unroll
        for (int kb = 0; kb < 4; ++kb)
#pragma unroll
            for (int rr = 0; rr < 16; ++rr) p[kb][rr] *= inv;
        float rc_prev = 0.f;
#pragma unroll
        for (int k = 0; k < 16; ++k) { const int kb = k >> 2, c4 = k & 3; const float bc = p[kb][4 * c4 + 3]; const float av = (p[kb][4 * c4] + p[kb][4 * c4 + 1]) + (p[kb][4 * c4 + 2] + bc);
            const float rc = __shfl_xor(bc, 32); const float v = av + (hi ? rc : rc_prev); rc_prev = rc;
            *(LAS float*)(lds + AL_IMP + ((r * 64 + tl) * 33 + 2 * k + hi) * 4) = v; }
        f32x16 o[2];
#pragma unroll
        for (int i = 0; i < 16; ++i) { o[0][i] = 0.f; o[1][i] = 0.f; }
        attn_pv(lds, 0, p[0], p[1], o, q32, hi);
        if (ntile == 2) attn_pv(lds, 1, p[2], p[3], o, q32, hi);
#pragma unroll
        for (int i = 0; i < 16; ++i) { stash[i * 64] = g0 * o[0][i]; stash[(16 + i) * 64] = g0 * o[1][i]; }
    }
    __syncthreads();
    {
        const int tok = tid >> 3, jg = tid & 7;
        float v[32];
#pragma unroll
        for (int j = 0; j < 32; ++j) { float s = 0.f;
#pragma unroll
            for (int rr = 0; rr < 4; ++rr) s += *(const LAS float*)(lds + AL_IMP + ((rr * 64 + tok) * 33 + j) * 4);
            const bool forced = (j == 0) || (j == cur) || (j == cur - 1);
            v[j] = forced ? 1e9f : ((j > cur) ? -1e9f : s); }
        unsigned bits = 0u;
#pragma unroll
        for (int i = 0; i < 4; ++i) {
            float mine = 0.f;
#pragma unroll
            for (int j = 0; j < 32; ++j) if ((j >> 2) == jg && (j & 3) == i) mine = v[j];
            const int jme = 4 * jg + i; int rank = 0;
#pragma unroll
            for (int j = 0; j < 32; ++j) rank += (v[j] > mine || (v[j] == mine && j < jme)) ? 1 : 0;
            if (rank < 16) bits |= 1u << jme;
        }
        bits |= __shfl_xor(bits, 1); bits |= __shfl_xor(bits, 2); bits |= __shfl_xor(bits, 4);
        if (jg == 0) *(LAS unsigned*)(lds + AL_SELM + tok * 4) = bits;
    }
    __syncthreads();
    unsigned umask = *(const LAS unsigned*)(lds + AL_SELM + lane * 4);
#pragma unroll
    for (int o2 = 1; o2 < 64; o2 <<= 1) umask |= __shfl_xor(umask, o2);
    const unsigned mymask = *(const LAS unsigned*)(lds + AL_SELM + tl * 4);
    const unsigned causal = (cur == 31) ? 0xffffffffu : ((1u << (cur + 1)) - 1u);
    umask = __builtin_amdgcn_readfirstlane(umask & causal);
    f32x16 ob[2];
    f32x16 ab0, ab1;
#pragma unroll
    for (int rr = 0; rr < 16; ++rr) { ab0[rr] = slope2 * (float)(crow(rr, hi) - tl); ab1[rr] = slope2 * (float)(crow(rr, hi) + 32 - tl); }
    unsigned amask = *(const LAS unsigned*)(lds + AL_SELM + lane * 4);
#pragma unroll
    for (int o2 = 1; o2 < 64; o2 <<= 1) amask &= __shfl_xor(amask, o2);
    const unsigned below = (1u << cur) - 1u;
    const unsigned sfull = __builtin_amdgcn_readfirstlane(amask) & below;
    attn_stream<0>(lds, P + (size_t)(b * SEQ) * NP + C_NKS + g * 64, (const bf16_t*)(a.ws + WS_VT) + (size_t)bg * 64 * SEQ, umask, sfull, mymask, cur, tq, slope2, g1, qf, ab0, ab1, ob, tid, q32, hi);
#pragma unroll
    for (int i = 0; i < 16; ++i) { stash[i * 64] += ob[0][i]; stash[(16 + i) * 64] += ob[1][i]; }
    const int wlo = cur >= 8 ? cur - 8 : 0;
    const unsigned wmask = causal & ~((1u << wlo) - 1u);
    const unsigned wfull = below & ~((1u << (cur >= 7 ? cur - 7 : 0)) - 1u);
    attn_stream<1>(lds, P + (size_t)(b * SEQ) * NP + C_NKW + g * 64, (const bf16_t*)(a.ws + WS_VT) + (size_t)(32 * 64 * SEQ) + (size_t)bg * 64 * SEQ, wmask, wfull, 0u, cur, tq, slope2, g2, qf, ab0, ab1, ob, tid, q32, hi);
#pragma unroll
    for (int i = 0; i < 16; ++i) { ob[0][i] += stash[i * 64]; ob[1][i] += stash[(16 + i) * 64]; }
    bf16_t* mo = (bf16_t*)(a.ws + WS_XN) + (size_t)(b * SEQ + tq) * DM + 1024 + head * 64;
#pragma unroll
    for (int db = 0; db < 2; ++db)
#pragma unroll
        for (int c4 = 0; c4 < 4; ++c4) { u32x2 w; w.x = pk2(ob[db][4 * c4], ob[db][4 * c4 + 1]); w.y = pk2(ob[db][4 * c4 + 2], ob[db][4 * c4 + 3]);
            *(u32x2*)(mo + 32 * db + 8 * c4 + 4 * hi) = w; }
}

DI unsigned f2sort(float f) { const unsigned u = __float_as_uint(f); return u ^ ((u >> 31) ? 0xffffffffu : 0x80000000u); }
DI float sort2f(unsigned u) { return __uint_as_float(u ^ ((u >> 31) ? 0x80000000u : 0xffffffffu)); }
DI void ce_desc(unsigned& x, unsigned& y) { const unsigned hi = max(x, y), lo = min(x, y); x = hi; y = lo; }
template <int NA> DI void sort16_desc(unsigned (&a)[NA], const int off) {
#pragma unroll
    for (int ks = 1; ks <= 4; ++ks)
#pragma unroll
        for (int js = 0; js < 4; ++js) { const int k = 1 << ks, jb = ks - 1 - js;
            if (jb >= 0) { const int j = 1 << jb;
#pragma unroll
                for (int i = 0; i < 16; ++i) { const int l = i ^ j; if (l > i) { if ((i & k) == 0) ce_desc(a[off + i], a[off + l]); else ce_desc(a[off + l], a[off + i]); } } } }
}
template <int NA> DI void merge_top16(unsigned (&a)[NA], const int oa, const int ob) {
#pragma unroll
    for (int i = 0; i < 16; ++i) a[oa + i] = max(a[oa + i], a[ob + 15 - i]);
#pragma unroll
    for (int js = 0; js < 4; ++js) { const int j = 8 >> js;
#pragma unroll
        for (int i = 0; i < 16; ++i) { const int l = i ^ j; if (l > i) ce_desc(a[oa + i], a[oa + l]); } }
}
DI void top16_of_64(unsigned (&a)[64]) { sort16_desc(a, 0); sort16_desc(a, 16); sort16_desc(a, 32); sort16_desc(a, 48); merge_top16(a, 0, 16); merge_top16(a, 32, 48); merge_top16(a, 0, 32); }
DI void topk_item(const Args& a, LAS unsigned char* wl, int item, int lane, LAS unsigned* lcnt) {
    const int tt = item >> 3, h = item & 7, q32 = lane & 31, hi = lane >> 5, tok = 32 * tt + q32;
    const __amdgpu_buffer_rsrc_t SKb = __builtin_amdgcn_make_buffer_rsrc((void*)(a.ws + SM_SK), 0, 524288, 0x00020000);
    const __amdgpu_buffer_rsrc_t Qb = __builtin_amdgcn_make_buffer_rsrc((void*)(a.ws + WS_QP), 0, 64 << 20, 0x00020000);
    LAS unsigned* tab = (LAS unsigned*)wl;
    unsigned top[2][16];
#pragma unroll
    for (int p = 0; p < 2; ++p) {
        f32x16 acc[4];
#pragma unroll
        for (int kb = 0; kb < 4; ++kb)
#pragma unroll
            for (int i = 0; i < 16; ++i) acc[kb][i] = 0.f;
        const int kvo = (q32 * 128 + 8 * hi) * 2, qvo = (q32 * DM + 8 * hi) * 2;
#pragma unroll
        for (int ks = 0; ks < 8; ++ks) {
            const bf16x8 qv = __builtin_bit_cast(bf16x8, __builtin_amdgcn_raw_buffer_load_b128(Qb, qvo, ((32 * tt) * DM + h * 256 + p * 128 + 16 * ks) * 2, 0));
#pragma unroll
            for (int kb = 0; kb < 4; ++kb) acc[kb] = MFMA32(__builtin_bit_cast(bf16x8, __builtin_amdgcn_raw_buffer_load_b128(SKb, kvo, (((h * 2 + p) * 128 + 32 * kb) * 128 + 16 * ks) * 2, 0)), qv, acc[kb]);
        }
        int h4 = 4 * hi; asm volatile("" : "+v"(h4));
        unsigned key[64];
#pragma unroll
        for (int kb = 0; kb < 4; ++kb)
#pragma unroll
            for (int r = 0; r < 16; ++r) key[kb * 16 + r] = (f2sort(acc[kb][r]) & ~127u) | (unsigned)(127 - (32 * kb + (r & 3) + 8 * (r >> 2)) - h4);
        top16_of_64(key);
#pragma unroll
        for (int i = 0; i < 16; ++i) key[16 + i] = (unsigned)__shfl_xor((int)key[i], 32);
        merge_top16(key, 0, 16);
#pragma unroll
        for (int i = 0; i < 16; ++i) { top[p][i] = key[i]; tab[(p * 16 + i) * 64 + lane] = key[i]; }
    }
    unsigned cand[64]; { int n = 0;
#pragma unroll
        for (int i = 0; i < 16; ++i)
#pragma unroll
            for (int j = 0; j < 16; ++j) if ((i + 1) * (j + 1) <= 16) { cand[n] = (f2sort(sort2f(top[0][i] & ~127u) + sort2f(top[1][j] & ~127u)) & ~255u) | (unsigned)(255 - (16 * i + j)); ++n; }
#pragma unroll
        for (int i = 50; i < 64; ++i) cand[i] = 0u; }
    top16_of_64(cand);
    const float vmax = sort2f(cand[0] & ~255u);
    float e[16], esum = 0.f; unsigned ex[16];
#pragma unroll
    for (int rd = 0; rd < 16; ++rd) {
        const unsigned m = cand[rd]; const int cidx = 255 - (int)(m & 255u), ci = cidx >> 4, cj = cidx & 15;
        e[rd] = __expf(sort2f(m & ~255u) - vmax); esum += e[rd];
        const unsigned i0 = 127u - (tab[ci * 64 + lane] & 127u), i1 = 127u - (tab[(16 + cj) * 64 + lane] & 127u);
        ex[rd] = i0 * 128u + i1;
    }
    if (hi == 0) {
        LAS unsigned* cnt = lcnt + (q32 >> 4) * 16; unsigned* lt = (unsigned*)(a.ws + WS_LIST) + (size_t)(2 * tt + (q32 >> 4)) * 2048; unsigned* lm = (unsigned*)(a.ws + WS_LISTM) + (size_t)(2 * tt + (q32 >> 4)) * 4096;
        unsigned* pidx = (unsigned*)(a.ws + WS_PIDX) + (size_t)tok * 128 + h * 16; unsigned pos[16];
#pragma unroll
        for (int rd = 0; rd < 16; ++rd) { const unsigned g = ex[rd] >> 10, el = ex[rd] & 1023u;
            pos[rd] = __hip_atomic_fetch_add(cnt + g, 1u, __ATOMIC_RELAXED, __HIP_MEMORY_SCOPE_WORKGROUP);
            const unsigned ent = (el << 7) | (((el >> 1) & 7u) << 4) | ((unsigned)(q32 & 3) << 17) | ((unsigned)((q32 >> 2) & 3) << 24), p = pos[rd];
            if (p < 256u) lm[g * 256u + (p >> 6) * 64u + (p & 15u) * 4u + ((p >> 4) & 3u)] = ent;
            if (p >= 192u) lt[(size_t)g * (1024 * 2048) + (p & 15u) * 128u + (p >> 4)] = ent; }
#pragma unroll
        for (int k4 = 0; k4 < 4; ++k4) *(u32x4*)(pidx + 4 * k4) = (u32x4){pos[4 * k4], pos[4 * k4 + 1], pos[4 * k4 + 2], pos[4 * k4 + 3]};
        const float inv = 1.f / esum;
        unsigned* ei = (unsigned*)(a.ws + WS_EI) + (size_t)tok * 128 + h * 16; float* eg = (float*)(a.ws + WS_EG) + (size_t)tok * 128 + h * 16;
#pragma unroll
        for (int k4 = 0; k4 < 4; ++k4) {
            *(u32x4*)(ei + 4 * k4) = (u32x4){ex[4 * k4], ex[4 * k4 + 1], ex[4 * k4 + 2], ex[4 * k4 + 3]};
            *(f32x4*)(eg + 4 * k4) = (f32x4){e[4 * k4] * inv, e[4 * k4 + 1] * inv, e[4 * k4 + 2] * inv, e[4 * k4 + 3] * inv};
        }
    }
}

#define XB_TMO      128
#define XB_XCNT(j)  (256  + 64 * (j))
#define XB_XSUB(j)  (1280 + 64 * (j))
#define XB_XGEN(j)  (2304 + 64 * (j))
#define XB_TOP      3328
#define XB_TOPGEN   3392
#define XCD_BAR_WORDS 3456
#define XB_SPIN_CAP (1u << 22)
DI unsigned xb_ld(unsigned* p)              { return __hip_atomic_load(p, __ATOMIC_RELAXED, __HIP_MEMORY_SCOPE_AGENT); }
DI unsigned xb_add(unsigned* p, unsigned v) { return __hip_atomic_fetch_add(p, v, __ATOMIC_RELAXED, __HIP_MEMORY_SCOPE_AGENT); }
DI unsigned xb_xcc_id() { return (unsigned)__builtin_amdgcn_s_getreg((3 << 11) | 20) & 0xFu; }
#define XB_SPIN(cond, bar) do { unsigned _sp = 0; while (cond) { __builtin_amdgcn_s_sleep(1); \
    if ((++_sp & 255u) == 0u) { if (xb_ld(&(bar)[XB_TMO])) break; if (_sp > XB_SPIN_CAP) { atomicAdd(&(bar)[XB_TMO], 1u); break; } } } } while (0)
struct XcdBarrier { unsigned* bar; unsigned x; volatile LAS unsigned* st; };
DI XcdBarrier xcd_barrier_post(unsigned* bar, volatile LAS unsigned* st) {
    XcdBarrier b; b.bar = bar; b.x = xb_xcc_id(); b.st = st;
    if (threadIdx.x == 0) (void)xb_add(&bar[XB_XCNT(b.x)], 1u);
    return b;
}
DI void xcd_barrier_complete(unsigned* bar, unsigned x, unsigned& nloc, unsigned& nx) {
    const unsigned G = gridDim.x * gridDim.y * gridDim.z;
    unsigned sum, cnt, mine, sp = 0u;
    for (;;) {
        sum = 0u; cnt = 0u; mine = 0u;
#pragma unroll
        for (unsigned j = 0; j < 16; ++j) { const unsigned c = xb_ld(&bar[XB_XCNT(j)]); sum += c; cnt += (c > 0u) ? 1u : 0u; mine = (j == x) ? c : mine; }
        if (sum == G) break;
        __builtin_amdgcn_s_sleep(1);
        if ((++sp & 255u) == 0u) { if (xb_ld(&bar[XB_TMO])) break; if (sp > XB_SPIN_CAP) { atomicAdd(&bar[XB_TMO], 1u); break; } }
    }
    nloc = mine > 0u ? mine : 1u; nx = cnt > 0u ? cnt : 1u;
}
DI void xcd_barrier(const XcdBarrier& b) {
    asm volatile("s_waitcnt vmcnt(0)" ::: "memory");
    __syncthreads();
    if (threadIdx.x == 0) {
        unsigned* bar = b.bar;
        __builtin_amdgcn_s_waitcnt(0);
        unsigned nloc = b.st[0], nx = b.st[1];
        if (nloc == 0u) { xcd_barrier_complete(bar, b.x, nloc, nx); b.st[0] = nloc; b.st[1] = nx; }
        const unsigned old = xb_add(&bar[XB_XSUB(b.x)], 1u);
        const unsigned gen = old / nloc;
        if (old + 1u == (gen + 1u) * nloc) {
            __builtin_amdgcn_fence(__ATOMIC_RELEASE, "agent");
            asm volatile("s_waitcnt vmcnt(0)" ::: "memory");
            const unsigned og = xb_add(&bar[XB_TOP], 1u);
            const unsigned tg = og / nx;
            if (og + 1u == (tg + 1u) * nx) xb_add(&bar[XB_TOPGEN], 1u);
            else XB_SPIN(xb_ld(&bar[XB_TOPGEN]) == tg, bar);
            __builtin_amdgcn_fence(__ATOMIC_ACQUIRE, "agent");
            xb_add(&bar[XB_XGEN(b.x)], 1u);
            asm volatile("s_waitcnt vmcnt(0)" ::: "memory");
        } else {
            XB_SPIN(xb_ld(&bar[XB_XGEN(b.x)]) == gen, bar);
            __builtin_amdgcn_fence(__ATOMIC_ACQUIRE, "agent");
            asm volatile("s_waitcnt vmcnt(0)" ::: "memory");
        }
    }
    __syncthreads();
}

constexpr int SLICE_BYTES = 16384 * 128;
constexpr int PEER_TT = 128, PEER_NT = PEER_TT / 8;
struct PeerIdxW { u32x4 e4[4]; };
struct PeerVRows { u32x4 r[16]; u32x2 h2; };
struct UTile { u32x4 a0, a1, e0, e1, e2; unsigned n, off; };
struct UBuf { i32x4 b0[4], b1[4]; unsigned en[4]; };
DI void peer_u_lds_phase(const Args& a, LAS unsigned char* lds, int tid, int lane, int wave) {
    LAS int* rslot = (LAS int*)(lds + LDS_BYTES - 64);
    unsigned* ctl = (unsigned*)(a.ws + WS_CTL);
    const int xcd = (int)(xb_xcc_id() & 7u);
    for (;;) {
        __syncthreads();
        if (tid == 0) { int role = -1;
            if (__hip_atomic_load(ctl + CW_ROLE + 512, __ATOMIC_RELAXED, __HIP_MEMORY_SCOPE_AGENT) < 256u)
                for (int q = 0; q < 8 && role < 0; ++q) { const int x = (xcd + q) & 7; const unsigned r = atomicAdd(ctl + CW_ROLE + 64 * x, 1u); if (r < 32u) role = (int)((((unsigned)x + 8u * (r >> 4)) << 4) | (r & 15u)); }
            if (role >= 0) atomicAdd(ctl + CW_ROLE + 512, 1u);
            *rslot = role; }
        __syncthreads();
        const int role = *rslot; if (role < 0) break;
        const int s = role >> 4, g = role & 15;
        { const unsigned char* src = a.ws + WS_UB + (size_t)s * SLICE_BYTES + (size_t)g * 131072;
#pragma unroll
          for (int hb = 0; hb < 2; ++hb) { u32x4 v[8];
#pragma unroll
            for (int i = 0; i < 8; ++i) v[i] = *(const u32x4*)(src + (size_t)(tid + 512 * (8 * hb + i)) * 16);
#pragma unroll
            for (int i = 0; i < 8; ++i) { const int idx = tid + 512 * (8 * hb + i), e = idx >> 3, c = idx & 7; *(LAS u32x4*)(lds + e * 128 + ((c ^ ((e >> 1) & 7)) << 4)) = v[i]; } } }
        __syncthreads();
        const int j = lane & 15, kg = lane >> 4;
        const __amdgpu_buffer_rsrc_t Hb = __builtin_amdgcn_make_buffer_rsrc((void*)(a.ws + WS_HQ8), 0, 32 << 20, 0x00020000);
        const __amdgpu_buffer_rsrc_t Mb = __builtin_amdgcn_make_buffer_rsrc((void*)(a.ws + WS_LISTM), 0, 16 << 20, 0x00020000);
        const __amdgpu_buffer_rsrc_t Lb = __builtin_amdgcn_make_buffer_rsrc((void*)(a.ws + WS_LIST + (size_t)g * (8 << 20)), 0, 8 << 20, 0x00020000);
        const __amdgpu_buffer_rsrc_t Cb = __builtin_amdgcn_make_buffer_rsrc((void*)(ctl + CW_CNT), 0, 131072, 0x00020000);
        const __amdgpu_buffer_rsrc_t Pb = __builtin_amdgcn_make_buffer_rsrc((void*)(a.ws + WS_PU + (size_t)s * M * 512), 0, M * 512, 0x00020000);
        auto load = [&](UTile& t, int T) {
            t.n = (unsigned)__builtin_amdgcn_raw_buffer_load_b32(Cb, 0, (T * 16 + g) * 4, 0); t.off = (unsigned)__builtin_amdgcn_raw_buffer_load_b32(Cb, 0, (CW_OFF - CW_CNT + T * 16 + g) * 4, 0);
            t.a0 = __builtin_bit_cast(u32x4, __builtin_amdgcn_raw_buffer_load_b128(Hb, j * DM + 128 * s + 16 * kg, T * (16 * DM), 0));
            t.a1 = __builtin_bit_cast(u32x4, __builtin_amdgcn_raw_buffer_load_b128(Hb, j * DM + 128 * s + 16 * kg + 64, T * (16 * DM), 0));
            t.e0 = __builtin_bit_cast(u32x4, __builtin_amdgcn_raw_buffer_load_b128(Mb, j * 16, T * 16384 + g * 1024, 0));
            t.e1 = __builtin_bit_cast(u32x4, __builtin_amdgcn_raw_buffer_load_b128(Mb, j * 16 + 256, T * 16384 + g * 1024, 0));
            t.e2 = __builtin_bit_cast(u32x4, __builtin_amdgcn_raw_buffer_load_b128(Mb, j * 16 + 512, T * 16384 + g * 1024, 0)); };
        auto issue = [&](UBuf& B, const u32x4 e4, int rt0, int n) {
#pragma unroll
            for (int v = 0; v < 4; ++v) { B.en[v] = e4[v];
                const unsigned ad = (B.en[v] & 0x1FFFFu) ^ ((unsigned)kg << 4);
                B.b0[v] = *(const LAS i32x4*)(lds + ad); B.b1[v] = *(const LAS i32x4*)(lds + (ad ^ 64u)); }
            __builtin_amdgcn_sched_barrier(0); };
        auto finish = [&](const UBuf& B, const i32x4 a0, const i32x4 a1, int rt0, int so) {
            i32x4 c[4];
#pragma unroll
            for (int v = 0; v < 4; ++v) c[v] = __builtin_amdgcn_mfma_i32_16x16x64_i8(a0, B.b0[v], (i32x4){0, 0, 0, 0}, 0, 0, 0);
#pragma unroll
            for (int v = 0; v < 4; ++v) c[v] = __builtin_amdgcn_mfma_i32_16x16x64_i8(a1, B.b1[v], c[v], 0, 0, 0);
            __builtin_amdgcn_sched_barrier(0);
#pragma unroll
            for (int v = 0; v < 4; ++v) {
                int m0, m1, v01, v23, val;
                asm("v_bfe_i32 %0, %1, 17, 1" : "=v"(m0) : "v"(B.en[v])); asm("v_bfe_i32 %0, %1, 18, 1" : "=v"(m1) : "v"(B.en[v]));
                asm("v_bfi_b32 %0, %1, %2, %3" : "=v"(v01) : "v"(m0), "v"(c[v][1]), "v"(c[v][0])); asm("v_bfi_b32 %0, %1, %2, %3" : "=v"(v23) : "v"(m0), "v"(c[v][3]), "v"(c[v][2]));
                asm("v_bfi_b32 %0, %1, %2, %3" : "=v"(val) : "v"(m1), "v"(v23), "v"(v01));
                if ((B.en[v] >> 24) == (unsigned)kg) __builtin_amdgcn_raw_buffer_store_b32((unsigned)val, Pb, (16 * (rt0 + v) + j) * 4, so, 0); }
            __builtin_amdgcn_sched_barrier(0); };
        auto proc = [&](const UTile& t, int T) {
            const int n = (int)__builtin_amdgcn_readfirstlane(t.n), nrt = (n + 15) >> 4;
            const i32x4 a0 = __builtin_bit_cast(i32x4, t.a0), a1 = __builtin_bit_cast(i32x4, t.a1);
            const int so = T * 8192 + 4 * (int)__builtin_amdgcn_readfirstlane(t.off);
            UBuf B0, B1;
            if (nrt > 0) { issue(B0, t.e0, 0, n);
                if (nrt > 4) { issue(B1, t.e1, 4, n); finish(B0, a0, a1, 0, so);
                    if (nrt > 8) { issue(B0, t.e2, 8, n); finish(B1, a0, a1, 4, so); finish(B0, a0, a1, 8, so); }
                    else finish(B1, a0, a1, 4, so); }
                else finish(B0, a0, a1, 0, so); }
            if (nrt > 12) {
#pragma unroll 1
                for (int c0 = 12; c0 < nrt; c0 += 4) { const u32x4 x0 = __builtin_bit_cast(u32x4, __builtin_amdgcn_raw_buffer_load_b128(Lb, j * 512 + c0 * 4, T * 8192, 0));
                    issue(B0, x0, c0, n); finish(B0, a0, a1, c0, so); }
                __builtin_amdgcn_s_waitcnt(0x0F70);
            } };
        UTile t0, t1, t2, t3; load(t0, wave); __builtin_amdgcn_sched_barrier(0); load(t1, wave + 8); __builtin_amdgcn_sched_barrier(0); load(t2, wave + 16); __builtin_amdgcn_sched_barrier(0);
#pragma unroll 1
        for (int T = wave; T < M / 16; T += 32) {
            const int Tn = T + 32 < M / 16 ? T + 32 : T;
            load(t3, T + 24);
            proc(t0, T);
            load(t0, Tn);
            proc(t1, T + 8);
            load(t1, Tn + 8);
            proc(t2, T + 16);
            load(t2, Tn + 16);
            proc(t3, T + 24);
        }
    }
}
DI void peer_reduce_tile(const Args& a, LAS unsigned char* lds, int T, int tid, int lane, int wave) {
    const unsigned* EI = (const unsigned*)(a.ws + WS_EI); const float* EG = (const float*)(a.ws + WS_EG); const unsigned* PIDX = (const unsigned*)(a.ws + WS_PIDX);
    const float* isU = (const float*)(a.ws + WS_UB + TAB_SCALE_OFF); const float* isV = (const float*)(a.ws + WS_VB + TAB_SCALE_OFF);
    LAS unsigned* loff = (LAS unsigned*)(lds + 131072);
    __syncthreads();
    { const unsigned char* src = a.ws + WS_PU + (size_t)T * 8192 + (size_t)tid * 16;
#pragma unroll
      for (int hb = 0; hb < 2; ++hb) { u32x4 v[8];
#pragma unroll
        for (int i = 0; i < 8; ++i) v[i] = *(const u32x4*)(src + (size_t)(8 * hb + i) * (8 << 20));
#pragma unroll
        for (int i = 0; i < 8; ++i) *(LAS u32x4*)(lds + (8 * hb + i) * 8192 + tid * 16) = v[i]; }
      if (tid < 16) loff[tid] = ((const unsigned*)(a.ws + WS_CTL))[CW_OFF + T * 16 + tid]; }
    __syncthreads();
#pragma unroll
    for (int tl = 0; tl < 2; ++tl) { const int tok = 16 * T + 2 * wave + tl; const float dq = ((const float*)(a.ws + WS_DQ))[tok];
#pragma unroll
        for (int hs = 0; hs < 2; ++hs) { const size_t idx = (size_t)tok * 128 + 64 * hs + lane; const unsigned e = EI[idx]; const float gt = EG[idx];
            const unsigned q = loff[e >> 10] + PIDX[idx]; int isum = 0;
#pragma unroll
            for (int s = 0; s < 16; ++s) isum += *(const LAS int*)(lds + s * 8192 + q * 4);
            const float w = gelu_tanh((float)isum * dq * isU[e]) * gt * isV[e];
            ((unsigned*)(a.ws + WS_W))[idx] = e | ((__float_as_uint(w) + 0x7fffu + ((__float_as_uint(w) >> 16) & 1u)) & 0xffff0000u); } }
}
DI void peer_v_item(const Args& a, int s, int tt, int lane, int wave) {
    const int g = lane >> 3, c8 = lane & 7;
    const __amdgpu_buffer_rsrc_t Vb = __builtin_amdgcn_make_buffer_rsrc((void*)(a.ws + WS_VB), 0, 32 << 20, 0x00020000);
    const __amdgpu_buffer_rsrc_t Wb = __builtin_amdgcn_make_buffer_rsrc((void*)(a.ws + WS_W), 0, 8 << 20, 0x00020000);
    const __amdgpu_buffer_rsrc_t Ob = __builtin_amdgcn_make_buffer_rsrc((void*)a.out, 0, (int)((size_t)M * DM * 4), 0x00020000);
    const int tok0 = PEER_TT * tt + wave;
    const int col = 128 * s + 16 * c8 + ((lane & 32) ? 8 : 0) + ((lane & 16) ? 4 : 0) + ((lane & 8) ? 2 : 0);
    auto pre = [&](PeerIdxW& E, int t) {
#pragma unroll
        for (int j = 0; j < 4; ++j) E.e4[j] = __builtin_bit_cast(u32x4, __builtin_amdgcn_raw_buffer_load_b128(Wb, g * 64 + 16 * j, (tok0 + 8 * t) * 512, 0)); };
    auto rows = [&](PeerVRows& R, const PeerIdxW& E, int t) {
#pragma unroll
        for (int i = 0; i < 16; ++i) R.r[i] = __builtin_bit_cast(u32x4, __builtin_amdgcn_raw_buffer_load_b128(Vb, (int)(E.e4[i >> 2][i & 3] & 0xffffu) * 128 + 16 * c8, s * SLICE_BYTES, 0));
        R.h2 = __builtin_bit_cast(u32x2, __builtin_amdgcn_raw_buffer_load_b64(Ob, col * 4, (tok0 + 8 * t) * (DM * 4), 0)); };
    auto comp = [&](const PeerVRows& R, const u32x4 (&w4)[4], int t) {
        f32x2 o2[8];
#pragma unroll
        for (int j = 0; j < 8; ++j) o2[j] = (f32x2){0.f, 0.f};
#pragma unroll
        for (int i = 0; i < 16; ++i) { const float w = __uint_as_float(w4[i >> 2][i & 3] & 0xffff0000u); const f32x2 w2 = (f32x2){w, w};
#pragma unroll
            for (int q = 0; q < 4; ++q) { const unsigned u = R.r[i][q]; o2[2 * q] += w2 * __builtin_amdgcn_cvt_pk_f32_fp8(u, false); o2[2 * q + 1] += w2 * __builtin_amdgcn_cvt_pk_f32_fp8(u, true); } }
        float v[16];
#pragma unroll
        for (int j = 0; j < 8; ++j) { v[2 * j] = o2[j][0]; v[2 * j + 1] = o2[j][1]; }
#pragma unroll
        for (int i = 0; i < 8; ++i) { float x = v[i], y = v[i + 8];
            asm volatile("s_nop 1\n\tv_permlane32_swap_b32 %0, %1" : "+v"(x), "+v"(y)); v[i] = x + y; }
#pragma unroll
        for (int i = 0; i < 4; ++i) { float x = v[i], y = v[i + 4];
            asm volatile("s_nop 1\n\tv_permlane16_swap_b32 %0, %1" : "+v"(x), "+v"(y)); v[i] = x + y; }
        { const bool up = (lane & 8) != 0;
#pragma unroll
          for (int i = 0; i < 2; ++i) { const float send = up ? v[i] : v[i + 2], keep = up ? v[i + 2] : v[i]; v[i] = keep + dpp_f<0x128>(send); } }
        f32x2 h2 = __builtin_bit_cast(f32x2, R.h2); h2[0] += v[0]; h2[1] += v[1];
        __builtin_amdgcn_raw_buffer_store_b64(__builtin_bit_cast(u32x2, h2), Ob, col * 4, (tok0 + 8 * t) * (DM * 4), 0); };
    PeerIdxW E0, E1; PeerVRows R0, R1; u32x4 wa[4], wb[4];
    pre(E0, 0); pre(E1, 1); rows(R0, E0, 0);
#pragma unroll
    for (int j = 0; j < 4; ++j) wa[j] = E0.e4[j];
#pragma unroll 1
    for (int t = 0; t < PEER_NT; t += 2) {
        rows(R1, E1, t + 1);
#pragma unroll
        for (int j = 0; j < 4; ++j) wb[j] = E1.e4[j];
        if (t + 2 < PEER_NT) pre(E0, t + 2);
        comp(R0, wa, t);
        if (t + 2 < PEER_NT) { rows(R0, E0, t + 2);
#pragma unroll
            for (int j = 0; j < 4; ++j) wa[j] = E0.e4[j]; }
        if (t + 3 < PEER_NT) pre(E1, t + 3);
        comp(R1, wb, t + 1);
    }
}
template <int VPH> DI void peer_sliced_phase(const Args& a, LAS unsigned char* lds, int tid, int lane, int wave) {
    LAS int* qslot = (LAS int*)(lds + LDS_BYTES - 64);
    const int xcd = (int)(xb_xcc_id() & 7u);
    for (int qi = 0; qi < 8; ++qi) {
        const int q = (xcd + qi) & 7; unsigned* head = (unsigned*)(a.ws + WS_CTL) + (VPH ? CW_PQV : CW_PQU) + 64 * q;
        for (;;) {
            __syncthreads();
            if (tid == 0) *qslot = (int)atomicAdd(head, 1u);
            __syncthreads();
            const int i = *qslot;
            if (i >= 2 * (M / PEER_TT)) break;
            const int s = q + 8 * (i / (M / PEER_TT)), tt = i % (M / PEER_TT);
            int l2 = (int)(threadIdx.x & 63u); asm volatile("" : "+v"(l2));
            peer_v_item(a, s, tt, l2, wave);
        }
    }
}

constexpr int NPHASE = 10;
#ifndef REPK
#define REPK -1
#endif
#define NREP(k) ((REPK) == (k) ? 2 : 1)
#ifndef PHMASK
#define PHMASK 0x3ff
#endif
__global__ void __launch_bounds__(NTHREADS, 2) fwd_kernel(Args a) {
    extern __shared__ __attribute__((aligned(16))) unsigned char lds_raw[];
    LAS unsigned char* lds = (LAS unsigned char*)lds_raw;
    cg::grid_group grid = cg::this_grid();
    int tid = threadIdx.x, lane = tid & 63, wave = __builtin_amdgcn_readfirstlane(tid >> 6);
    const int G = gridDim.x, NGW = G * NWAVES; int gw = blockIdx.x * NWAVES + wave;
#define FRESH() do { tid = threadIdx.x; asm volatile("" : "+v"(tid)); lane = tid & 63; wave = __builtin_amdgcn_readfirstlane(tid >> 6); gw = blockIdx.x * NWAVES + wave; } while (0)
    unsigned char* ws = a.ws;
    const int lo = a.ph_lo, hi = a.ph_hi;
#define IN(k) (lo <= (k) && (k) < hi)
#define SEAM(k) do { if (IN(k) && IN((k) + 1)) { if ((k) == 0) grid.sync(); else xcd_barrier(xbar); } } while (0)
    volatile LAS unsigned* xst = (volatile LAS unsigned*)(lds + LDS_BYTES - 32);
    if (tid < 2) xst[tid] = 0u;
    __syncthreads();
    const XcdBarrier xbar = xcd_barrier_post((unsigned*)(ws + WS_CTL) + CW_XBAR, xst);
    if (((PHMASK >> 0) & 1) && IN(0)) { FRESH(); for (int rep = 0; rep < NREP(0); ++rep) phase_prep(a, lds, gw, NGW, lane, wave);
        for (int fi = blockIdx.x; fi < FILL_SPLIT; fi += G) filler_item(a, lds, fi, lane, wave);
        for (int tile = blockIdx.x; tile < NP / 16; tile += G) coltile_q8_item(a.in[I_WIN], NPROJ, ws + WS_WIN, (float*)(ws + SM_SWC), lds, tile, tid); }
    SEAM(0);
    if (((PHMASK >> 1) & 1) && IN(1)) { FRESH();
        pg8::Gemm g{(const bf16_t*)(ws + WS_XN), (const bf16_t*)(ws + WS_WIN), M, NP, DM / 2}; pg8::StaticOrder S; S.init(M, NP, G, (int)blockIdx.x);
        pg8::EpiBf16 E{(bf16_t*)(ws + WS_P), NP, (const float*)(ws + SM_LB), (const float*)(ws + WS_XN + 32 * MiB), (const float*)(ws + SM_SWC)};
        for (int rep = 0; rep < NREP(1); ++rep) pg8::gemm_phase<pg8::EpiBf16, pg8::StaticOrder, true, true, true>(lds, g, S, E);
    }
    SEAM(1);
    if (((PHMASK >> 2) & 1) && IN(2)) { FRESH();
        for (int row = gw; row < M; row += NGW) nsa_norm_row(a, row, lane);
        for (int rep = 0; rep < NREP(2); ++rep) {
        for (int it = gw; it < 2048; it += NGW) vtrans_item(a, lds + wave * 9216, it, lane);
        __syncthreads();
        for (int it = blockIdx.x; it < 256; it += G) compress_item(a, lds, it, tid, lane, wave);
        }
    }
    SEAM(2);
    if (((PHMASK >> 3) & 1) && IN(3)) { FRESH();
        LAS int* qslot = (LAS int*)(lds + LDS_BYTES - 64);
        for (int rep = 0; rep < ((REPK) == 30 || (REPK) == 31 ? 2 : 1); ++rep) {
        unsigned* qhead = (unsigned*)(ws + WS_CTL) + CW_QUEUE + 64 * rep;
        const int item_lo = (rep == 1 && (REPK) == 31) ? 64 : 0, item_hi = (rep == 1 && (REPK) == 30) ? 64 : 64 + 1024 + FILL_END - FILL_SPLIT;
        for (;;) {
            __syncthreads();
            if (tid == 0) *qslot = (int)atomicAdd(qhead, 1u);
            __syncthreads();
            const int item = *qslot + item_lo;
            if (item >= item_hi) break;
            int tid2 = tid; asm volatile("" : "+v"(tid2));
            const int lane2 = tid2 & 63, wave2 = __builtin_amdgcn_readfirstlane(tid2 >> 6);

#ifndef NO_HGRN
            if (item < 64) hgrn_item(a, lds, item, tid2, lane2, wave2);
#endif
#ifndef NO_ATTN
            if (item >= 64) {
                constexpr int NF = FILL_END - FILL_SPLIT, NT = 1024 + NF; const int k = item - 64;
                const int a0 = (int)(((long)k * 1024) / NT), a1 = (int)(((long)(k + 1) * 1024) / NT);
                if (a1 != a0) attn_item(a, lds, a0, tid2, lane2, wave2); else filler_item(a, lds, k - a0 + FILL_SPLIT, lane2, wave2); }
#endif

        }
        }
    }
    SEAM(3);
    if (((PHMASK >> 4) & 1) && IN(4)) { FRESH();
        rowquant_mix(a, gw, NGW, lane);
        xcd_barrier(xbar);
        FRESH();
        pg8::Gemm g{(const bf16_t*)(ws + WS_MIX8), (const bf16_t*)(ws + WS_WOUT), M, DM, DM / 2}; pg8::StaticOrder S; S.init(M, DM, G, (int)blockIdx.x);
        pg8::EpiH E{a.in[I_X], a.out, (const float*)(ws + WS_MIX8 + 32 * MiB), (const float*)(ws + SM_SWO), lds + 131072};
        for (int rep = 0; rep < NREP(4); ++rep) pg8::gemm_phase<pg8::EpiH, pg8::StaticOrder, true, true, true>(lds, g, S, E);
    }
    SEAM(4);
    if (((PHMASK >> 5) & 1) && IN(5)) { FRESH();
        rowquant_h(a, gw, NGW, lane);
        xcd_barrier(xbar);
        FRESH();
        pg8::Gemm g{(const bf16_t*)(ws + WS_HQ8), (const bf16_t*)(ws + WS_WQ), M, DM, DM / 2}; pg8::StaticOrder S; S.init(M, DM, G, (int)blockIdx.x);
        pg8::EpiBf16 E{(bf16_t*)(ws + WS_QP), DM, nullptr, (const float*)(ws + WS_DQ), (const float*)(ws + SM_SWQ)};
        for (int rep = 0; rep < NREP(5); ++rep) pg8::gemm_phase<pg8::EpiBf16, pg8::StaticOrder, true, true, true>(lds, g, S, E);
    }
    SEAM(5);
    if (((PHMASK >> 6) & 1) && IN(6)) { FRESH(); for (int rep = 0; rep < NREP(6); ++rep) {
        LAS unsigned* lcnt = (LAS unsigned*)(lds + 131072);
        for (int it = gw; it < 4096; it += NGW) { int l2 = lane; asm volatile("" : "+v"(l2));
            if (tid < 32) lcnt[tid] = 0u;
            __syncthreads();
            topk_item(a, lds + wave * 16384, it, l2, lcnt);
            __syncthreads();
            if (tid < 32) { unsigned off = 0u; for (int g2 = 0; g2 < (tid & 15); ++g2) off += lcnt[(tid & 16) + g2];
                unsigned* ctl = (unsigned*)(ws + WS_CTL); const int ti = (2 * (it >> 3) + (tid >> 4)) * 16 + (tid & 15);
                ctl[CW_CNT + ti] = lcnt[tid]; ctl[CW_OFF + ti] = off; }
            { const int li = tid >> 4, g2 = li & 15; const unsigned n = lcnt[li], nup = (n + 63u) & ~63u;
                unsigned* lt = (unsigned*)(ws + WS_LIST) + (size_t)g2 * (1024 * 2048) + (size_t)(2 * (it >> 3) + (li >> 4)) * 2048;
                unsigned* lm = (unsigned*)(ws + WS_LISTM) + (size_t)(2 * (it >> 3) + (li >> 4)) * 4096 + g2 * 256;
#pragma unroll
                for (int k = 0; k < 4; ++k) { const unsigned p = n + (unsigned)(tid & 15) + 16u * k;
                    if (p < nup) { if (p < 256u) lm[(p >> 6) * 64u + (p & 15u) * 4u + ((p >> 4) & 3u)] = 0x80000000u; if (p >= 192u) lt[(p & 15u) * 128u + (p >> 4)] = 0x80000000u; } } }
        } } }
    SEAM(6);
    if (((PHMASK >> 7) & 1) && IN(7)) { FRESH(); peer_u_lds_phase(a, lds, tid, lane, wave); }
    SEAM(7);
    if (((PHMASK >> 8) & 1) && IN(8)) { FRESH(); for (int T = blockIdx.x; T < M / 16; T += G) peer_reduce_tile(a, lds, T, tid, lane, wave); }
    SEAM(8);
    if (((PHMASK >> 9) & 1) && IN(9)) { FRESH(); peer_sliced_phase<1>(a, lds, tid, lane, wave); }
#undef IN
#undef SEAM
}

#ifndef N_LAUNCH_MODE
#define N_LAUNCH_MODE 1
#endif
extern "C" void kernel_launch(void* const* d_in, const int* in_sizes, int n_in, void* d_out, int out_size, void* d_ws, size_t ws_size, hipStream_t stream) {
    static int grid = 0;
    if (grid == 0) {
        int dev = 0, cus = 0, per_cu = 0;
        (void)hipGetDevice(&dev); (void)hipDeviceGetAttribute(&cus, hipDeviceAttributeMultiprocessorCount, dev);
        (void)hipFuncSetAttribute((const void*)fwd_kernel, hipFuncAttributeMaxDynamicSharedMemorySize, LDS_BYTES);
        (void)hipOccupancyMaxActiveBlocksPerMultiprocessor(&per_cu, (const void*)fwd_kernel, NTHREADS, LDS_BYTES);
        if (per_cu < 1) { fprintf(stderr, "occupancy query says %d blocks/CU\n", per_cu); per_cu = 1; }
        grid = cus;
        if (ws_size < WS_END) fprintf(stderr, "warning: ws_size %zu too small\n", ws_size);
    }
    (void)hipMemsetAsync((char*)d_ws + WS_CTL, 0, CTL_BYTES, stream);
    Args a{};
    for (int i = 0; i < 21; ++i) a.in[i] = (const float*)d_in[i];
    a.out = (float*)d_out; a.ws = (unsigned char*)d_ws;
    if (N_LAUNCH_MODE == 1) {
        a.ph_lo = 0; a.ph_hi = NPHASE;
        void* args[] = {&a};
        hipError_t e = hipLaunchCooperativeKernel((const void*)fwd_kernel, dim3(grid), dim3(NTHREADS), args, LDS_BYTES, stream);
        if (e != hipSuccess) fprintf(stderr, "launch failed: %s\n", hipGetErrorString(e));
    } else {
        for (int p = 0; p < NPHASE; ++p) {
            a.ph_lo = p; a.ph_hi = p + 1;
            void* args[] = {&a};
            hipError_t e = hipLaunchCooperativeKernel((const void*)fwd_kernel, dim3(grid), dim3(NTHREADS), args, LDS_BYTES, stream);
            if (e != hipSuccess) { fprintf(stderr, "launch failed: %s\n", hipGetErrorString(e)); break; }
        }
    }
}
```

```cpp
#include <hip/hip_runtime.h>
#include <hip/hip_cooperative_groups.h>
#include <cstdio>
#include <cstdint>
namespace cg = cooperative_groups;

#define DI __device__ __forceinline__
#define LAS __attribute__((address_space(3)))
typedef unsigned short bf16_t;
typedef short bf16x8 __attribute__((ext_vector_type(8)));
typedef float f32x2 __attribute__((ext_vector_type(2)));
typedef float f32x4 __attribute__((ext_vector_type(4)));
typedef float f32x16 __attribute__((ext_vector_type(16)));
typedef unsigned u32x2 __attribute__((ext_vector_type(2)));
typedef int i32x4 __attribute__((ext_vector_type(4)));
typedef unsigned u32x4 __attribute__((ext_vector_type(4)));
typedef __bf16 bf16x2_t __attribute__((ext_vector_type(2)));

constexpr int DM = 2048, NB = 8, SEQ = 2048, M = NB * SEQ;
constexpr int NPROJ = 6704, NP = 6912;
constexpr int C_HQ = 0, C_HF = 1024, C_HI = 2048, C_HG = 3072, C_NQ = 4096, C_NKC = 5120, C_NVC = 5376, C_NKS = 5632, C_NVS = 5888, C_NKW = 6144, C_NVW = 6400, C_GATE = 6656;
constexpr float EPS = 1e-6f;
constexpr float LOG2E = 1.4426950408889634f;

constexpr size_t MiB = 1u << 20;
constexpr size_t WS_CTL = 0, CTL_BYTES = 1 * MiB;
constexpr size_t WS_WIN = 1 * MiB;
constexpr size_t WS_WOUT = 28 * MiB;
constexpr size_t WS_WQ = 36 * MiB;
constexpr size_t WS_SMALL = 44 * MiB;
constexpr size_t WS_UB = 52 * MiB;
constexpr size_t WS_VB = 116 * MiB;
constexpr size_t TAB_SCALE_OFF = 32 * MiB;
constexpr size_t WS_P = 180 * MiB;
constexpr size_t WS_XN = 396 * MiB;
constexpr size_t WS_VT = 460 * MiB;
constexpr size_t WS_SSQ = 476 * MiB;
constexpr size_t WS_LISTM = 478 * MiB;
constexpr size_t WS_END = 494 * MiB;
constexpr size_t WS_MIX8 = WS_P + 64 * MiB;
constexpr size_t WS_QP = WS_P + 64 * MiB;
constexpr size_t WS_EI = WS_P + 128 * MiB;
constexpr size_t WS_EG = WS_P + 136 * MiB;
constexpr size_t WS_W = WS_P + 144 * MiB;
constexpr size_t WS_PU = WS_P;
constexpr size_t WS_LIST = WS_P + 152 * MiB;
constexpr size_t WS_PIDX = WS_VT;
constexpr size_t WS_HQ8 = WS_WIN;
constexpr size_t WS_DQ = WS_WIN + 32 * MiB;
constexpr size_t SM_W1K = WS_SMALL;
constexpr size_t SM_W1V = WS_SMALL + 1 * MiB;
constexpr size_t SM_W2K = WS_SMALL + 2 * MiB;
constexpr size_t SM_W2V = SM_W2K + 32768;
constexpr size_t SM_SK = WS_SMALL + 3 * MiB;
constexpr size_t SM_LB = WS_SMALL + 4 * MiB;
constexpr size_t SM_BIASP = SM_LB + 4096;
constexpr size_t SM_KC = WS_SMALL + 5 * MiB;
constexpr size_t SM_SWC = WS_SMALL + 7 * MiB;
constexpr size_t SM_SWQ = WS_SMALL + 7 * MiB + 32768;
constexpr size_t SM_SWO = WS_SMALL + 7 * MiB + 49152;
constexpr size_t SM_VCT = WS_SMALL + 6 * MiB;
static_assert(WS_END <= 512 * MiB, "ws");
constexpr int CW_QUEUE = 64;
constexpr int CW_PQU = 8192, CW_PQV = 9216;
constexpr int CW_ROLE = 10240;
constexpr int CW_CNT = 16384;
constexpr int CW_OFF = 32768;
constexpr int CW_XBAR = 4096;

constexpr int LDS_BYTES = 151552;
constexpr int NTHREADS = 512, NWAVES = 8;

DI unsigned pk2(float lo, float hi) { f32x2 v = {lo, hi}; bf16x2_t b = __builtin_convertvector(v, bf16x2_t); return __builtin_bit_cast(unsigned, b); }
DI bf16_t f2bf(float f) { return (bf16_t)(pk2(f, 0.f) & 0xffffu); }
DI float bf2f(bf16_t u) { return __uint_as_float((unsigned)u << 16); }
DI float bflo(unsigned u) { return __uint_as_float(u << 16); }
DI float bfhi(unsigned u) { return __uint_as_float(u & 0xffff0000u); }
DI float wave_sum(float v) {
#pragma unroll
    for (int o = 1; o < 64; o <<= 1) v += __shfl_xor(v, o);
    return v;
}
DI float fast_exp2(float x) { return __builtin_amdgcn_exp2f(x); }
DI float fast_rcp(float x) { return __builtin_amdgcn_rcpf(x); }
DI float sigmoidf_(float x) { return fast_rcp(1.f + fast_exp2(-x * LOG2E)); }
DI float gelu_tanh(float x) {
    const float u = 0.7978845608028654f * (x + 0.044715f * x * x * x);
    return x * sigmoidf_(2.f * u);
}
#define LDS_WAIT() asm volatile("s_waitcnt lgkmcnt(0)" ::: "memory")
#define MFMA32(a, b, c) __builtin_amdgcn_mfma_f32_32x32x16_bf16((a), (b), (c), 0, 0, 0)
#define MFMA16(a, b, c) __builtin_amdgcn_mfma_f32_16x16x32_bf16((a), (b), (c), 0, 0, 0)
DI int crow(int r, int hi) { return (r & 3) + 8 * (r >> 2) + 4 * hi; }

namespace pg8 {
constexpr int BM = 256, BK = 64, HALF = 128, HTB = HALF * BK * 2, STAGE_BYTES = 8 * HTB, NXCD = 8, WGM = 8;
__host__ __device__ __forceinline__ int lds_byte(int r, int c) { const int st = (r >> 4) * 2 + (c >> 5), rr = r & 15, cc = c & 31, ob = rr * 64 + cc * 2; return st * 1024 + (ob ^ (((ob >> 9) & 1) << 5)); }
__host__ __device__ __forceinline__ void stage_rc(int b, int& R, int& C) { const int st = b / 1024, sb = b % 1024, swz = sb ^ (((sb >> 9) & 1) << 5); R = (st >> 1) * 16 + swz / 64; C = (st & 1) * 32 + (swz % 64) / 2; }
__host__ __device__ __forceinline__ int perm32(int rho) { const int n = rho >> 4, i = rho & 15; return 8 * (i >> 2) + 4 * n + (i & 3); }
struct Unit { int pm, pn; };
template <bool I8> __device__ __forceinline__ f32x4 mma1(const bf16x8 b, const bf16x8 a, const f32x4 c) {
    if constexpr (I8) return __builtin_bit_cast(f32x4, __builtin_amdgcn_mfma_i32_16x16x64_i8(__builtin_bit_cast(i32x4, b), __builtin_bit_cast(i32x4, a), __builtin_bit_cast(i32x4, c), 0, 0, 0));
    else return __builtin_amdgcn_mfma_f32_16x16x32_bf16(b, a, c, 0, 0, 0); }
struct Gemm { const bf16_t* A; const bf16_t* Bt; int M, N, K; };
struct StaticOrder {
    int nM, nN, nwg, G, c;
    __host__ __device__ void init(int M_, int N_, int G_, int c_) { nM = M_ / BM; nN = N_ / BM; nwg = nM * nN; G = G_; c = c_; }
    __host__ __device__ bool next(int i, Unit& u) const {
        const long L = (long)i * G + c; if (L >= nwg) return false;
        int wgid = (int)L; { const int q = nwg / NXCD, r = nwg % NXCD, xcd = wgid % NXCD, off = wgid / NXCD; wgid = (xcd < r ? xcd * (q + 1) : r * (q + 1) + (xcd - r) * q) + off; }
        const int nig = WGM * nN, gid = wgid / nig, fm = gid * WGM, gsz = (nM - fm) < WGM ? (nM - fm) : WGM;
        u.pm = fm + ((wgid % nig) % gsz); u.pn = (wgid % nig) / gsz; return true;
    }
    __device__ __forceinline__ void a_ready(const Unit&) const {}
    __device__ __forceinline__ void done(const Unit&) const {}
};
struct EpiBf16 {
    static constexpr bool PERM = true, AFTER_DRAIN = false;
    bf16_t* O; int ldc;
    const float* lbp;
    const float* sa; const float* sw;
    __device__ __forceinline__ void operator()(const f32x4 (&acc)[2][2][4][2], const Unit& u, int wr, int wc, int fr, int fq) const {
        const int row0 = u.pm * BM + wr * 64 + fr; const int col0 = u.pn * BM + wc * 32 + 8 * fq;
        const bool fg = lbp && (unsigned)(u.pn - 4) < 4u;
        float sav[8]; f32x4 swv[2][2], lbv[2][2];
#pragma unroll
        for (int i = 0; i < 8; ++i) sav[i] = sa[row0 + (i >> 2) * HALF + (i & 3) * 16];
#pragma unroll
        for (int bj = 0; bj < 2; ++bj) { swv[bj][0] = *(const f32x4*)(sw + col0 + bj * HALF); swv[bj][1] = *(const f32x4*)(sw + col0 + bj * HALF + 4);
            lbv[bj][0] = fg ? *(const f32x4*)(lbp + col0 + bj * HALF - 1024) : (f32x4){0.f, 0.f, 0.f, 0.f}; lbv[bj][1] = fg ? *(const f32x4*)(lbp + col0 + bj * HALF - 1020) : (f32x4){0.f, 0.f, 0.f, 0.f}; }
#pragma unroll
        for (int ai = 0; ai < 2; ++ai)
#pragma unroll
            for (int m = 0; m < 4; ++m) { const int row = row0 + ai * HALF + m * 16; bf16_t* rowp = O + (size_t)row * ldc + col0; const float sc = sav[ai * 4 + m];
#pragma unroll
                for (int bj = 0; bj < 2; ++bj) {
                    f32x4 v0 = __builtin_convertvector(__builtin_bit_cast(i32x4, acc[ai][bj][m][0]), f32x4) * (swv[bj][0] * sc), v1 = __builtin_convertvector(__builtin_bit_cast(i32x4, acc[ai][bj][m][1]), f32x4) * (swv[bj][1] * sc);
                    if (fg) {
#pragma unroll
                        for (int i = 0; i < 4; ++i) { v0[i] = (1.f - lbv[bj][0][i]) * __builtin_amdgcn_rcpf(1.f + __builtin_amdgcn_exp2f(v0[i] * 1.4426950408889634f));
                                                      v1[i] = (1.f - lbv[bj][1][i]) * __builtin_amdgcn_rcpf(1.f + __builtin_amdgcn_exp2f(v1[i] * 1.4426950408889634f)); } }
                    u32x4 w; w.x = pk2(v0[0], v0[1]); w.y = pk2(v0[2], v0[3]); w.z = pk2(v1[0], v1[1]); w.w = pk2(v1[2], v1[3]);
                    *(u32x4*)(rowp + bj * HALF) = w; } }
    }
};
struct EpiH {
    static constexpr bool PERM = false, AFTER_DRAIN = false;
    const float* x; float* out; const float* sa; const float* sw; LAS unsigned char* scr;
    __device__ __forceinline__ void operator()(const f32x4 (&acc)[2][2][4][2], const Unit& u, int wr, int wc, int fr, int fq) const {
        const int lane = fr + 16 * fq, wid = wr * 4 + wc;
        LAS unsigned char* t = scr + wid * 2048;
        const int rr = lane >> 3, c4 = lane & 7;
        const int colb = u.pn * BM + wc * 32 + 4 * c4;
        const f32x4 swv[2] = {*(const f32x4*)(sw + colb), *(const f32x4*)(sw + colb + HALF)};
        f32x4 xv[4][2][2]; float sv[4][2];
        auto rowof = [&](int g) { return u.pm * BM + (g >> 2) * HALF + wr * 64 + (g & 3) * 16 + rr; };
#pragma unroll
        for (int g = 0; g < 4; ++g) { const int row = rowof(g); sv[g][0] = sa[row]; sv[g][1] = sa[row + 8];
#pragma unroll
            for (int bj = 0; bj < 2; ++bj)
#pragma unroll
                for (int k = 0; k < 2; ++k) xv[g][bj][k] = *(const f32x4*)(x + (size_t)(row + 8 * k) * DM + colb + bj * HALF); }
#pragma unroll
        for (int g = 0; g < 8; ++g) { const int ai = g >> 2, m = g & 3, sl = g & 3; const int row = rowof(g);
            f32x4 xc[2][2]; const float sc[2] = {sv[sl][0], sv[sl][1]};
#pragma unroll
            for (int bj = 0; bj < 2; ++bj)
#pragma unroll
                for (int k = 0; k < 2; ++k) xc[bj][k] = xv[sl][bj][k];
            if (g + 4 < 8) { const int rn = rowof(g + 4); sv[sl][0] = sa[rn]; sv[sl][1] = sa[rn + 8];
#pragma unroll
                for (int bj = 0; bj < 2; ++bj)
#pragma unroll
                    for (int k = 0; k < 2; ++k) xv[sl][bj][k] = *(const f32x4*)(x + (size_t)(rn + 8 * k) * DM + colb + bj * HALF); }
#pragma unroll
            for (int bj = 0; bj < 2; ++bj) {
                *(LAS f32x4*)(t + fr * 128 + (4 * fq) * 4) = acc[ai][bj][m][0]; *(LAS f32x4*)(t + fr * 128 + (16 + 4 * fq) * 4) = acc[ai][bj][m][1];
                asm volatile("s_waitcnt lgkmcnt(0)" ::: "memory");
#pragma unroll
                for (int k = 0; k < 2; ++k) { const f32x4 v = __builtin_convertvector(*(const LAS i32x4*)(t + (rr + 8 * k) * 128 + c4 * 16), f32x4) * (swv[bj] * sc[k]) + xc[bj][k];
                    *(f32x4*)(out + (size_t)(row + 8 * k) * DM + colb + bj * HALF) = v; }
                asm volatile("s_waitcnt lgkmcnt(0)" ::: "memory");
            }
        }
    }
};

template <class Epi, class Sched, bool ALIGN_EPI = false, bool SP2 = false, bool I8 = false>
__device__ __forceinline__ void gemm_phase(LAS unsigned char* lds, const Gemm g, const Sched& S, const Epi& E) {
    const int tid = threadIdx.x, wid = __builtin_amdgcn_readfirstlane(tid >> 6), lane = tid & 63, wr = wid >> 2, wc = wid & 3, fr = lane & 15, fq = lane >> 4;
    const int K = g.K, nt = K / BK;
    unsigned voffA[2], voffB[2];
#pragma unroll
    for (int i = 0; i < 2; ++i) { int R, C; stage_rc(tid * 16 + i * 8192, R, C); const int Rb = Epi::PERM ? ((R & ~31) + perm32(R & 31)) : R;
        voffA[i] = (unsigned)(R * K + C) * 2u; voffB[i] = (unsigned)(Rb * K + C) * 2u; }
    const size_t kstep = (size_t)(BK * 2);
    const size_t hstep = (size_t)HALF * K * 2;
    const size_t tstep = 2 * hstep;
    const unsigned ldsw = (unsigned)wid * 1024u;
    const int aoff = lds_byte(wr * 64 + fr, fq * 8), boff = lds_byte(wc * 32 + fr, fq * 8);
#define PG8_SA(b, h) (((b) * 2 + (h)) * HTB)
#define PG8_SB(b, h) ((4 + (b) * 2 + (h)) * HTB)
#define PG8_STAGE(bufoff, gbase, voff) do { _Pragma("unroll") for (int _i = 0; _i < 2; ++_i) \
        __builtin_amdgcn_global_load_lds((const unsigned*)((const char*)(gbase) + (voff)[_i]), (LAS unsigned*)(lds + (bufoff) + ldsw + _i * 8192), 16, 0, 0); } while (0)
#define PG8_LDA(dst, b, h) do { _Pragma("unroll") for (int m = 0; m < 4; ++m) _Pragma("unroll") for (int k = 0; k < 2; ++k) dst[m][k] = *(const LAS bf16x8*)(lds + PG8_SA(b, h) + aoff + m * 2048 + k * 1024); } while (0)
#define PG8_LDB(dst, b, h) do { _Pragma("unroll") for (int n = 0; n < 2; ++n) _Pragma("unroll") for (int k = 0; k < 2; ++k) dst[n][k] = *(const LAS bf16x8*)(lds + PG8_SB(b, h) + boff + n * 2048 + k * 1024); } while (0)
#define PG8_MMA(ai, bj, At, Bt) do { __builtin_amdgcn_s_setprio(1); _Pragma("unroll") for (int m = 0; m < 4; ++m) _Pragma("unroll") for (int n = 0; n < 2; ++n) _Pragma("unroll") for (int k = 0; k < 2; ++k) \
        acc[ai][bj][m][n] = mma1<I8>(Bt[n][k], At[m][k], acc[ai][bj][m][n]); __builtin_amdgcn_s_setprio(0); } while (0)
#define PG8_WAIT_V(n) asm volatile("s_waitcnt vmcnt(" #n ")" ::: "memory")
#define PG8_WAIT_L(n) asm volatile("s_waitcnt lgkmcnt(" #n ")" ::: "memory")
#define PG8_BAR __builtin_amdgcn_s_barrier()
#define PG8_SCHED __builtin_amdgcn_sched_barrier(0)
    Unit cur, nxt; int ui = 0;
    if (!S.next(0, cur)) return;
    f32x4 acc[2][2][4][2];
#pragma unroll
    for (int a = 0; a < 2; ++a)
#pragma unroll
        for (int b = 0; b < 2; ++b)
#pragma unroll
            for (int m = 0; m < 4; ++m)
#pragma unroll
                for (int n = 0; n < 2; ++n) acc[a][b][m][n] = (f32x4){0.f, 0.f, 0.f, 0.f};
    bf16x8 At[4][2], B0[2][2], B1[2][2];
    const char* cA = (const char*)g.A + (size_t)cur.pm * tstep; const char* cB = (const char*)g.Bt + (size_t)cur.pn * tstep;
    S.a_ready(cur);
    if constexpr (SP2) {
        PG8_STAGE(PG8_SB(0, 0), cB, voffB); PG8_STAGE(PG8_SB(0, 1), cB + hstep, voffB); PG8_STAGE(PG8_SA(0, 0), cA, voffA); PG8_STAGE(PG8_SA(0, 1), cA + hstep, voffA);
        if (wr == 1) PG8_BAR;
        PG8_WAIT_V(2); PG8_BAR;
        PG8_STAGE(PG8_SB(1, 0), cB + kstep, voffB); PG8_STAGE(PG8_SA(1, 0), cA + kstep, voffA); PG8_STAGE(PG8_SB(1, 1), cB + hstep + kstep, voffB);
        PG8_WAIT_V(6); PG8_BAR;
    } else {
        PG8_STAGE(PG8_SB(0, 0), cB, voffB); PG8_STAGE(PG8_SA(0, 0), cA, voffA); PG8_STAGE(PG8_SB(0, 1), cB + hstep, voffB); PG8_STAGE(PG8_SA(0, 1), cA + hstep, voffA);
        if (wr == 1) PG8_BAR;
        PG8_WAIT_V(4); PG8_BAR;
        PG8_STAGE(PG8_SB(1, 0), cB + kstep, voffB); PG8_STAGE(PG8_SA(1, 0), cA + kstep, voffA); PG8_STAGE(PG8_SB(1, 1), cB + hstep + kstep, voffB);
        PG8_WAIT_V(6); PG8_BAR;
    }
    for (;;) {
        const bool has_next = S.next(ui + 1, nxt);
        const char* nA = has_next ? (const char*)g.A + (size_t)nxt.pm * tstep : cA; const char* nB = has_next ? (const char*)g.Bt + (size_t)nxt.pn * tstep : cB;
        for (int t = 0; t < nt; t += 2) {
            const bool last = (t == nt - 2);
            const char* a1 = cA + (size_t)(t + 1) * kstep;
            const char* a2 = last ? nA : cA + (size_t)(t + 2) * kstep; const char* b2 = last ? nB : cB + (size_t)(t + 2) * kstep;
            const char* a3 = a2 + kstep; const char* b3 = b2 + kstep;
            if (last && has_next) S.a_ready(nxt);
            if constexpr (SP2) {
            PG8_LDB(B0, 0, 0); PG8_LDB(B1, 0, 1); PG8_SCHED; PG8_LDA(At, 0, 0); PG8_STAGE(PG8_SA(1, 1), a1 + hstep, voffA);
            PG8_WAIT_V(8); PG8_WAIT_L(0); PG8_BAR; PG8_MMA(0, 0, At, B0); PG8_MMA(0, 1, At, B1); PG8_BAR; PG8_SCHED;
            PG8_LDA(At, 0, 1); PG8_STAGE(PG8_SB(0, 0), b2, voffB); PG8_STAGE(PG8_SB(0, 1), b2 + hstep, voffB); PG8_STAGE(PG8_SA(0, 0), a2, voffA);
            PG8_WAIT_V(8); PG8_WAIT_L(0); PG8_BAR; PG8_MMA(1, 0, At, B0); PG8_MMA(1, 1, At, B1); PG8_BAR; PG8_SCHED;
            PG8_LDB(B0, 1, 0); PG8_LDB(B1, 1, 1); PG8_SCHED; PG8_LDA(At, 1, 0); PG8_STAGE(PG8_SA(0, 1), a2 + hstep, voffA);
            PG8_WAIT_V(8); PG8_WAIT_L(0); PG8_BAR; PG8_MMA(0, 0, At, B0); PG8_MMA(0, 1, At, B1); PG8_BAR; PG8_SCHED;
            PG8_LDA(At, 1, 1); PG8_STAGE(PG8_SB(1, 0), b3, voffB); PG8_STAGE(PG8_SB(1, 1), b3 + hstep, voffB); PG8_STAGE(PG8_SA(1, 0), a3, voffA);
            PG8_WAIT_V(8); PG8_WAIT_L(0); PG8_BAR; PG8_MMA(1, 0, At, B0); PG8_MMA(1, 1, At, B1); PG8_BAR; PG8_SCHED;
            } else {
            PG8_LDB(B0, 0, 0); PG8_SCHED; PG8_LDA(At, 0, 0); PG8_STAGE(PG8_SA(1, 1), a1 + hstep, voffA);
            PG8_WAIT_L(8); PG8_BAR; PG8_WAIT_L(0); PG8_MMA(0, 0, At, B0); PG8_BAR; PG8_SCHED;
            PG8_LDB(B1, 0, 1); PG8_STAGE(PG8_SB(0, 0), b2, voffB);
            PG8_BAR; PG8_WAIT_L(0); PG8_MMA(0, 1, At, B1); PG8_BAR;
            PG8_LDA(At, 0, 1); PG8_STAGE(PG8_SA(0, 0), a2, voffA);
            PG8_BAR; PG8_WAIT_L(0); PG8_MMA(1, 0, At, B0); PG8_BAR; PG8_SCHED;
            PG8_STAGE(PG8_SB(0, 1), b2 + hstep, voffB);
            PG8_WAIT_V(6); PG8_BAR; PG8_MMA(1, 1, At, B1); PG8_BAR;
            PG8_LDB(B0, 1, 0); PG8_SCHED; PG8_LDA(At, 1, 0); PG8_STAGE(PG8_SA(0, 1), a2 + hstep, voffA);
            PG8_WAIT_L(8); PG8_BAR; PG8_WAIT_L(0); PG8_MMA(0, 0, At, B0); PG8_BAR; PG8_SCHED;
            PG8_LDB(B1, 1, 1); PG8_STAGE(PG8_SB(1, 0), b3, voffB);
            PG8_BAR; PG8_WAIT_L(0); PG8_MMA(0, 1, At, B1); PG8_BAR;
            PG8_LDA(At, 1, 1); PG8_STAGE(PG8_SA(1, 0), a3, voffA);
            PG8_BAR; PG8_WAIT_L(0); PG8_MMA(1, 0, At, B0); PG8_BAR; PG8_SCHED;
            PG8_STAGE(PG8_SB(1, 1), b3 + hstep, voffB);
            PG8_WAIT_V(6); PG8_BAR; PG8_MMA(1, 1, At, B1); PG8_BAR;
            }
        }
        if constexpr (ALIGN_EPI) { if (wr == 0) PG8_BAR; }
        if constexpr (!Epi::AFTER_DRAIN) { E(acc, cur, wr, wc, fr, fq); S.done(cur); }
        if (!has_next) break;
#pragma unroll
        for (int a = 0; a < 2; ++a)
#pragma unroll
            for (int b = 0; b < 2; ++b)
#pragma unroll
                for (int m = 0; m < 4; ++m)
#pragma unroll
                    for (int n = 0; n < 2; ++n) acc[a][b][m][n] = (f32x4){0.f, 0.f, 0.f, 0.f};
        cur = nxt; cA = nA; cB = nB; ++ui;
        if constexpr (ALIGN_EPI) { if (wr == 1) PG8_BAR; }
    }
    PG8_WAIT_V(0);
    if constexpr (!ALIGN_EPI) { if (wr == 0) PG8_BAR; }
    PG8_BAR;
#undef PG8_SA
#undef PG8_SB
#undef PG8_STAGE
#undef PG8_LDA
#undef PG8_LDB
#undef PG8_MMA
#undef PG8_WAIT_V
#undef PG8_WAIT_L
#undef PG8_BAR
#undef PG8_SCHED
}
}

struct Args {
    const float* in[21];
    float* out; unsigned char* ws;
    int ph_lo, ph_hi;
};
enum { I_X = 0, I_N1W, I_WIN, I_LB, I_HGNW, I_QNW, I_KCNW, I_KSNW, I_KWNW, I_POSK, I_POSV, I_WCK1, I_WCK2, I_WCV1, I_WCV2, I_WOUT, I_N2W, I_WQ, I_SK, I_PU, I_PV };

constexpr float Q8_MAGIC = 12582912.f;
DI unsigned pack_q8(float t0, float t1, float t2, float t3) {
    const unsigned lo = __builtin_amdgcn_perm(__builtin_bit_cast(unsigned, t1), __builtin_bit_cast(unsigned, t0), 0x0c0c0400u);
    const unsigned hi = __builtin_amdgcn_perm(__builtin_bit_cast(unsigned, t3), __builtin_bit_cast(unsigned, t2), 0x04000c0cu);
    return lo | hi; }
DI void transpose_item(const float* W, int K, int N, int Npad, bf16_t* WT, LAS float* scr, int item, int lane, const float* kscale) {
    const int nblk = Npad / 32, kb = item / nblk, nb = item % nblk, k0 = 64 * kb, n0 = 32 * nb;
    const int n = n0 + 4 * (lane & 7);
    f32x4 v[8];
#pragma unroll
    for (int i = 0; i < 8; ++i) { const int kk = 8 * i + (lane >> 3); v[i] = (n < N) ? *(const f32x4*)(W + (size_t)(k0 + kk) * N + n) : (f32x4){0.f, 0.f, 0.f, 0.f}; }
#pragma unroll
    for (int i = 0; i < 8; ++i) { const int kk = 8 * i + (lane >> 3); f32x4 y = v[i]; if (kscale) y = y * kscale[k0 + kk];
        LAS float* d = scr + kk * 33 + 4 * (lane & 7); d[0] = y[0]; d[1] = y[1]; d[2] = y[2]; d[3] = y[3]; }
    LDS_WAIT(); asm volatile("" ::: "memory");
    const int c = lane & 7;
#pragma unroll
    for (int j = 0; j < 4; ++j) { const int nn = (lane >> 3) + 8 * j; const LAS float* s = scr + (8 * c) * 33 + nn;
        u32x4 o; o.x = pk2(s[0 * 33], s[1 * 33]); o.y = pk2(s[2 * 33], s[3 * 33]); o.z = pk2(s[4 * 33], s[5 * 33]); o.w = pk2(s[6 * 33], s[7 * 33]);
        *(u32x4*)(WT + (size_t)(n0 + nn) * K + k0 + 8 * c) = o; }
    LDS_WAIT(); asm volatile("" ::: "memory");
}

DI void coltile_q8_item(const float* W, int N, unsigned char* WT, float* wscale, LAS unsigned char* lds, int tile, int tid) {
    const int cq = tid & 3, rg = tid >> 2, n0 = 16 * tile + 4 * cq, wv = tid >> 6;
    f32x4 v[16];
#pragma unroll
    for (int i = 0; i < 16; ++i) v[i] = (n0 < N) ? *(const f32x4*)(W + (size_t)(16 * rg + i) * N + n0) : (f32x4){0.f, 0.f, 0.f, 0.f};
    f32x4 m = (f32x4){0.f, 0.f, 0.f, 0.f};
#pragma unroll
    for (int i = 0; i < 16; ++i) { m[0] = fmaxf(m[0], fabsf(v[i][0])); m[1] = fmaxf(m[1], fabsf(v[i][1])); m[2] = fmaxf(m[2], fabsf(v[i][2])); m[3] = fmaxf(m[3], fabsf(v[i][3])); }
#pragma unroll
    for (int o = 4; o < 64; o <<= 1) { m[0] = fmaxf(m[0], __shfl_xor(m[0], o)); m[1] = fmaxf(m[1], __shfl_xor(m[1], o)); m[2] = fmaxf(m[2], __shfl_xor(m[2], o)); m[3] = fmaxf(m[3], __shfl_xor(m[3], o)); }
    LAS f32x4* wm = (LAS f32x4*)(lds + 131072 + 1024);
    __syncthreads();
    if ((tid & 63) < 4) wm[wv * 4 + cq] = m;
    __syncthreads();
#pragma unroll
    for (int w = 0; w < 8; ++w) { const f32x4 t = wm[w * 4 + cq]; m[0] = fmaxf(m[0], t[0]); m[1] = fmaxf(m[1], t[1]); m[2] = fmaxf(m[2], t[2]); m[3] = fmaxf(m[3], t[3]); }
    if (rg == 0) *(f32x4*)(wscale + n0) = m * (1.f / 127.f);
#pragma unroll
    for (int c = 0; c < 4; ++c) { const float qs = m[c] > 0.f ? 127.f / m[c] : 0.f; u32x4 o;
#pragma unroll
        for (int q = 0; q < 4; ++q) o[q] = pack_q8(fmaf(v[4 * q][c], qs, Q8_MAGIC), fmaf(v[4 * q + 1][c], qs, Q8_MAGIC), fmaf(v[4 * q + 2][c], qs, Q8_MAGIC), fmaf(v[4 * q + 3][c], qs, Q8_MAGIC));
        *(u32x4*)(WT + (size_t)(n0 + c) * 2048 + 16 * rg) = o; }
}
DI void peer_conv_rows(const Args& a, int tsel, int rp0, int nrp, int lane) {
    const float* src = a.in[tsel ? I_PV : I_PU]; unsigned char* dst = a.ws + (tsel ? WS_VB : WS_UB); float* isc = (float*)(dst + TAB_SCALE_OFF);
    f32x4 v[2][8], nx[2][8];
#pragma unroll
    for (int rr = 0; rr < 2; ++rr)
#pragma unroll
        for (int q = 0; q < 8; ++q) nx[rr][q] = *(const f32x4*)(src + (size_t)(2 * rp0 + rr) * DM + 256 * q + 4 * lane);
#pragma unroll 1
    for (int k = 0; k < nrp; ++k) {
#pragma unroll
        for (int rr = 0; rr < 2; ++rr)
#pragma unroll
            for (int q = 0; q < 8; ++q) v[rr][q] = nx[rr][q];
        if (k + 1 < nrp) {
#pragma unroll
            for (int rr = 0; rr < 2; ++rr)
#pragma unroll
                for (int q = 0; q < 8; ++q) nx[rr][q] = *(const f32x4*)(src + (size_t)(2 * (rp0 + k + 1) + rr) * DM + 256 * q + 4 * lane);
        }
#pragma unroll
        for (int rr = 0; rr < 2; ++rr) { const int row = 2 * (rp0 + k) + rr; float mx = 0.f;
#pragma unroll
            for (int q = 0; q < 8; ++q) mx = fmaxf(mx, fmaxf(fmaxf(fabsf(v[rr][q][0]), fabsf(v[rr][q][1])), fmaxf(fabsf(v[rr][q][2]), fabsf(v[rr][q][3]))));
#pragma unroll
            for (int o = 1; o < 64; o <<= 1) mx = fmaxf(mx, __shfl_xor(mx, o));
            const float top = tsel ? 448.f : 127.f;
            const float sc = (mx > 0.f) ? top / mx : 1.f;
            if (lane == 0) isc[row] = (mx > 0.f) ? mx / top : 1.f;
#pragma unroll
            for (int q = 0; q < 8; ++q) { const f32x4 y = v[rr][q] * sc; int pk;
                if (tsel) { pk = __builtin_amdgcn_cvt_pk_fp8_f32(y[0], y[1], 0, false); pk = __builtin_amdgcn_cvt_pk_fp8_f32(y[2], y[3], pk, true); }
                else pk = (int)pack_q8(y[0] + Q8_MAGIC, y[1] + Q8_MAGIC, y[2] + Q8_MAGIC, y[3] + Q8_MAGIC);
                *(unsigned*)(dst + (size_t)(2 * q + (lane >> 5)) * (16384 * 128) + (size_t)row * 128 + 4 * (lane & 31)) = (unsigned)pk; } }
    }
}
DI void sk_conv_item(const Args& a, int it, int lane) {
    const float* sk = a.in[I_SK]; bf16_t* skb = (bf16_t*)(a.ws + SM_SK); const size_t e = (size_t)it * 512 + lane * 8;
    const f32x4 v0 = *(const f32x4*)(sk + e), v1 = *(const f32x4*)(sk + e + 4);
    u32x4 w; w.x = pk2(v0[0], v0[1]); w.y = pk2(v0[2], v0[3]); w.z = pk2(v1[0], v1[1]); w.w = pk2(v1[2], v1[3]);
    *(u32x4*)(skb + e) = w;
}
constexpr int FILL_RP = 4;
#ifndef FILL_SPLIT
#define FILL_SPLIT 0
#endif
constexpr int FILL_PU = 0, FILL_PV = 8192 / (8 * FILL_RP), FILL_WOUT = 2 * FILL_PV, FILL_WQ = FILL_WOUT + DM / 16, FILL_SK = FILL_WQ + DM / 16, FILL_END = FILL_SK + 64;
DI void filler_item(const Args& a, LAS unsigned char* lds, int fi, int lane, int wave) {
    LAS float* scr = (LAS float*)(lds + wave * 8704);
    if (fi < FILL_PV) peer_conv_rows(a, 0, (fi * 8 + wave) * FILL_RP, FILL_RP, lane);
    else if (fi < FILL_WOUT) peer_conv_rows(a, 1, ((fi - FILL_PV) * 8 + wave) * FILL_RP, FILL_RP, lane);
    else if (fi < FILL_WQ) coltile_q8_item(a.in[I_WOUT], DM, a.ws + WS_WOUT, (float*)(a.ws + SM_SWO), lds, fi - FILL_WOUT, wave * 64 + lane);
    else if (fi < FILL_SK) coltile_q8_item(a.in[I_WQ], DM, a.ws + WS_WQ, (float*)(a.ws + SM_SWQ), lds, fi - FILL_WQ, wave * 64 + lane);
    else sk_conv_item(a, (fi - FILL_SK) * 8 + wave, lane);
}
DI void phase_prep(const Args& a, LAS unsigned char* lds, int gw, int NGW, int lane, int wave) {
    unsigned char* ws = a.ws;
    LAS float* scr = (LAS float*)(lds + wave * 8704);
    constexpr int I_IN = (DM / 64) * (NP / 32), I_C1 = (2048 / 64) * (256 / 32), I_C2 = (256 / 64) * (64 / 32);
    constexpr int NITEMS = I_IN + 2 * I_C1 + 2 * I_C2;
    for (int it = gw + I_IN; it < NITEMS; it += NGW) {
        int r = it;
        if (r < I_IN) { continue; } r -= I_IN;
        if (r < I_C1) { transpose_item(a.in[I_WCK1], 2048, 256, 256, (bf16_t*)(ws + SM_W1K), scr, r, lane, nullptr); continue; } r -= I_C1;
        if (r < I_C1) { transpose_item(a.in[I_WCV1], 2048, 256, 256, (bf16_t*)(ws + SM_W1V), scr, r, lane, nullptr); continue; } r -= I_C1;
        if (r < I_C2) { transpose_item(a.in[I_WCK2], 256, 64, 64, (bf16_t*)(ws + SM_W2K), scr, r, lane, nullptr); continue; } r -= I_C2;
        transpose_item(a.in[I_WCV2], 256, 64, 64, (bf16_t*)(ws + SM_W2V), scr, r, lane, nullptr);
    }
    {
        const float* x = a.in[I_X]; const float* w1 = a.in[I_N1W]; unsigned char* XN = ws + WS_XN; float* sxa = (float*)(ws + WS_XN + 32 * MiB);
        f32x4 wv[8];
#pragma unroll
        for (int j = 0; j < 8; ++j) wv[j] = *(const f32x4*)(w1 + 4 * lane + 256 * j);
        for (int m2 = gw; m2 < M / 2; m2 += NGW) {
            f32x4 v[2][8];
#pragma unroll
            for (int rr = 0; rr < 2; ++rr)
#pragma unroll
                for (int j = 0; j < 8; ++j) v[rr][j] = ((const f32x4*)(x + (size_t)(2 * m2 + rr) * DM) + lane)[64 * j];
#pragma unroll
            for (int rr = 0; rr < 2; ++rr) { float s = 0.f;
#pragma unroll
                for (int j = 0; j < 8; ++j) s += (v[rr][j][0] * v[rr][j][0] + v[rr][j][1] * v[rr][j][1]) + (v[rr][j][2] * v[rr][j][2] + v[rr][j][3] * v[rr][j][3]);
                const float rstd = __builtin_amdgcn_rsqf(wave_sum(s) * (1.f / DM) + EPS);
                f32x4 y[8]; float am = 0.f;
#pragma unroll
                for (int j = 0; j < 8; ++j) { y[j] = v[rr][j] * rstd * wv[j]; am = fmaxf(am, fmaxf(fmaxf(fabsf(y[j][0]), fabsf(y[j][1])), fmaxf(fabsf(y[j][2]), fabsf(y[j][3])))); }
#pragma unroll
                for (int o = 1; o < 64; o <<= 1) am = fmaxf(am, __shfl_xor(am, o));
                const float qs = am > 0.f ? 127.f / am : 0.f;
                if (lane == 0) sxa[2 * m2 + rr] = am * (1.f / 127.f);
                unsigned* o4 = (unsigned*)(XN + (size_t)(2 * m2 + rr) * DM) + lane;
#pragma unroll
                for (int j = 0; j < 8; ++j) o4[64 * j] = pack_q8(fmaf(y[j][0], qs, Q8_MAGIC), fmaf(y[j][1], qs, Q8_MAGIC), fmaf(y[j][2], qs, Q8_MAGIC), fmaf(y[j][3], qs, Q8_MAGIC)); }
        }
    }
    {
        const int tid = threadIdx.x, blk = blockIdx.x;
        if (blk == 0) { for (int c = tid; c < 1024; c += NTHREADS) { const float l0 = a.in[I_LB][c], l1 = a.in[I_LB][1024 + c]; ((float*)(ws + SM_LB))[c] = 1.f / (1.f + __expf(l1 - l0)); } }
        if (blk >= 1 && blk <= 32) { const int part = blk - 1, mat = tid >> 8, j = tid & 255;
            const float* w1 = a.in[mat ? I_WCV1 : I_WCK1]; const float* pos = a.in[mat ? I_POSV : I_POSK]; float acc = 0.f;
            for (int i = part * 64; i < part * 64 + 64; ++i) acc += pos[i] * w1[(size_t)i * 256 + j];
            ((float*)(ws + SM_BIASP))[part * 512 + tid] = acc; }
    }
}

DI void rowquant_mix(const Args& a, int gw, int NGW, int lane) {
    const bf16_t* MIX = (const bf16_t*)(a.ws + WS_XN); unsigned char* A8 = a.ws + WS_MIX8; float* rs = (float*)(a.ws + WS_MIX8 + 32 * MiB);
    for (int row = gw; row < M; row += NGW) {
        u32x4 v[4]; float am = 0.f;
#pragma unroll
        for (int j = 0; j < 4; ++j) v[j] = ((const u32x4*)(MIX + (size_t)row * DM) + lane)[64 * j];
#pragma unroll
        for (int j = 0; j < 4; ++j)
#pragma unroll
            for (int i = 0; i < 4; ++i) am = fmaxf(am, fmaxf(fabsf(bflo(v[j][i])), fabsf(bfhi(v[j][i]))));
#pragma unroll
        for (int o = 1; o < 64; o <<= 1) am = fmaxf(am, __shfl_xor(am, o));
        const float qs = am > 0.f ? 127.f / am : 0.f;
        if (lane == 0) rs[row] = am * (1.f / 127.f);
        u32x2* o2 = (u32x2*)(A8 + (size_t)row * DM) + lane;
#pragma unroll
        for (int j = 0; j < 4; ++j) { u32x2 w;
            w.x = pack_q8(fmaf(bflo(v[j][0]), qs, Q8_MAGIC), fmaf(bfhi(v[j][0]), qs, Q8_MAGIC), fmaf(bflo(v[j][1]), qs, Q8_MAGIC), fmaf(bfhi(v[j][1]), qs, Q8_MAGIC));
            w.y = pack_q8(fmaf(bflo(v[j][2]), qs, Q8_MAGIC), fmaf(bfhi(v[j][2]), qs, Q8_MAGIC), fmaf(bflo(v[j][3]), qs, Q8_MAGIC), fmaf(bfhi(v[j][3]), qs, Q8_MAGIC));
            o2[64 * j] = w; }
    }
}
DI void rowquant_h(const Args& a, int gw, int NGW, int lane) {
    const float* w2 = a.in[I_N2W]; unsigned char* A8 = a.ws + WS_HQ8; float* rs = (float*)(a.ws + WS_DQ);
    f32x4 wv[8];
#pragma unroll
    for (int j = 0; j < 8; ++j) wv[j] = *(const f32x4*)(w2 + 4 * lane + 256 * j);
    for (int row = gw; row < M; row += NGW) {
        f32x4 v[8]; float s = 0.f, am = 0.f;
#pragma unroll
        for (int j = 0; j < 8; ++j) v[j] = ((const f32x4*)(a.out + (size_t)row * DM) + lane)[64 * j];
#pragma unroll
        for (int j = 0; j < 8; ++j) { s += (v[j][0] * v[j][0] + v[j][1] * v[j][1]) + (v[j][2] * v[j][2] + v[j][3] * v[j][3]); v[j] = v[j] * wv[j];
            am = fmaxf(am, fmaxf(fmaxf(fabsf(v[j][0]), fabsf(v[j][1])), fmaxf(fabsf(v[j][2]), fabsf(v[j][3])))); }
        s = wave_sum(s);
#pragma unroll
        for (int o = 1; o < 64; o <<= 1) am = fmaxf(am, __shfl_xor(am, o));
        const float qs = am > 0.f ? 127.f / am : 0.f;
        if (lane == 0) rs[row] = am * (1.f / 127.f) * __builtin_amdgcn_rsqf(s * (1.f / DM) + EPS);
        unsigned* o4 = (unsigned*)(A8 + (size_t)row * DM) + lane;
#pragma unroll
        for (int j = 0; j < 8; ++j) o4[64 * j] = pack_q8(fmaf(v[j][0], qs, Q8_MAGIC), fmaf(v[j][1], qs, Q8_MAGIC), fmaf(v[j][2], qs, Q8_MAGIC), fmaf(v[j][3], qs, Q8_MAGIC));
    }
}
DI int perm16(int t) { return (t & ~12) | ((t & 4) << 1) | ((t & 8) >> 1); }

DI void nsa_norm_row(const Args& a, int row, int lane) {
    bf16_t* pr = (bf16_t*)(a.ws + WS_P) + (size_t)row * NP;
    const int c8 = lane & 7;
    const f32x4 qw0 = *(const f32x4*)(a.in[I_QNW] + 8 * c8), qw1 = *(const f32x4*)(a.in[I_QNW] + 8 * c8 + 4);
    const float* kwp = a.in[lane < 32 ? I_KSNW : I_KWNW];
    const f32x4 kw0 = *(const f32x4*)(kwp + 8 * c8), kw1 = *(const f32x4*)(kwp + 8 * c8 + 4);
    bf16_t* p0 = pr + C_NQ + 8 * lane; bf16_t* p1 = pr + C_NQ + 512 + 8 * lane; bf16_t* p2 = pr + (lane < 32 ? C_NKS + 8 * lane : C_NKW + 8 * (lane - 32));
    const u32x4 v0 = *(const u32x4*)p0, v1 = *(const u32x4*)p1, v2 = *(const u32x4*)p2;
    auto nrm = [&](const u32x4 v, const f32x4 w0, const f32x4 w1, float extra) -> u32x4 {
        float f[8] = {bflo(v.x), bfhi(v.x), bflo(v.y), bfhi(v.y), bflo(v.z), bfhi(v.z), bflo(v.w), bfhi(v.w)};
        float s = 0.f;
#pragma unroll
        for (int i = 0; i < 8; ++i) s += f[i] * f[i];
        s += __shfl_xor(s, 1); s += __shfl_xor(s, 2); s += __shfl_xor(s, 4);
        const float r = __builtin_amdgcn_rsqf(s * (1.f / 64.f) + EPS) * extra;
        u32x4 o; o.x = pk2(f[0] * r * w0[0], f[1] * r * w0[1]); o.y = pk2(f[2] * r * w0[2], f[3] * r * w0[3]);
        o.z = pk2(f[4] * r * w1[0], f[5] * r * w1[1]); o.w = pk2(f[6] * r * w1[2], f[7] * r * w1[3]); return o; };
    *(u32x4*)p0 = nrm(v0, qw0, qw1, 0.125f * LOG2E);
    *(u32x4*)p1 = nrm(v1, qw0, qw1, 0.125f * LOG2E);
    *(u32x4*)p2 = nrm(v2, kw0, kw1, 1.f);
}

DI void vtrans_item(const Args& a, LAS unsigned char* scr, int item, int lane) {
    const int which = item >> 10, b = (item >> 7) & 7, g = (item >> 5) & 3, tt = item & 31;
    const bf16_t* src = (const bf16_t*)(a.ws + WS_P) + (size_t)(b * SEQ + 64 * tt + lane) * NP + (which ? C_NVW : C_NVS) + g * 64;
    u32x4 v[8];
#pragma unroll
    for (int j = 0; j < 8; ++j) v[j] = *(const u32x4*)(src + 8 * j);
    const int tp = perm16(lane);
#pragma unroll
    for (int j = 0; j < 8; ++j) {
        const unsigned w[4] = {v[j].x, v[j].y, v[j].z, v[j].w};
#pragma unroll
        for (int i = 0; i < 4; ++i) {
            *(LAS bf16_t*)(scr + (8 * j + 2 * i) * 144 + 2 * tp) = (bf16_t)(w[i] & 0xffffu);
            *(LAS bf16_t*)(scr + (8 * j + 2 * i + 1) * 144 + 2 * tp) = (bf16_t)(w[i] >> 16);
        }
    }
    LDS_WAIT(); asm volatile("" ::: "memory");
    bf16_t* dst = (bf16_t*)(a.ws + WS_VT) + (size_t)which * (32 * 64 * SEQ) + (size_t)((b * 4 + g) * 64 + lane) * SEQ + 64 * tt;
#pragma unroll
    for (int j = 0; j < 8; ++j) *(u32x4*)(dst + 8 * j) = *(const LAS u32x4*)(scr + lane * 144 + 16 * j);
    LDS_WAIT(); asm volatile("" ::: "memory");
}

DI void compress_item(const Args& a, LAS unsigned char* lds, int item, int tid, int lane, int wave) {
    const int kv = item >> 7, b = (item >> 4) & 7, g = (item >> 2) & 3, n0 = 32 * (item & 3);
    const int hi = lane >> 5, r32 = lane & 31;
    const bf16_t* P = (const bf16_t*)(a.ws + WS_P);
    const bf16_t* w1T = (const bf16_t*)(a.ws + (kv ? SM_W1V : SM_W1K));
    const bf16_t* w2T = (const bf16_t*)(a.ws + (kv ? SM_W2V : SM_W2K));
    int nabs = n0 + r32; if (nabs > 126) nabs = 126;
    const bf16_t* ap = P + (size_t)(b * SEQ + 16 * nabs) * NP + (kv ? C_NVC : C_NKC) + g * 64 + 8 * hi;
    const bf16_t* bp = w1T + (size_t)(32 * wave + r32) * 2048 + 8 * hi;
    float bpv[32]; { const float* bpart = (const float*)(a.ws + SM_BIASP) + kv * 256 + 32 * wave + r32;
#pragma unroll
        for (int p = 0; p < 32; ++p) bpv[p] = bpart[p * 512]; }
    f32x16 acc;
#pragma unroll
    for (int i = 0; i < 16; ++i) acc[i] = 0.f;
    {
        LAS unsigned char* wl = lds + 20480 + wave * 9216;
        const int r8 = lane >> 3, c8 = lane & 7;
        const bf16_t* ga[4]; const bf16_t* gb[4];
#pragma unroll
        for (int q = 0; q < 4; ++q) { int na = n0 + r8 + 8 * q; if (na > 126) na = 126;
            ga[q] = P + (size_t)(b * SEQ + 16 * na) * NP + (kv ? C_NVC : C_NKC) + g * 64 + 8 * c8;
            gb[q] = w1T + (size_t)(32 * wave + r8 + 8 * q) * 2048 + 8 * c8; }
        u32x4 ra[4], rb[4];
        auto gload = [&](int l) {
#pragma unroll
            for (int q = 0; q < 4; ++q) { ra[q] = *(const u32x4*)(ga[q] + (size_t)l * NP); rb[q] = *(const u32x4*)(gb[q] + l * 64); } };
        auto lwrite = [&]() {
#pragma unroll
            for (int q = 0; q < 4; ++q) { *(LAS u32x4*)(wl + (r8 + 8 * q) * 144 + c8 * 16) = ra[q]; *(LAS u32x4*)(wl + 4608 + (r8 + 8 * q) * 144 + c8 * 16) = rb[q]; } };
        gload(0); lwrite(); gload(1);
#pragma unroll 1
        for (int l = 0; l < 32; ++l) {
            LDS_WAIT();
            bf16x8 fa[4], fb[4];
#pragma unroll
            for (int kk = 0; kk < 4; ++kk) { fa[kk] = *(const LAS bf16x8*)(wl + r32 * 144 + 32 * kk + 16 * hi); fb[kk] = *(const LAS bf16x8*)(wl + 4608 + r32 * 144 + 32 * kk + 16 * hi); }
            LDS_WAIT();
#pragma unroll
            for (int kk = 0; kk < 4; ++kk) acc = MFMA32(fa[kk], fb[kk], acc);
            if (l + 1 < 32) { lwrite(); if (l + 2 < 32) gload(l + 2); }
        }
    }
    bf16x8 w2f[2][16];
    if (wave == 0) {
#pragma unroll
        for (int db = 0; db < 2; ++db)
#pragma unroll
            for (int ks = 0; ks < 16; ++ks) w2f[db][ks] = *(const bf16x8*)(w2T + (size_t)(32 * db + r32) * 256 + 16 * ks + 8 * hi);
    }
    float bias = 0.f;
#pragma unroll
    for (int p = 0; p < 32; ++p) bias += bpv[p];
#pragma unroll
    for (int r = 0; r < 16; ++r) { const int n = crow(r, hi); *(LAS bf16_t*)(lds + (n * 264 + 32 * wave + r32) * 2) = f2bf(gelu_tanh(acc[r] + bias)); }
    __syncthreads();
    if (wave == 0) {
        f32x16 c[2];
#pragma unroll
        for (int db = 0; db < 2; ++db) {
#pragma unroll
            for (int i = 0; i < 16; ++i) c[db][i] = 0.f;
#pragma unroll
            for (int ks = 0; ks < 16; ++ks) {
                const bf16x8 bv = *(const LAS bf16x8*)(lds + (r32 * 264 + 16 * ks + 8 * hi) * 2);
                c[db] = MFMA32(w2f[db][ks], bv, c[db]);
            }
        }
        const int bg = b * 4 + g;
        if (kv == 0) {
            float ss = 0.f;
#pragma unroll
            for (int db = 0; db < 2; ++db)
#pragma unroll
                for (int r = 0; r < 16; ++r) ss += c[db][r] * c[db][r];
            ss += __shfl_xor(ss, 32);
            const float rstd = __builtin_amdgcn_rsqf(ss * (1.f / 64.f) + EPS);
            bf16_t* kc = (bf16_t*)(a.ws + SM_KC) + (size_t)(bg * 128 + n0 + r32) * 64;
#pragma unroll
            for (int db = 0; db < 2; ++db)
#pragma unroll
                for (int c4 = 0; c4 < 4; ++c4) { const int d0 = 32 * db + 8 * c4 + 4 * hi; const f32x4 w = *(const f32x4*)(a.in[I_KCNW] + d0);
                    u32x2 o; o.x = pk2(c[db][4 * c4] * rstd * w[0], c[db][4 * c4 + 1] * rstd * w[1]); o.y = pk2(c[db][4 * c4 + 2] * rstd * w[2], c[db][4 * c4 + 3] * rstd * w[3]);
                    *(u32x2*)(kc + d0) = o; }
        } else {
            bf16_t* vct = (bf16_t*)(a.ws + SM_VCT) + (size_t)bg * 64 * 128 + perm16(n0 + r32);
#pragma unroll
            for (int db = 0; db < 2; ++db)
#pragma unroll
                for (int r = 0; r < 16; ++r) vct[(size_t)(32 * db + crow(r, hi)) * 128] = f2bf(c[db][r]);
        }
    }
    __syncthreads();
}

template <int CTRL> DI float dpp_f(float v) { return __builtin_bit_cast(float, __builtin_amdgcn_update_dpp(0, __builtin_bit_cast(int, v), CTRL, 0xf, 0xf, true)); }
template <int CTRL> DI int dpp_i(int v) { return __builtin_amdgcn_update_dpp(0, v, CTRL, 0xf, 0xf, true); }
constexpr int HL_QD = 0, HL_KD = 17408, HL_KET = 34816, HL_IT = 53248, HL_AT = 71680, HL_DEC = 80896, HL_SEG = 81408, HL_SSQ = 85504, HL_G = 87552;
static_assert(HL_G + 2 * 64 * 272 <= LDS_BYTES - 64, "hgrn LDS");
struct HgRaw { unsigned f[8], q[8], i[8]; u32x4 g[2]; };
DI void hgrn_item(const Args& a, LAS unsigned char* lds, int item, int tid, int lane, int wave) {
    const int b = item >> 3, h = item & 7;
    const bf16_t* P = (const bf16_t*)(a.ws + WS_P);
    bf16_t* MIX = (bf16_t*)(a.ws + WS_XN);
    const int c2 = tid & 63, sg = tid >> 6, l15 = lane & 15, q4 = lane >> 4;
    const f32x2 lb2 = *(const f32x2*)((const float*)(a.ws + SM_LB) + h * 128 + 2 * c2);
    const float gnw = a.in[I_HGNW][16 * wave + l15];
    const __amdgpu_buffer_rsrc_t prs = __builtin_amdgcn_make_buffer_rsrc((void*)P, 0, (int)((size_t)M * NP * 2), 0x00020000);
    const int voffA = ((8 * sg) * NP + h * 128 + 2 * c2) * 2;
    const int grow = tid >> 3, gch = tid & 7;
    const int voffG = (grow * NP + C_HG + h * 128 + 16 * gch) * 2;
    auto load_raw = [&](HgRaw& R, int n) { const int soff0 = (b * SEQ + 64 * n) * NP * 2;
#pragma unroll
        for (int tt = 0; tt < 8; ++tt) { R.f[tt] = __builtin_amdgcn_raw_buffer_load_b32(prs, voffA, soff0 + tt * NP * 2 + C_HF * 2, 0);
            R.q[tt] = __builtin_amdgcn_raw_buffer_load_b32(prs, voffA, soff0 + tt * NP * 2 + C_HQ * 2, 0);
            R.i[tt] = __builtin_amdgcn_raw_buffer_load_b32(prs, voffA, soff0 + tt * NP * 2 + C_HI * 2, 0); }
        R.g[0] = __builtin_bit_cast(u32x4, __builtin_amdgcn_raw_buffer_load_b128(prs, voffG, soff0, 0)); R.g[1] = __builtin_bit_cast(u32x4, __builtin_amdgcn_raw_buffer_load_b128(prs, voffG + 16, soff0, 0)); };
    f32x4 S[8];
#pragma unroll
    for (int i = 0; i < 8; ++i) S[i] = (f32x4){0.f, 0.f, 0.f, 0.f};
    HgRaw R; load_raw(R, 0);
    for (int n = 0; n < 32; ++n) {
        const int rowbase = b * SEQ + 64 * n;
        float cum[2][8], kk[2][8], qq[2][8]; unsigned iv[8]; float run0 = 1.f, run1 = 1.f;
#pragma unroll
        for (int tt = 0; tt < 8; ++tt) {
            kk[0][tt] = bflo(R.f[tt]); kk[1][tt] = bfhi(R.f[tt]);
            run0 *= 1.f - kk[0][tt]; run1 *= 1.f - kk[1][tt]; cum[0][tt] = run0; cum[1][tt] = run1;
            qq[0][tt] = bflo(R.q[tt]); qq[1][tt] = bfhi(R.q[tt]); iv[tt] = R.i[tt];
        }
        *(LAS u32x4*)(lds + HL_G + (n & 1) * 17408 + grow * 272 + gch * 32) = R.g[0]; *(LAS u32x4*)(lds + HL_G + (n & 1) * 17408 + grow * 272 + gch * 32 + 16) = R.g[1];
        *(LAS f32x2*)(lds + HL_SEG + (sg * 128 + 2 * c2) * 4) = (f32x2){run0, run1};
        if (n + 1 < 32) load_raw(R, n + 1);
        __syncthreads();
        float off0 = 1.f, off1 = 1.f, bend0 = 1.f, bend1 = 1.f;
#pragma unroll
        for (int s2 = 0; s2 < 8; ++s2) { const f32x2 v = *(const LAS f32x2*)(lds + HL_SEG + (s2 * 128 + 2 * c2) * 4); bend0 *= v[0]; bend1 *= v[1]; if (s2 < sg) { off0 *= v[0]; off1 *= v[1]; } }
        unsigned ke0[4], ke1[4];
#pragma unroll
        for (int tt = 0; tt < 8; ++tt) {
            const float eb0 = off0 * cum[0][tt], eb1 = off1 * cum[1][tt]; const int t = 8 * sg + tt;
            const float kd0 = kk[0][tt] * fast_rcp(eb0), kd1 = kk[1][tt] * fast_rcp(eb1);
            *(LAS unsigned*)(lds + HL_QD + (t * 136 + 2 * c2) * 2) = pk2(qq[0][tt] * eb0, qq[1][tt] * eb1);
            *(LAS unsigned*)(lds + HL_KD + (t * 136 + 2 * c2) * 2) = pk2(kd0, kd1);
            const unsigned e0 = pk2(kd0 * bend0, 0.f) & 0xffffu, e1 = pk2(kd1 * bend1, 0.f) & 0xffffu;
            if (tt & 1) { ke0[tt >> 1] |= e0 << 16; ke1[tt >> 1] |= e1 << 16; } else { ke0[tt >> 1] = e0; ke1[tt >> 1] = e1; }
        }
        *(LAS u32x4*)(lds + HL_KET + ((2 * c2) * 72 + 8 * sg) * 2) = (u32x4){ke0[0], ke0[1], ke0[2], ke0[3]};
        *(LAS u32x4*)(lds + HL_KET + ((2 * c2 + 1) * 72 + 8 * sg) * 2) = (u32x4){ke1[0], ke1[1], ke1[2], ke1[3]};
        { u32x4 i0, i1;
#pragma unroll
          for (int k = 0; k < 4; ++k) { i0[k] = (iv[2 * k] & 0xffffu) | (iv[2 * k + 1] << 16); i1[k] = (iv[2 * k] >> 16) | (iv[2 * k + 1] & 0xffff0000u); }
          *(LAS u32x4*)(lds + HL_IT + ((2 * c2) * 72 + 8 * sg) * 2) = i0; *(LAS u32x4*)(lds + HL_IT + ((2 * c2 + 1) * 72 + 8 * sg) * 2) = i1; }
        if (sg == 0) *(LAS f32x2*)(lds + HL_DEC + 2 * c2 * 4) = (f32x2){bend0, bend1};
        __syncthreads();
#pragma unroll
        for (int u = 0; u < 2; ++u) {
            const int tile = 2 * wave + u, tb = tile >> 2, sb = tile & 3;
            f32x4 acc = (f32x4){0.f, 0.f, 0.f, 0.f};
            if (sb <= tb) {
#pragma unroll
                for (int ks = 0; ks < 4; ++ks) {
                    const bf16x8 av = *(const LAS bf16x8*)(lds + HL_QD + ((16 * tb + l15) * 136 + 32 * ks + 8 * q4) * 2);
                    const bf16x8 bv = *(const LAS bf16x8*)(lds + HL_KD + ((16 * sb + l15) * 136 + 32 * ks + 8 * q4) * 2);
                    acc = MFMA16(av, bv, acc);
                }
            }
#pragma unroll
            for (int r = 0; r < 4; ++r) { const int t = 16 * tb + 4 * q4 + r, s2 = 16 * sb + l15;
                *(LAS bf16_t*)(lds + HL_AT + (t * 72 + s2) * 2) = f2bf(s2 <= t ? acc[r] : 0.f); }
        }
        __syncthreads();
        f32x4 o[4];
        bf16x8 sfrag[4];
#pragma unroll
        for (int ks = 0; ks < 4; ++ks) { u32x4 w; w.x = pk2(S[2 * ks][0], S[2 * ks][1]); w.y = pk2(S[2 * ks][2], S[2 * ks][3]); w.z = pk2(S[2 * ks + 1][0], S[2 * ks + 1][1]); w.w = pk2(S[2 * ks + 1][2], S[2 * ks + 1][3]);
            sfrag[ks] = __builtin_bit_cast(bf16x8, w); }
        bf16x8 itf[2];
#pragma unroll
        for (int ks = 0; ks < 2; ++ks) itf[ks] = *(const LAS bf16x8*)(lds + HL_IT + ((16 * wave + l15) * 72 + 32 * ks + 8 * q4) * 2);
#pragma unroll
        for (int tb = 0; tb < 4; ++tb) {
            o[tb] = (f32x4){0.f, 0.f, 0.f, 0.f};
#pragma unroll
            for (int ks = 0; ks < 2; ++ks) {
                const bf16x8 av = *(const LAS bf16x8*)(lds + HL_AT + ((16 * tb + l15) * 72 + 32 * ks + 8 * q4) * 2);
                o[tb] = MFMA16(av, itf[ks], o[tb]);
            }
#pragma unroll
            for (int ks = 0; ks < 4; ++ks) {
                const u32x2 lo = *(const LAS u32x2*)(lds + HL_QD + ((16 * tb + l15) * 136 + 32 * ks + 4 * q4) * 2);
                const u32x2 hi2 = *(const LAS u32x2*)(lds + HL_QD + ((16 * tb + l15) * 136 + 32 * ks + 16 + 4 * q4) * 2);
                const bf16x8 av = __builtin_bit_cast(bf16x8, (u32x4){lo.x, lo.y, hi2.x, hi2.y});
                o[tb] = MFMA16(av, sfrag[ks], o[tb]);
            }
        }
#pragma unroll
        for (int cb = 0; cb < 8; ++cb) {
            const f32x4 d4 = *(const LAS f32x4*)(lds + HL_DEC + (16 * cb + 4 * q4) * 4);
            S[cb] = S[cb] * d4;
#pragma unroll
            for (int ks = 0; ks < 2; ++ks) {
                const bf16x8 av = *(const LAS bf16x8*)(lds + HL_KET + ((16 * cb + l15) * 72 + 32 * ks + 8 * q4) * 2);
                S[cb] = MFMA16(av, itf[ks], S[cb]);
            }
        }
#pragma unroll
        for (int tb = 0; tb < 4; ++tb)
#pragma unroll
            for (int r = 0; r < 4; ++r) { float v = o[tb][r] * o[tb][r];
                v += dpp_f<0xB1>(v); v += dpp_f<0x4E>(v); v += dpp_f<0x141>(v); v += dpp_f<0x140>(v);
                if (l15 == 0) *(LAS float*)(lds + HL_SSQ + (wave * 64 + 16 * tb + 4 * q4 + r) * 4) = v; }
        __syncthreads();
        float rs_mine; { const int tm = 16 * (l15 >> 2) + 4 * q4 + (l15 & 3); float tot = 0.f;
#pragma unroll
            for (int w = 0; w < 8; ++w) tot += *(const LAS float*)(lds + HL_SSQ + (w * 64 + tm) * 4);
            rs_mine = __builtin_amdgcn_rsqf(tot * (1.f / 128.f) + EPS); }
#pragma unroll
        for (int tb = 0; tb < 4; ++tb)
#pragma unroll
            for (int r = 0; r < 4; ++r) { const int t = 16 * tb + 4 * q4 + r;
                const float rstd = __shfl(rs_mine, (lane & 48) + 4 * tb + r);
                const float g = bf2f(*(const LAS bf16_t*)(lds + HL_G + (n & 1) * 17408 + t * 272 + (16 * wave + l15) * 2));
                MIX[(size_t)(rowbase + t) * DM + h * 128 + 16 * wave + l15] = f2bf(o[tb][r] * rstd * gnw * (g * sigmoidf_(g))); }
    }
}

constexpr int AL_K = 0, AL_V = 18432, AL_IMP = 36864, AL_SELM = 70656, AL_STASH = 71680;
static_assert(AL_STASH + 8 * 8192 <= LDS_BYTES - 64, "attention LDS");
constexpr float NEGBIG = -1e30f;
DI bf16x8 pack8(const f32x16& p, int s) {
    u32x4 w; w.x = pk2(p[8 * s], p[8 * s + 1]); w.y = pk2(p[8 * s + 2], p[8 * s + 3]); w.z = pk2(p[8 * s + 4], p[8 * s + 5]); w.w = pk2(p[8 * s + 6], p[8 * s + 7]);
    return __builtin_bit_cast(bf16x8, w);
}
DI void attn_scores(LAS unsigned char* lds, int buf, const bf16x8 (&qf)[4], f32x16& p0, f32x16& p1, int q32, int hi) {
    const LAS unsigned char* kb = lds + AL_K + buf * 9216 + q32 * 144 + hi * 16;
#pragma unroll
    for (int i = 0; i < 16; ++i) { p0[i] = 0.f; p1[i] = 0.f; }
#pragma unroll
    for (int kk = 0; kk < 4; ++kk) {
        const bf16x8 a0 = *(const LAS bf16x8*)(kb + kk * 32), a1 = *(const LAS bf16x8*)(kb + 32 * 144 + kk * 32);
        p0 = MFMA32(a0, qf[kk], p0); p1 = MFMA32(a1, qf[kk], p1);
    }
}
DI void attn_pv(LAS unsigned char* lds, int buf, const f32x16& p0, const f32x16& p1, f32x16 (&o)[2], int q32, int hi) {
    const LAS unsigned char* vb = lds + AL_V + buf * 9216 + q32 * 144 + hi * 16;
    const bf16x8 pb0 = pack8(p0, 0), pb1 = pack8(p0, 1), pb2 = pack8(p1, 0), pb3 = pack8(p1, 1);
#pragma unroll
    for (int db = 0; db < 2; ++db) {
        const LAS unsigned char* v2 = vb + db * 32 * 144;
        o[db] = MFMA32(*(const LAS bf16x8*)(v2), pb0, o[db]);
        o[db] = MFMA32(*(const LAS bf16x8*)(v2 + 32), pb1, o[db]);
        o[db] = MFMA32(*(const LAS bf16x8*)(v2 + 64), pb2, o[db]);
        o[db] = MFMA32(*(const LAS bf16x8*)(v2 + 96), pb3, o[db]);
    }
}
DI void attn_scores_biased(LAS unsigned char* lds, int buf, const bf16x8 (&qf)[4], const f32x16& a0, const f32x16& a1, f32x16& p0, f32x16& p1, int q32, int hi) {
    const LAS unsigned char* kb = lds + AL_K + buf * 9216 + q32 * 144 + hi * 16;
    p0 = MFMA32(*(const LAS bf16x8*)(kb), qf[0], a0); p1 = MFMA32(*(const LAS bf16x8*)(kb + 32 * 144), qf[0], a1);
#pragma unroll
    for (int kk = 1; kk < 4; ++kk) {
        p0 = MFMA32(*(const LAS bf16x8*)(kb + kk * 32), qf[kk], p0); p1 = MFMA32(*(const LAS bf16x8*)(kb + 32 * 144 + kk * 32), qf[kk], p1);
    }
}
template <int MODE>
DI void attn_stream(LAS unsigned char* lds, const bf16_t* kbase, const bf16_t* vbase, unsigned tmask, unsigned fullmask, unsigned mymask, int cur, int tq, float slope2, float gate,
                    const bf16x8 (&qf)[4], const f32x16& a0, const f32x16& a1, f32x16 (&o)[2], int tid, int q32, int hi) {
    const int srow = tid >> 3, sch = tid & 7;
    float m = NEGBIG, lsum = 0.f;
#pragma unroll
    for (int i = 0; i < 16; ++i) { o[0][i] = 0.f; o[1][i] = 0.f; }
    auto next_tile = [&]() -> int { if (!tmask) return -1; const int t = 31 - __clz(tmask); tmask &= ~(1u << t); return t; };
    int j = next_tile();
    u32x4 kA = *(const u32x4*)(kbase + (size_t)(64 * j + srow) * NP + 8 * sch), vA = *(const u32x4*)(vbase + (size_t)srow * SEQ + 64 * j + 8 * sch);
    u32x4 kB = kA, vB = vA;
    int jn = next_tile();
    if (jn >= 0) { kB = *(const u32x4*)(kbase + (size_t)(64 * jn + srow) * NP + 8 * sch); vB = *(const u32x4*)(vbase + (size_t)srow * SEQ + 64 * jn + 8 * sch); }
    __syncthreads();
    *(LAS u32x4*)(lds + AL_K + srow * 144 + sch * 16) = kA; *(LAS u32x4*)(lds + AL_V + srow * 144 + sch * 16) = vA;
    __syncthreads();
    auto step = [&](u32x4& kL, u32x4& vL, const u32x4& kS, const u32x4& vS, const int bufc) -> bool {
        const int jnn = (jn >= 0) ? next_tile() : -1;
        if (jnn >= 0) { kL = *(const u32x4*)(kbase + (size_t)(64 * jnn + srow) * NP + 8 * sch); vL = *(const u32x4*)(vbase + (size_t)srow * SEQ + 64 * jnn + 8 * sch); }
        f32x16 p0, p1;
        attn_scores_biased(lds, bufc, qf, a0, a1, p0, p1, q32, hi);
        const float Bj = -slope2 * (float)(64 * (cur - j));
        if (!((fullmask >> j) & 1u)) {
            const bool selv = (MODE == 0) ? (((mymask >> j) & 1u) != 0u) : true;
            float basef = (float)(tq - 64 * j - 4 * hi); asm volatile("" : "+v"(basef));
#pragma unroll
            for (int r = 0; r < 16; ++r) {
                const float d0 = basef - (float)((r & 3) + 8 * (r >> 2)), d1 = d0 - 32.f;
                const bool v0 = (MODE == 0) ? (selv && d0 >= 0.f) : (d0 >= 0.f && d0 < 512.f);
                const bool v1 = (MODE == 0) ? (selv && d1 >= 0.f) : (d1 >= 0.f && d1 < 512.f);
                p0[r] = v0 ? p0[r] : NEGBIG; p1[r] = v1 ? p1[r] : NEGBIG;
            }
        }
        float mx = fmaxf(p0[0], p1[0]);
#pragma unroll
        for (int r = 1; r < 16; ++r) mx = fmaxf(mx, fmaxf(p0[r], p1[r]));
        mx = fmaxf(mx, __shfl_xor(mx, 32));
        const float mcand = mx + Bj;
        if (__any(mcand > m)) {
            const float mnew = fmaxf(m, mcand), alpha = fast_exp2(m - mnew); m = mnew; lsum *= alpha;
#pragma unroll
            for (int i = 0; i < 16; ++i) { o[0][i] *= alpha; o[1][i] *= alpha; }
        }
        const float madj = m - Bj;
        float ps = 0.f;
#pragma unroll
        for (int r = 0; r < 16; ++r) { p0[r] = fast_exp2(p0[r] - madj); p1[r] = fast_exp2(p1[r] - madj); ps += p0[r] + p1[r]; }
        lsum += ps;
        attn_pv(lds, bufc, p0, p1, o, q32, hi);
        if (jn < 0) return false;
        *(LAS u32x4*)(lds + AL_K + (bufc ^ 1) * 9216 + srow * 144 + sch * 16) = kS; *(LAS u32x4*)(lds + AL_V + (bufc ^ 1) * 9216 + srow * 144 + sch * 16) = vS;
        __syncthreads();
        j = jn; jn = jnn;
        return true;
    };
    for (;;) { if (!step(kA, vA, kB, vB, 0)) break; if (!step(kB, vB, kA, vA, 1)) break; }
    const float ltot = lsum + __shfl_xor(lsum, 32);
    const float sc = (m > -1e29f) ? gate * fast_rcp(ltot) : 0.f;
#pragma unroll
    for (int i = 0; i < 16; ++i) { o[0][i] *= sc; o[1][i] *= sc; }
}

DI void attn_item(const Args& a, LAS unsigned char* lds, int item, int tid, int lane, int wave) {
    const int qt = 31 - (item >> 5), b = (item >> 2) & 7, g = item & 3, bg = b * 4 + g;
    const int cur = qt, t0 = 64 * qt, r = wave >> 1, head = 4 * g + r, q32 = lane & 31, hi = lane >> 5, tl = 32 * (wave & 1) + q32, tq = t0 + tl;
    const bf16_t* P = (const bf16_t*)(a.ws + WS_P);
    const float slope2 = exp2f(-0.5f * (float)(head + 1)) * LOG2E;
    const bf16_t* prow = P + (size_t)(b * SEQ + tq) * NP;
    bf16x8 qf[4];
#pragma unroll
    for (int kk = 0; kk < 4; ++kk) qf[kk] = *(const bf16x8*)(prow + C_NQ + head * 64 + 16 * kk + 8 * hi);
    const float g0 = sigmoidf_(bf2f(prow[C_GATE + head * 3])), g1 = sigmoidf_(bf2f(prow[C_GATE + head * 3 + 1])), g2 = sigmoidf_(bf2f(prow[C_GATE + head * 3 + 2]));
    LAS float* stash = (LAS float*)(lds + AL_STASH + wave * 8192) + lane;
    const int srow = tid >> 3, sch = tid & 7;
    {
        const int ntile = (qt >= 16) ? 2 : 1;
        const bf16_t* kc = (const bf16_t*)(a.ws + SM_KC) + (size_t)bg * 128 * 64;
        const bf16_t* vct = (const bf16_t*)(a.ws + SM_VCT) + (size_t)bg * 64 * 128;
        {
            const u32x4 k0 = *(const u32x4*)(kc + (size_t)srow * 64 + 8 * sch), v0 = *(const u32x4*)(vct + (size_t)srow * 128 + 8 * sch);
            u32x4 k1 = k0, v1 = v0;
            if (ntile == 2) { k1 = *(const u32x4*)(kc + (size_t)(64 + srow) * 64 + 8 * sch); v1 = *(const u32x4*)(vct + (size_t)srow * 128 + 64 + 8 * sch); }
            *(LAS u32x4*)(lds + AL_K + srow * 144 + sch * 16) = k0; *(LAS u32x4*)(lds + AL_V + srow * 144 + sch * 16) = v0;
            *(LAS u32x4*)(lds + AL_K + 9216 + srow * 144 + sch * 16) = k1; *(LAS u32x4*)(lds + AL_V + 9216 + srow * 144 + sch * 16) = v1;
        }
        __syncthreads();
        f32x16 p[4];
        attn_scores(lds, 0, qf, p[0], p[1], q32, hi);
        attn_scores(lds, 1, qf, p[2], p[3], q32, hi);
        float mx = NEGBIG;
#pragma unroll
        for (int kb = 0; kb < 4; ++kb)
#pragma unroll
            for (int rr = 0; rr < 16; ++rr) { const int n = 32 * kb + crow(rr, hi); const int d = tq - (16 * n + 31);
                const bool v = (d >= 0) && (kb < 2 * ntile);
                p[kb][rr] = v ? p[kb][rr] - slope2 * (float)d : NEGBIG; mx = fmaxf(mx, p[kb][rr]); }
        mx = fmaxf(mx, __shfl_xor(mx, 32));
        float ps = 0.f;
#pragma unroll
        for (int kb = 0; kb < 4; ++kb)
#pragma unroll
            for (int rr = 0; rr < 16; ++rr) { p[kb][rr] = fast_exp2(p[kb][rr] - mx); ps += p[kb][rr]; }
        ps += __shfl_xor(ps, 32);
        const float inv = (mx > -1e29f) ? fast_rcp(ps) : 0.f;
#pragma unroll
        for (int kb = 0; kb < 4; ++kb)
#pragma unroll
            for (int rr = 0; rr < 16; ++rr) p[kb][rr] *= inv;
        float rc_prev = 0.f;
#pragma unroll
        for (int k = 0; k < 16; ++k) { const int kb = k >> 2, c4 = k & 3; const float bc = p[kb][4 * c4 + 3]; const float av = (p[kb][4 * c4] + p[kb][4 * c4 + 1]) + (p[kb][4 * c4 + 2] + bc);
            const float rc = __shfl_xor(bc, 32); const float v = av + (hi ? rc : rc_prev); rc_prev = rc;
            *(LAS float*)(lds + AL_IMP + ((r * 64 + tl) * 33 + 2 * k + hi) * 4) = v; }
        f32x16 o[2];
#pragma unroll
        for (int i = 0; i < 16; ++i) { o[0][i] = 0.f; o[1][i] = 0.f; }
        attn_pv(lds, 0, p[0], p[1], o, q32, hi);
        if (ntile == 2) attn_pv(lds, 1, p[2], p[3], o, q32, hi);
#pragma unroll
        for (int i = 0; i < 16; ++i) { stash[i * 64] = g0 * o[0][i]; stash[(16 + i) * 64] = g0 * o[1][i]; }
    }
    __syncthreads();
    {
        const int tok = tid >> 3, jg = tid & 7;
        float v[32];
#pragma unroll
        for (int j = 0; j < 32; ++j) { float s = 0.f;
#pragma unroll
            for (int rr = 0; rr < 4; ++rr) s += *(const LAS float*)(lds + AL_IMP + ((rr * 64 + tok) * 33 + j) * 4);
            const bool forced = (j == 0) || (j == cur) || (j == cur - 1);
            v[j] = forced ? 1e9f : ((j > cur) ? -1e9f : s); }
        unsigned bits = 0u;
#pragma unroll
        for (int i = 0; i < 4; ++i) {
            float mine = 0.f;
#pragma unroll
            for (int j = 0; j < 32; ++j) if ((j >> 2) == jg && (j & 3) == i) mine = v[j];
            const int jme = 4 * jg + i; int rank = 0;
#pragma unroll
            for (int j = 0; j < 32; ++j) rank += (v[j] > mine || (v[j] == mine && j < jme)) ? 1 : 0;
            if (rank < 16) bits |= 1u << jme;
        }
        bits |= __shfl_xor(bits, 1); bits |= __shfl_xor(bits, 2); bits |= __shfl_xor(bits, 4);
        if (jg == 0) *(LAS unsigned*)(lds + AL_SELM + tok * 4) = bits;
    }
    __syncthreads();
    unsigned umask = *(const LAS unsigned*)(lds + AL_SELM + lane * 4);
#pragma unroll
    for (int o2 = 1; o2 < 64; o2 <<= 1) umask |= __shfl_xor(umask, o2);
    const unsigned mymask = *(const LAS unsigned*)(lds + AL_SELM + tl * 4);
    const unsigned causal = (cur == 31) ? 0xffffffffu : ((1u << (cur + 1)) - 1u);
    umask = __builtin_amdgcn_readfirstlane(umask & causal);
    f32x16 ob[2];
    f32x16 ab0, ab1;
#pragma unroll
    for (int rr = 0; rr < 16; ++rr) { ab0[rr] = slope2 * (float)(crow(rr, hi) - tl); ab1[rr] = slope2 * (float)(crow(rr, hi) + 32 - tl); }
    unsigned amask = *(const LAS unsigned*)(lds + AL_SELM + lane * 4);
#pragma unroll
    for (int o2 = 1; o2 < 64; o2 <<= 1) amask &= __shfl_xor(amask, o2);
    const unsigned below = (1u << cur) - 1u;
    const unsigned sfull = __builtin_amdgcn_readfirstlane(amask) & below;
    attn_stream<0>(lds, P + (size_t)(b * SEQ) * NP + C_NKS + g * 64, (const bf16_t*)(a.ws + WS_VT) + (size_t)bg * 64 * SEQ, umask, sfull, mymask, cur, tq, slope2, g1, qf, ab0, ab1, ob, tid, q32, hi);
#pragma unroll
    for (int i = 0; i < 16; ++i) { stash[i * 64] += ob[0][i]; stash[(16 + i) * 64] += ob[1][i]; }
    const int wlo = cur >= 8 ? cur - 8 : 0;
    const unsigned wmask = causal & ~((1u << wlo) - 1u);
    const unsigned wfull = below & ~((1u << (cur >= 7 ? cur - 7 : 0)) - 1u);
    attn_stream<1>(lds, P + (size_t)(b * SEQ) * NP + C_NKW + g * 64, (const bf16_t*)(a.ws + WS_VT) + (size_t)(32 * 64 * SEQ) + (size_t)bg * 64 * SEQ, wmask, wfull, 0u, cur, tq, slope2, g2, qf, ab0, ab1, ob, tid, q32, hi);
#pragma unroll
    for (int i = 0; i < 16; ++i) { ob[0][i] += stash[i * 64]; ob[1][i] += stash[(16 + i) * 64]; }
    bf16_t* mo = (bf16_t*)(a.ws + WS_XN) + (size_t)(b * SEQ + tq) * DM + 1024 + head * 64;
#pragma unroll
    for (int db = 0; db < 2; ++db)
#pragma unroll
        for (int c4 = 0; c4 < 4; ++c4) { u32x2 w; w.x = pk2(ob[db][4 * c4], ob[db][4 * c4 + 1]); w.y = pk2(ob[db][4 * c4 + 2], ob[db][4 * c4 + 3]);
            *(u32x2*)(mo + 32 * db + 8 * c4 + 4 * hi) = w; }
}

DI unsigned f2sort(float f) { const unsigned u = __float_as_uint(f); return u ^ ((u >> 31) ? 0xffffffffu : 0x80000000u); }
DI float sort2f(unsigned u) { return __uint_as_float(u ^ ((u >> 31) ? 0x80000000u : 0xffffffffu)); }
DI void ce_desc(unsigned& x, unsigned& y) { const unsigned hi = max(x, y), lo = min(x, y); x = hi; y = lo; }
template <int NA> DI void sort16_desc(unsigned (&a)[NA], const int off) {
#pragma unroll
    for (int ks = 1; ks <= 4; ++ks)
#pragma unroll
        for (int js = 0; js < 4; ++js) { const int k = 1 << ks, jb = ks - 1 - js;
            if (jb >= 0) { const int j = 1 << jb;
#pragma unroll
                for (int i = 0; i < 16; ++i) { const int l = i ^ j; if (l > i) { if ((i & k) == 0) ce_desc(a[off + i], a[off + l]); else ce_desc(a[off + l], a[off + i]); } } } }
}
template <int NA> DI void merge_top16(unsigned (&a)[NA], const int oa, const int ob) {
#pragma unroll
    for (int i = 0; i < 16; ++i) a[oa + i] = max(a[oa + i], a[ob + 15 - i]);
#pragma unroll
    for (int js = 0; js < 4; ++js) { const int j = 8 >> js;
#pragma unroll
        for (int i = 0; i < 16; ++i) { const int l = i ^ j; if (l > i) ce_desc(a[oa + i], a[oa + l]); } }
}
DI void top16_of_64(unsigned (&a)[64]) { sort16_desc(a, 0); sort16_desc(a, 16); sort16_desc(a, 32); sort16_desc(a, 48); merge_top16(a, 0, 16); merge_top16(a, 32, 48); merge_top16(a, 0, 32); }
DI void topk_item(const Args& a, LAS unsigned char* wl, int item, int lane, LAS unsigned* lcnt) {
    const int tt = item >> 3, h = item & 7, q32 = lane & 31, hi = lane >> 5, tok = 32 * tt + q32;
    const __amdgpu_buffer_rsrc_t SKb = __builtin_amdgcn_make_buffer_rsrc((void*)(a.ws + SM_SK), 0, 524288, 0x00020000);
    const __amdgpu_buffer_rsrc_t Qb = __builtin_amdgcn_make_buffer_rsrc((void*)(a.ws + WS_QP), 0, 64 << 20, 0x00020000);
    LAS unsigned* tab = (LAS unsigned*)wl;
    unsigned top[2][16];
#pragma unroll
    for (int p = 0; p < 2; ++p) {
        f32x16 acc[4];
#pragma unroll
        for (int kb = 0; kb < 4; ++kb)
#pragma unroll
            for (int i = 0; i < 16; ++i) acc[kb][i] = 0.f;
        const int kvo = (q32 * 128 + 8 * hi) * 2, qvo = (q32 * DM + 8 * hi) * 2;
#pragma unroll
        for (int ks = 0; ks < 8; ++ks) {
            const bf16x8 qv = __builtin_bit_cast(bf16x8, __builtin_amdgcn_raw_buffer_load_b128(Qb, qvo, ((32 * tt) * DM + h * 256 + p * 128 + 16 * ks) * 2, 0));
#pragma unroll
            for (int kb = 0; kb < 4; ++kb) acc[kb] = MFMA32(__builtin_bit_cast(bf16x8, __builtin_amdgcn_raw_buffer_load_b128(SKb, kvo, (((h * 2 + p) * 128 + 32 * kb) * 128 + 16 * ks) * 2, 0)), qv, acc[kb]);
        }
        int h4 = 4 * hi; asm volatile("" : "+v"(h4));
        unsigned key[64];
#pragma unroll
        for (int kb = 0; kb < 4; ++kb)
#pragma unroll
            for (int r = 0; r < 16; ++r) key[kb * 16 + r] = (f2sort(acc[kb][r]) & ~127u) | (unsigned)(127 - (32 * kb + (r & 3) + 8 * (r >> 2)) - h4);
        top16_of_64(key);
#pragma unroll
        for (int i = 0; i < 16; ++i) key[16 + i] = (unsigned)__shfl_xor((int)key[i], 32);
        merge_top16(key, 0, 16);
#pragma unroll
        for (int i = 0; i < 16; ++i) { top[p][i] = key[i]; tab[(p * 16 + i) * 64 + lane] = key[i]; }
    }
    unsigned cand[64]; { int n = 0;
#pragma unroll
        for (int i = 0; i < 16; ++i)
#pragma unroll
            for (int j = 0; j < 16; ++j) if ((i + 1) * (j + 1) <= 16) { cand[n] = (f2sort(sort2f(top[0][i] & ~127u) + sort2f(top[1][j] & ~127u)) & ~255u) | (unsigned)(255 - (16 * i + j)); ++n; }
#pragma unroll
        for (int i = 50; i < 64; ++i) cand[i] = 0u; }
    top16_of_64(cand);
    const float vmax = sort2f(cand[0] & ~255u);
    float e[16], esum = 0.f; unsigned ex[16];
#pragma unroll
    for (int rd = 0; rd < 16; ++rd) {
        const unsigned m = cand[rd]; const int cidx = 255 - (int)(m & 255u), ci = cidx >> 4, cj = cidx & 15;
        e[rd] = __expf(sort2f(m & ~255u) - vmax); esum += e[rd];
        const unsigned i0 = 127u - (tab[ci * 64 + lane] & 127u), i1 = 127u - (tab[(16 + cj) * 64 + lane] & 127u);
        ex[rd] = i0 * 128u + i1;
    }
    if (hi == 0) {
        LAS unsigned* cnt = lcnt + (q32 >> 4) * 16; unsigned* lt = (unsigned*)(a.ws + WS_LIST) + (size_t)(2 * tt + (q32 >> 4)) * 2048; unsigned* lm = (unsigned*)(a.ws + WS_LISTM) + (size_t)(2 * tt + (q32 >> 4)) * 4096;
        unsigned* pidx = (unsigned*)(a.ws + WS_PIDX) + (size_t)tok * 128 + h * 16; unsigned pos[16];
#pragma unroll
        for (int rd = 0; rd < 16; ++rd) { const unsigned g = ex[rd] >> 10, el = ex[rd] & 1023u;
            pos[rd] = __hip_atomic_fetch_add(cnt + g, 1u, __ATOMIC_RELAXED, __HIP_MEMORY_SCOPE_WORKGROUP);
            const unsigned ent = (el << 7) | (((el >> 1) & 7u) << 4) | ((unsigned)(q32 & 3) << 17) | ((unsigned)((q32 >> 2) & 3) << 24), p = pos[rd];
            if (p < 256u) lm[g * 256u + (p >> 6) * 64u + (p & 15u) * 4u + ((p >> 4) & 3u)] = ent;
            if (p >= 192u) lt[(size_t)g * (1024 * 2048) + (p & 15u) * 128u + (p >> 4)] = ent; }
#pragma unroll
        for (int k4 = 0; k4 < 4; ++k4) *(u32x4*)(pidx + 4 * k4) = (u32x4){pos[4 * k4], pos[4 * k4 + 1], pos[4 * k4 + 2], pos[4 * k4 + 3]};
        const float inv = 1.f / esum;
        unsigned* ei = (unsigned*)(a.ws + WS_EI) + (size_t)tok * 128 + h * 16; float* eg = (float*)(a.ws + WS_EG) + (size_t)tok * 128 + h * 16;
#pragma unroll
        for (int k4 = 0; k4 < 4; ++k4) {
            *(u32x4*)(ei + 4 * k4) = (u32x4){ex[4 * k4], ex[4 * k4 + 1], ex[4 * k4 + 2], ex[4 * k4 + 3]};
            *(f32x4*)(eg + 4 * k4) = (f32x4){e[4 * k4] * inv, e[4 * k4 + 1] * inv, e[4 * k4 + 2] * inv, e[4 * k4 + 3] * inv};
        }
    }
}

#define XB_TMO      128
#define XB_XCNT(j)  (256  + 64 * (j))
#define XB_XSUB(j)  (1280 + 64 * (j))
#define XB_XGEN(j)  (2304 + 64 * (j))
#define XB_TOP      3328
#define XB_TOPGEN   3392
#define XCD_BAR_WORDS 3456
#define XB_SPIN_CAP (1u << 22)
DI unsigned xb_ld(unsigned* p)              { return __hip_atomic_load(p, __ATOMIC_RELAXED, __HIP_MEMORY_SCOPE_AGENT); }
DI unsigned xb_add(unsigned* p, unsigned v) { return __hip_atomic_fetch_add(p, v, __ATOMIC_RELAXED, __HIP_MEMORY_SCOPE_AGENT); }
DI unsigned xb_xcc_id() { return (unsigned)__builtin_amdgcn_s_getreg((3 << 11) | 20) & 0xFu; }
#define XB_SPIN(cond, bar) do { unsigned _sp = 0; while (cond) { __builtin_amdgcn_s_sleep(1); \
    if ((++_sp & 255u) == 0u) { if (xb_ld(&(bar)[XB_TMO])) break; if (_sp > XB_SPIN_CAP) { atomicAdd(&(bar)[XB_TMO], 1u); break; } } } } while (0)
struct XcdBarrier { unsigned* bar; unsigned x; volatile LAS unsigned* st; };
DI XcdBarrier xcd_barrier_post(unsigned* bar, volatile LAS unsigned* st) {
    XcdBarrier b; b.bar = bar; b.x = xb_xcc_id(); b.st = st;
    if (threadIdx.x == 0) (void)xb_add(&bar[XB_XCNT(b.x)], 1u);
    return b;
}
DI void xcd_barrier_complete(unsigned* bar, unsigned x, unsigned& nloc, unsigned& nx) {
    const unsigned G = gridDim.x * gridDim.y * gridDim.z;
    unsigned sum, cnt, mine, sp = 0u;
    for (;;) {
        sum = 0u; cnt = 0u; mine = 0u;
#pragma unroll
        for (unsigned j = 0; j < 16; ++j) { const unsigned c = xb_ld(&bar[XB_XCNT(j)]); sum += c; cnt += (c > 0u) ? 1u : 0u; mine = (j == x) ? c : mine; }
        if (sum == G) break;
        __builtin_amdgcn_s_sleep(1);
        if ((++sp & 255u) == 0u) { if (xb_ld(&bar[XB_TMO])) break; if (sp > XB_SPIN_CAP) { atomicAdd(&bar[XB_TMO], 1u); break; } }
    }
    nloc = mine > 0u ? mine : 1u; nx = cnt > 0u ? cnt : 1u;
}
DI void xcd_barrier(const XcdBarrier& b) {
    asm volatile("s_waitcnt vmcnt(0)" ::: "memory");
    __syncthreads();
    if (threadIdx.x == 0) {
        unsigned* bar = b.bar;
        __builtin_amdgcn_s_waitcnt(0);
        unsigned nloc = b.st[0], nx = b.st[1];
        if (nloc == 0u) { xcd_barrier_complete(bar, b.x, nloc, nx); b.st[0] = nloc; b.st[1] = nx; }
        const unsigned old = xb_add(&bar[XB_XSUB(b.x)], 1u);
        const unsigned gen = old / nloc;
        if (old + 1u == (gen + 1u) * nloc) {
            __builtin_amdgcn_fence(__ATOMIC_RELEASE, "agent");
            asm volatile("s_waitcnt vmcnt(0)" ::: "memory");
            const unsigned og = xb_add(&bar[XB_TOP], 1u);
            const unsigned tg = og / nx;
            if (og + 1u == (tg + 1u) * nx) xb_add(&bar[XB_TOPGEN], 1u);
            else XB_SPIN(xb_ld(&bar[XB_TOPGEN]) == tg, bar);
            __builtin_amdgcn_fence(__ATOMIC_ACQUIRE, "agent");
            xb_add(&bar[XB_XGEN(b.x)], 1u);
            asm volatile("s_waitcnt vmcnt(0)" ::: "memory");
        } else {
            XB_SPIN(xb_ld(&bar[XB_XGEN(b.x)]) == gen, bar);
            __builtin_amdgcn_fence(__ATOMIC_ACQUIRE, "agent");
            asm volatile("s_waitcnt vmcnt(0)" ::: "memory");
        }
    }
    __syncthreads();
}

constexpr int SLICE_BYTES = 16384 * 128;
constexpr int PEER_TT = 128, PEER_NT = PEER_TT / 8;
struct PeerIdxW { u32x4 e4[4]; };
struct PeerVRows { u32x4 r[16]; u32x2 h2; };
struct UTile { u32x4 a0, a1, e0, e1, e2; unsigned n, off; };
struct UBuf { i32x4 b0[4], b1[4]; unsigned en[4]; };
DI void peer_u_lds_phase(const Args& a, LAS unsigned char* lds, int tid, int lane, int wave) {
    LAS int* rslot = (LAS int*)(lds + LDS_BYTES - 64);
    unsigned* ctl = (unsigned*)(a.ws + WS_CTL);
    const int xcd = (int)(xb_xcc_id() & 7u);
    for (;;) {
        __syncthreads();
        if (tid == 0) { int role = -1;
            if (__hip_atomic_load(ctl + CW_ROLE + 512, __ATOMIC_RELAXED, __HIP_MEMORY_SCOPE_AGENT) < 256u)
                for (int q = 0; q < 8 && role < 0; ++q) { const int x = (xcd + q) & 7; const unsigned r = atomicAdd(ctl + CW_ROLE + 64 * x, 1u); if (r < 32u) role = (int)((((unsigned)x + 8u * (r >> 4)) << 4) | (r & 15u)); }
            if (role >= 0) atomicAdd(ctl + CW_ROLE + 512, 1u);
            *rslot = role; }
        __syncthreads();
        const int role = *rslot; if (role < 0) break;
        const int s = role >> 4, g = role & 15;
        { const unsigned char* src = a.ws + WS_UB + (size_t)s * SLICE_BYTES + (size_t)g * 131072;
#pragma unroll
          for (int hb = 0; hb < 2; ++hb) { u32x4 v[8];
#pragma unroll
            for (int i = 0; i < 8; ++i) v[i] = *(const u32x4*)(src + (size_t)(tid + 512 * (8 * hb + i)) * 16);
#pragma unroll
            for (int i = 0; i < 8; ++i) { const int idx = tid + 512 * (8 * hb + i), e = idx >> 3, c = idx & 7; *(LAS u32x4*)(lds + e * 128 + ((c ^ ((e >> 1) & 7)) << 4)) = v[i]; } } }
        __syncthreads();
        const int j = lane & 15, kg = lane >> 4;
        const __amdgpu_buffer_rsrc_t Hb = __builtin_amdgcn_make_buffer_rsrc((void*)(a.ws + WS_HQ8), 0, 32 << 20, 0x00020000);
        const __amdgpu_buffer_rsrc_t Mb = __builtin_amdgcn_make_buffer_rsrc((void*)(a.ws + WS_LISTM), 0, 16 << 20, 0x00020000);
        const __amdgpu_buffer_rsrc_t Lb = __builtin_amdgcn_make_buffer_rsrc((void*)(a.ws + WS_LIST + (size_t)g * (8 << 20)), 0, 8 << 20, 0x00020000);
        const __amdgpu_buffer_rsrc_t Cb = __builtin_amdgcn_make_buffer_rsrc((void*)(ctl + CW_CNT), 0, 131072, 0x00020000);
        const __amdgpu_buffer_rsrc_t Pb = __builtin_amdgcn_make_buffer_rsrc((void*)(a.ws + WS_PU + (size_t)s * M * 512), 0, M * 512, 0x00020000);
        auto load = [&](UTile& t, int T) {
            t.n = (unsigned)__builtin_amdgcn_raw_buffer_load_b32(Cb, 0, (T * 16 + g) * 4, 0); t.off = (unsigned)__builtin_amdgcn_raw_buffer_load_b32(Cb, 0, (CW_OFF - CW_CNT + T * 16 + g) * 4, 0);
            t.a0 = __builtin_bit_cast(u32x4, __builtin_amdgcn_raw_buffer_load_b128(Hb, j * DM + 128 * s + 16 * kg, T * (16 * DM), 0));
            t.a1 = __builtin_bit_cast(u32x4, __builtin_amdgcn_raw_buffer_load_b128(Hb, j * DM + 128 * s + 16 * kg + 64, T * (16 * DM), 0));
            t.e0 = __builtin_bit_cast(u32x4, __builtin_amdgcn_raw_buffer_load_b128(Mb, j * 16, T * 16384 + g * 1024, 0));
            t.e1 = __builtin_bit_cast(u32x4, __builtin_amdgcn_raw_buffer_load_b128(Mb, j * 16 + 256, T * 16384 + g * 1024, 0));
            t.e2 = __builtin_bit_cast(u32x4, __builtin_amdgcn_raw_buffer_load_b128(Mb, j * 16 + 512, T * 16384 + g * 1024, 0)); };
        auto issue = [&](UBuf& B, const u32x4 e4, int rt0, int n) {
#pragma unroll
            for (int v = 0; v < 4; ++v) { B.en[v] = e4[v];
                const unsigned ad = (B.en[v] & 0x1FFFFu) ^ ((unsigned)kg << 4);
                B.b0[v] = *(const LAS i32x4*)(lds + ad); B.b1[v] = *(const LAS i32x4*)(lds + (ad ^ 64u)); }
            __builtin_amdgcn_sched_barrier(0); };
        auto finish = [&](const UBuf& B, const i32x4 a0, const i32x4 a1, int rt0, int so) {
            i32x4 c[4];
#pragma unroll
            for (int v = 0; v < 4; ++v) c[v] = __builtin_amdgcn_mfma_i32_16x16x64_i8(a0, B.b0[v], (i32x4){0, 0, 0, 0}, 0, 0, 0);
#pragma unroll
            for (int v = 0; v < 4; ++v) c[v] = __builtin_amdgcn_mfma_i32_16x16x64_i8(a1, B.b1[v], c[v], 0, 0, 0);
            __builtin_amdgcn_sched_barrier(0);
#pragma unroll
            for (int v = 0; v < 4; ++v) {
                int m0, m1, v01, v23, val;
                asm("v_bfe_i32 %0, %1, 17, 1" : "=v"(m0) : "v"(B.en[v])); asm("v_bfe_i32 %0, %1, 18, 1" : "=v"(m1) : "v"(B.en[v]));
                asm("v_bfi_b32 %0, %1, %2, %3" : "=v"(v01) : "v"(m0), "v"(c[v][1]), "v"(c[v][0])); asm("v_bfi_b32 %0, %1, %2, %3" : "=v"(v23) : "v"(m0), "v"(c[v][3]), "v"(c[v][2]));
                asm("v_bfi_b32 %0, %1, %2, %3" : "=v"(val) : "v"(m1), "v"(v23), "v"(v01));
                if ((B.en[v] >> 24) == (unsigned)kg) __builtin_amdgcn_raw_buffer_store_b32((unsigned)val, Pb, (16 * (rt0 + v) + j) * 4, so, 0); }
            __builtin_amdgcn_sched_barrier(0); };
        auto proc = [&](const UTile& t, int T) {
            const int n = (int)__builtin_amdgcn_readfirstlane(t.n), nrt = (n + 15) >> 4;
            const i32x4 a0 = __builtin_bit_cast(i32x4, t.a0), a1 = __builtin_bit_cast(i32x4, t.a1);
            const int so = T * 8192 + 4 * (int)__builtin_amdgcn_readfirstlane(t.off);
            UBuf B0, B1;
            if (nrt > 0) { issue(B0, t.e0, 0, n);
                if (nrt > 4) { issue(B1, t.e1, 4, n); finish(B0, a0, a1, 0, so);
                    if (nrt > 8) { issue(B0, t.e2, 8, n); finish(B1, a0, a1, 4, so); finish(B0, a0, a1, 8, so); }
                    else finish(B1, a0, a1, 4, so); }
                else finish(B0, a0, a1, 0, so); }
            if (nrt > 12) {
#pragma unroll 1
                for (int c0 = 12; c0 < nrt; c0 += 4) { const u32x4 x0 = __builtin_bit_cast(u32x4, __builtin_amdgcn_raw_buffer_load_b128(Lb, j * 512 + c0 * 4, T * 8192, 0));
                    issue(B0, x0, c0, n); finish(B0, a0, a1, c0, so); }
                __builtin_amdgcn_s_waitcnt(0x0F70);
            } };
        UTile t0, t1, t2, t3; load(t0, wave); __builtin_amdgcn_sched_barrier(0); load(t1, wave + 8); __builtin_amdgcn_sched_barrier(0); load(t2, wave + 16); __builtin_amdgcn_sched_barrier(0);
#pragma unroll 1
        for (int T = wave; T < M / 16; T += 32) {
            const int Tn = T + 32 < M / 16 ? T + 32 : T;
            load(t3, T + 24);
            proc(t0, T);
            load(t0, Tn);
            proc(t1, T + 8);
            load(t1, Tn + 8);
            proc(t2, T + 16);
            load(t2, Tn + 16);
            proc(t3, T + 24);
        }
    }
}
DI void peer_reduce_tile(const Args& a, LAS unsigned char* lds, int T, int tid, int lane, int wave) {
    const unsigned* EI = (const unsigned*)(a.ws + WS_EI); const float* EG = (const float*)(a.ws + WS_EG); const unsigned* PIDX = (const unsigned*)(a.ws + WS_PIDX);
    const float* isU = (const float*)(a.ws + WS_UB + TAB_SCALE_OFF); const float* isV = (const float*)(a.ws + WS_VB + TAB_SCALE_OFF);
    LAS unsigned* loff = (LAS unsigned*)(lds + 131072);
    __syncthreads();
    { const unsigned char* src = a.ws + WS_PU + (size_t)T * 8192 + (size_t)tid * 16;
#pragma unroll
      for (int hb = 0; hb < 2; ++hb) { u32x4 v[8];
#pragma unroll
        for (int i = 0; i < 8; ++i) v[i] = *(const u32x4*)(src + (size_t)(8 * hb + i) * (8 << 20));
#pragma unroll
        for (int i = 0; i < 8; ++i) *(LAS u32x4*)(lds + (8 * hb + i) * 8192 + tid * 16) = v[i]; }
      if (tid < 16) loff[tid] = ((const unsigned*)(a.ws + WS_CTL))[CW_OFF + T * 16 + tid]; }
    __syncthreads();
#pragma unroll
    for (int tl = 0; tl < 2; ++tl) { const int tok = 16 * T + 2 * wave + tl; const float dq = ((const float*)(a.ws + WS_DQ))[tok];
#pragma unroll
        for (int hs = 0; hs < 2; ++hs) { const size_t idx = (size_t)tok * 128 + 64 * hs + lane; const unsigned e = EI[idx]; const float gt = EG[idx];
            const unsigned q = loff[e >> 10] + PIDX[idx]; int isum = 0;
#pragma unroll
            for (int s = 0; s < 16; ++s) isum += *(const LAS int*)(lds + s * 8192 + q * 4);
            const float w = gelu_tanh((float)isum * dq * isU[e]) * gt * isV[e];
            ((unsigned*)(a.ws + WS_W))[idx] = e | ((__float_as_uint(w) + 0x7fffu + ((__float_as_uint(w) >> 16) & 1u)) & 0xffff0000u); } }
}
DI void peer_v_item(const Args& a, int s, int tt, int lane, int wave) {
    const int g = lane >> 3, c8 = lane & 7;
    const __amdgpu_buffer_rsrc_t Vb = __builtin_amdgcn_make_buffer_rsrc((void*)(a.ws + WS_VB), 0, 32 << 20, 0x00020000);
    const __amdgpu_buffer_rsrc_t Wb = __builtin_amdgcn_make_buffer_rsrc((void*)(a.ws + WS_W), 0, 8 << 20, 0x00020000);
    const __amdgpu_buffer_rsrc_t Ob = __builtin_amdgcn_make_buffer_rsrc((void*)a.out, 0, (int)((size_t)M * DM * 4), 0x00020000);
    const int tok0 = PEER_TT * tt + wave;
    const int col = 128 * s + 2 * lane;
    const int psrc = ((lane >> 3) + 8 * (lane & 7)) * 4;
    auto pre = [&](PeerIdxW& E, int t) {
#pragma unroll
        for (int j = 0; j < 4; ++j) E.e4[j] = __builtin_bit_cast(u32x4, __builtin_amdgcn_raw_buffer_load_b128(Wb, g * 64 + 16 * j, (tok0 + 8 * t) * 512, 0)); };
    auto rows = [&](PeerVRows& R, const PeerIdxW& E, int t) {
#pragma unroll
        for (int i = 0; i < 16; ++i) R.r[i] = __builtin_bit_cast(u32x4, __builtin_amdgcn_raw_buffer_load_b128(Vb, (int)(E.e4[i >> 2][i & 3] & 0xffffu) * 128 + 16 * c8, s * SLICE_BYTES, 0));
        R.h2 = __builtin_bit_cast(u32x2, __builtin_amdgcn_raw_buffer_load_b64(Ob, col * 4, (tok0 + 8 * t) * (DM * 4), 0)); };
    auto comp = [&](const PeerVRows& R, const u32x4 (&w4)[4], int t) {
        f32x2 o2[8];
#pragma unroll
        for (int j = 0; j < 8; ++j) o2[j] = (f32x2){0.f, 0.f};
#pragma unroll
        for (int i = 0; i < 16; ++i) { const float w = __uint_as_float(w4[i >> 2][i & 3] & 0xffff0000u); const f32x2 w2 = (f32x2){w, w};
#pragma unroll
            for (int q = 0; q < 4; ++q) { const unsigned u = R.r[i][q]; o2[2 * q] += w2 * __builtin_amdgcn_cvt_pk_f32_fp8(u, false); o2[2 * q + 1] += w2 * __builtin_amdgcn_cvt_pk_f32_fp8(u, true); } }
        float v[16];
#pragma unroll
        for (int j = 0; j < 8; ++j) { v[2 * j] = o2[j][0]; v[2 * j + 1] = o2[j][1]; }
#pragma unroll
        for (int i = 0; i < 8; ++i) { float x = v[i], y = v[i + 8];
            asm volatile("s_nop 1\n\tv_permlane32_swap_b32 %0, %1" : "+v"(x), "+v"(y)); v[i] = x + y; }
#pragma unroll
        for (int i = 0; i < 4; ++i) { float x = v[i], y = v[i + 4];
            asm volatile("s_nop 1\n\tv_permlane16_swap_b32 %0, %1" : "+v"(x), "+v"(y)); v[i] = x + y; }
        { const bool up = (lane & 8) != 0;
#pragma unroll
          for (int i = 0; i < 2; ++i) { const float send = up ? v[i] : v[i + 2], keep = up ? v[i + 2] : v[i]; v[i] = keep + dpp_f<0x128>(send); } }
        f32x2 h2 = __builtin_bit_cast(f32x2, R.h2);
        h2[0] += __builtin_bit_cast(float, __builtin_amdgcn_ds_bpermute(psrc, __builtin_bit_cast(int, v[0]))); h2[1] += __builtin_bit_cast(float, __builtin_amdgcn_ds_bpermute(psrc, __builtin_bit_cast(int, v[1])));
        __builtin_amdgcn_raw_buffer_store_b64(__builtin_bit_cast(u32x2, h2), Ob, col * 4, (tok0 + 8 * t) * (DM * 4), 0); };
    PeerIdxW E0, E1; PeerVRows R0, R1; u32x4 wa[4], wb[4];
    pre(E0, 0); pre(E1, 1); rows(R0, E0, 0);
#pragma unroll
    for (int j = 0; j < 4; ++j) wa[j] = E0.e4[j];
#pragma unroll 1
    for (int t = 0; t < PEER_NT; t += 2) {
        rows(R1, E1, t + 1);
#pragma unroll
        for (int j = 0; j < 4; ++j) wb[j] = E1.e4[j];
        if (t + 2 < PEER_NT) pre(E0, t + 2);
        comp(R0, wa, t);
        if (t + 2 < PEER_NT) { rows(R0, E0, t + 2);
#pragma unroll
            for (int j = 0; j < 4; ++j) wa[j] = E0.e4[j]; }
        if (t + 3 < PEER_NT) pre(E1, t + 3);
        comp(R1, wb, t + 1);
    }
}
template <int VPH> DI void peer_sliced_phase(const Args& a, LAS unsigned char* lds, int tid, int lane, int wave) {
    LAS int* qslot = (LAS int*)(lds + LDS_BYTES - 64);
    const int xcd = (int)(xb_xcc_id() & 7u);
    for (int qi = 0; qi < 8; ++qi) {
        const int q = (xcd + qi) & 7; unsigned* head = (unsigned*)(a.ws + WS_CTL) + (VPH ? CW_PQV : CW_PQU) + 64 * q;
        for (;;) {
            __syncthreads();
            if (tid == 0) *qslot = (int)atomicAdd(head, 1u);
            __syncthreads();
            const int i = *qslot;
            if (i >= 2 * (M / PEER_TT)) break;
            const int s = q + 8 * (i / (M / PEER_TT)), tt = i % (M / PEER_TT);
            int l2 = (int)(threadIdx.x & 63u); asm volatile("" : "+v"(l2));
            peer_v_item(a, s, tt, l2, wave);
        }
    }
}

constexpr int NPHASE = 10;
#ifndef REPK
#define REPK -1
#endif
#define NREP(k) ((REPK) == (k) ? 2 : 1)
#ifndef PHMASK
#define PHMASK 0x3ff
#endif
__global__ void __launch_bounds__(NTHREADS, 2) fwd_kernel(Args a) {
    extern __shared__ __attribute__((aligned(16))) unsigned char lds_raw[];
    LAS unsigned char* lds = (LAS unsigned char*)lds_raw;
    cg::grid_group grid = cg::this_grid();
    int tid = threadIdx.x, lane = tid & 63, wave = __builtin_amdgcn_readfirstlane(tid >> 6);
    const int G = gridDim.x, NGW = G * NWAVES; int gw = blockIdx.x * NWAVES + wave;
#define FRESH() do { tid = threadIdx.x; asm volatile("" : "+v"(tid)); lane = tid & 63; wave = __builtin_amdgcn_readfirstlane(tid >> 6); gw = blockIdx.x * NWAVES + wave; } while (0)
    unsigned char* ws = a.ws;
    const int lo = a.ph_lo, hi = a.ph_hi;
#define IN(k) (lo <= (k) && (k) < hi)
#define SEAM(k) do { if (IN(k) && IN((k) + 1)) { if ((k) == 0) grid.sync(); else xcd_barrier(xbar); } } while (0)
    volatile LAS unsigned* xst = (volatile LAS unsigned*)(lds + LDS_BYTES - 32);
    if (tid < 2) xst[tid] = 0u;
    __syncthreads();
    const XcdBarrier xbar = xcd_barrier_post((unsigned*)(ws + WS_CTL) + CW_XBAR, xst);
    if (((PHMASK >> 0) & 1) && IN(0)) { FRESH(); for (int rep = 0; rep < NREP(0); ++rep) phase_prep(a, lds, gw, NGW, lane, wave);
        for (int fi = blockIdx.x; fi < FILL_SPLIT; fi += G) filler_item(a, lds, fi, lane, wave);
        for (int tile = blockIdx.x; tile < NP / 16; tile += G) coltile_q8_item(a.in[I_WIN], NPROJ, ws + WS_WIN, (float*)(ws + SM_SWC), lds, tile, tid); }
    SEAM(0);
    if (((PHMASK >> 1) & 1) && IN(1)) { FRESH();
        pg8::Gemm g{(const bf16_t*)(ws + WS_XN), (const bf16_t*)(ws + WS_WIN), M, NP, DM / 2}; pg8::StaticOrder S; S.init(M, NP, G, (int)blockIdx.x);
        pg8::EpiBf16 E{(bf16_t*)(ws + WS_P), NP, (const float*)(ws + SM_LB), (const float*)(ws + WS_XN + 32 * MiB), (const float*)(ws + SM_SWC)};
        for (int rep = 0; rep < NREP(1); ++rep) pg8::gemm_phase<pg8::EpiBf16, pg8::StaticOrder, true, true, true>(lds, g, S, E);
    }
    SEAM(1);
    if (((PHMASK >> 2) & 1) && IN(2)) { FRESH();
        for (int row = gw; row < M; row += NGW) nsa_norm_row(a, row, lane);
        for (int rep = 0; rep < NREP(2); ++rep) {
        for (int it = gw; it < 2048; it += NGW) vtrans_item(a, lds + wave * 9216, it, lane);
        __syncthreads();
        for (int it = blockIdx.x; it < 256; it += G) compress_item(a, lds, it, tid, lane, wave);
        }
    }
    SEAM(2);
    if (((PHMASK >> 3) & 1) && IN(3)) { FRESH();
        LAS int* qslot = (LAS int*)(lds + LDS_BYTES - 64);
        for (int rep = 0; rep < ((REPK) == 30 || (REPK) == 31 ? 2 : 1); ++rep) {
        unsigned* qhead = (unsigned*)(ws + WS_CTL) + CW_QUEUE + 64 * rep;
        const int item_lo = (rep == 1 && (REPK) == 31) ? 64 : 0, item_hi = (rep == 1 && (REPK) == 30) ? 64 : 64 + 1024 + FILL_END - FILL_SPLIT;
        for (;;) {
            __syncthreads();
            if (tid == 0) *qslot = (int)atomicAdd(qhead, 1u);
            __syncthreads();
            const int item = *qslot + item_lo;
            if (item >= item_hi) break;
            int tid2 = tid; asm volatile("" : "+v"(tid2));
            const int lane2 = tid2 & 63, wave2 = __builtin_amdgcn_readfirstlane(tid2 >> 6);

#ifndef NO_HGRN
            if (item < 64) hgrn_item(a, lds, item, tid2, lane2, wave2);
#endif
#ifndef NO_ATTN
            if (item >= 64) {
                constexpr int NF = FILL_END - FILL_SPLIT, NT = 1024 + NF; const int k = item - 64;
                const int a0 = (int)(((long)k * 1024) / NT), a1 = (int)(((long)(k + 1) * 1024) / NT);
                if (a1 != a0) attn_item(a, lds, a0, tid2, lane2, wave2); else filler_item(a, lds, k - a0 + FILL_SPLIT, lane2, wave2); }
#endif

        }
        }
    }
    SEAM(3);
    if (((PHMASK >> 4) & 1) && IN(4)) { FRESH();
        rowquant_mix(a, gw, NGW, lane);
        xcd_barrier(xbar);
        FRESH();
        pg8::Gemm g{(const bf16_t*)(ws + WS_MIX8), (const bf16_t*)(ws + WS_WOUT), M, DM, DM / 2}; pg8::StaticOrder S; S.init(M, DM, G, (int)blockIdx.x);
        pg8::EpiH E{a.in[I_X], a.out, (const float*)(ws + WS_MIX8 + 32 * MiB), (const float*)(ws + SM_SWO), lds + 131072};
        for (int rep = 0; rep < NREP(4); ++rep) pg8::gemm_phase<pg8::EpiH, pg8::StaticOrder, true, true, true>(lds, g, S, E);
    }
    SEAM(4);
    if (((PHMASK >> 5) & 1) && IN(5)) { FRESH();
        rowquant_h(a, gw, NGW, lane);
        xcd_barrier(xbar);
        FRESH();
        pg8::Gemm g{(const bf16_t*)(ws + WS_HQ8), (const bf16_t*)(ws + WS_WQ), M, DM, DM / 2}; pg8::StaticOrder S; S.init(M, DM, G, (int)blockIdx.x);
        pg8::EpiBf16 E{(bf16_t*)(ws + WS_QP), DM, nullptr, (const float*)(ws + WS_DQ), (const float*)(ws + SM_SWQ)};
        for (int rep = 0; rep < NREP(5); ++rep) pg8::gemm_phase<pg8::EpiBf16, pg8::StaticOrder, true, true, true>(lds, g, S, E);
    }
    SEAM(5);
    if (((PHMASK >> 6) & 1) && IN(6)) { FRESH(); for (int rep = 0; rep < NREP(6); ++rep) {
        LAS unsigned* lcnt = (LAS unsigned*)(lds + 131072);
        for (int it = gw; it < 4096; it += NGW) { int l2 = lane; asm volatile("" : "+v"(l2));
            if (tid < 32) lcnt[tid] = 0u;
            __syncthreads();
            topk_item(a, lds + wave * 16384, it, l2, lcnt);
            __syncthreads();
            if (tid < 32) { unsigned off = 0u; for (int g2 = 0; g2 < (tid & 15); ++g2) off += lcnt[(tid & 16) + g2];
                unsigned* ctl = (unsigned*)(ws + WS_CTL); const int ti = (2 * (it >> 3) + (tid >> 4)) * 16 + (tid & 15);
                ctl[CW_CNT + ti] = lcnt[tid]; ctl[CW_OFF + ti] = off; }
            { const int li = tid >> 4, g2 = li & 15; const unsigned n = lcnt[li], nup = (n + 63u) & ~63u;
                unsigned* lt = (unsigned*)(ws + WS_LIST) + (size_t)g2 * (1024 * 2048) + (size_t)(2 * (it >> 3) + (li >> 4)) * 2048;
                unsigned* lm = (unsigned*)(ws + WS_LISTM) + (size_t)(2 * (it >> 3) + (li >> 4)) * 4096 + g2 * 256;
#pragma unroll
                for (int k = 0; k < 4; ++k) { const unsigned p = n + (unsigned)(tid & 15) + 16u * k;
                    if (p < nup) { if (p < 256u) lm[(p >> 6) * 64u + (p & 15u) * 4u + ((p >> 4) & 3u)] = 0x80000000u; if (p >= 192u) lt[(p & 15u) * 128u + (p >> 4)] = 0x80000000u; } } }
        } } }
    SEAM(6);
    if (((PHMASK >> 7) & 1) && IN(7)) { FRESH(); peer_u_lds_phase(a, lds, tid, lane, wave); }
    SEAM(7);
    if (((PHMASK >> 8) & 1) && IN(8)) { FRESH(); for (int T = blockIdx.x; T < M / 16; T += G) peer_reduce_tile(a, lds, T, tid, lane, wave); }
    SEAM(8);
    if (((PHMASK >> 9) & 1) && IN(9)) { FRESH(); peer_sliced_phase<1>(a, lds, tid, lane, wave); }
#undef IN
#undef SEAM
}

#ifndef N_LAUNCH_MODE
#define N_LAUNCH_MODE 1
#endif
extern "C" void kernel_launch(void* const* d_in, const int* in_sizes, int n_in, void* d_out, int out_size, void* d_ws, size_t ws_size, hipStream_t stream) {
    static int grid = 0;
    if (grid == 0) {
        int dev = 0, cus = 0, per_cu = 0;
        (void)hipGetDevice(&dev); (void)hipDeviceGetAttribute(&cus, hipDeviceAttributeMultiprocessorCount, dev);
        (void)hipFuncSetAttribute((const void*)fwd_kernel, hipFuncAttributeMaxDynamicSharedMemorySize, LDS_BYTES);
        (void)hipOccupancyMaxActiveBlocksPerMultiprocessor(&per_cu, (const void*)fwd_kernel, NTHREADS, LDS_BYTES);
        if (per_cu < 1) { fprintf(stderr, "occupancy query says %d blocks/CU\n", per_cu); per_cu = 1; }
        grid = cus;
        if (ws_size < WS_END) fprintf(stderr, "warning: ws_size %zu too small\n", ws_size);
    }
    (void)hipMemsetAsync((char*)d_ws + WS_CTL, 0, CTL_BYTES, stream);
    Args a{};
    for (int i = 0; i < 21; ++i) a.in[i] = (const float*)d_in[i];
    a.out = (float*)d_out; a.ws = (unsigned char*)d_ws;
    if (N_LAUNCH_MODE == 1) {
        a.ph_lo = 0; a.ph_hi = NPHASE;
        void* args[] = {&a};
        hipError_t e = hipLaunchCooperativeKernel((const void*)fwd_kernel, dim3(grid), dim3(NTHREADS), args, LDS_BYTES, stream);
        if (e != hipSuccess) fprintf(stderr, "launch failed: %s\n", hipGetErrorString(e));
    } else {
        for (int p = 0; p < NPHASE; ++p) {
            a.ph_lo = p; a.ph_hi = p + 1;
            void* args[] = {&a};
            hipError_t e = hipLaunchCooperativeKernel((const void*)fwd_kernel, dim3(grid), dim3(NTHREADS), args, LDS_BYTES, stream);
            if (e != hipSuccess) { fprintf(stderr, "launch failed: %s\n", hipGetErrorString(e)); break; }
        }
    }
}
```

```cpp
#include <hip/hip_runtime.h>
#include <hip/hip_cooperative_groups.h>
#include <cstdio>
#include <cstdint>
namespace cg = cooperative_groups;

#define DI __device__ __forceinline__
#define LAS __attribute__((address_space(3)))
typedef unsigned short bf16_t;
typedef short bf16x8 __attribute__((ext_vector_type(8)));
typedef float f32x2 __attribute__((ext_vector_type(2)));
typedef float f32x4 __attribute__((ext_vector_type(4)));
typedef float f32x16 __attribute__((ext_vector_type(16)));
typedef unsigned u32x2 __attribute__((ext_vector_type(2)));
typedef int i32x4 __attribute__((ext_vector_type(4)));
typedef unsigned u32x4 __attribute__((ext_vector_type(4)));
typedef __bf16 bf16x2_t __attribute__((ext_vector_type(2)));

constexpr int DM = 2048, NB = 8, SEQ = 2048, M = NB * SEQ;
constexpr int NPROJ = 6704, NP = 6912;
constexpr int C_HQ = 0, C_HF = 1024, C_HI = 2048, C_HG = 3072, C_NQ = 4096, C_NKC = 5120, C_NVC = 5376, C_NKS = 5632, C_NVS = 5888, C_NKW = 6144, C_NVW = 6400, C_GATE = 6656;
constexpr float EPS = 1e-6f;
constexpr float LOG2E = 1.4426950408889634f;

constexpr size_t MiB = 1u << 20;
constexpr size_t WS_CTL = 0, CTL_BYTES = 1 * MiB;
constexpr size_t WS_WIN = 1 * MiB;
constexpr size_t WS_WOUT = 28 * MiB;
constexpr size_t WS_WQ = 36 * MiB;
constexpr size_t WS_SMALL = 44 * MiB;
constexpr size_t WS_UB = 52 * MiB;
constexpr size_t WS_VB = 116 * MiB;
constexpr size_t TAB_SCALE_OFF = 32 * MiB;
constexpr size_t WS_P = 180 * MiB;
constexpr size_t WS_XN = 396 * MiB;
constexpr size_t WS_VT = 460 * MiB;
constexpr size_t WS_SSQ = 476 * MiB;
constexpr size_t WS_LISTM = 478 * MiB;
constexpr size_t WS_END = 494 * MiB;
constexpr size_t WS_MIX8 = WS_P + 64 * MiB;
constexpr size_t WS_QP = WS_P + 64 * MiB;
constexpr size_t WS_EI = WS_P + 128 * MiB;
constexpr size_t WS_EG = WS_P + 136 * MiB;
constexpr size_t WS_W = WS_P + 144 * MiB;
constexpr size_t WS_HB = WS_P;
constexpr size_t WS_PU = WS_P + 64 * MiB;
constexpr size_t WS_LIST = WS_P + 152 * MiB;
constexpr size_t WS_PIDX = WS_VT;
constexpr size_t WS_HQ8 = WS_WIN;
constexpr size_t WS_DQ = WS_WIN + 32 * MiB;
constexpr size_t SM_W1K = WS_SMALL;
constexpr size_t SM_W1V = WS_SMALL + 1 * MiB;
constexpr size_t SM_W2K = WS_SMALL + 2 * MiB;
constexpr size_t SM_W2V = SM_W2K + 32768;
constexpr size_t SM_SK = WS_SMALL + 3 * MiB;
constexpr size_t SM_LB = WS_SMALL + 4 * MiB;
constexpr size_t SM_BIASP = SM_LB + 4096;
constexpr size_t SM_KC = WS_SMALL + 5 * MiB;
constexpr size_t SM_SWC = WS_SMALL + 7 * MiB;
constexpr size_t SM_SWQ = WS_SMALL + 7 * MiB + 32768;
constexpr size_t SM_SWO = WS_SMALL + 7 * MiB + 49152;
constexpr size_t SM_VCT = WS_SMALL + 6 * MiB;
static_assert(WS_END <= 512 * MiB, "ws");
constexpr int CW_QUEUE = 64;
constexpr int CW_PQU = 8192, CW_PQV = 9216;
constexpr int CW_ROLE = 10240;
constexpr int CW_CNT = 16384;
constexpr int CW_OFF = 32768;
constexpr int CW_XBAR = 4096;

constexpr int LDS_BYTES = 151552;
constexpr int NTHREADS = 512, NWAVES = 8;

DI unsigned pk2(float lo, float hi) { f32x2 v = {lo, hi}; bf16x2_t b = __builtin_convertvector(v, bf16x2_t); return __builtin_bit_cast(unsigned, b); }
DI bf16_t f2bf(float f) { return (bf16_t)(pk2(f, 0.f) & 0xffffu); }
DI float bf2f(bf16_t u) { return __uint_as_float((unsigned)u << 16); }
DI float bflo(unsigned u) { return __uint_as_float(u << 16); }
DI float bfhi(unsigned u) { return __uint_as_float(u & 0xffff0000u); }
DI float wave_sum(float v) {
#pragma unroll
    for (int o = 1; o < 64; o <<= 1) v += __shfl_xor(v, o);
    return v;
}
DI float fast_exp2(float x) { return __builtin_amdgcn_exp2f(x); }
DI float fast_rcp(float x) { return __builtin_amdgcn_rcpf(x); }
DI float sigmoidf_(float x) { return fast_rcp(1.f + fast_exp2(-x * LOG2E)); }
DI float gelu_tanh(float x) {
    const float u = 0.7978845608028654f * (x + 0.044715f * x * x * x);
    return x * sigmoidf_(2.f * u);
}
#define LDS_WAIT() asm volatile("s_waitcnt lgkmcnt(0)" ::: "memory")
#define MFMA32(a, b, c) __builtin_amdgcn_mfma_f32_32x32x16_bf16((a), (b), (c), 0, 0, 0)
#define MFMA16(a, b, c) __builtin_amdgcn_mfma_f32_16x16x32_bf16((a), (b), (c), 0, 0, 0)
DI int crow(int r, int hi) { return (r & 3) + 8 * (r >> 2) + 4 * hi; }

namespace pg8 {
constexpr int BM = 256, BK = 64, HALF = 128, HTB = HALF * BK * 2, STAGE_BYTES = 8 * HTB, NXCD = 8, WGM = 8;
__host__ __device__ __forceinline__ int lds_byte(int r, int c) { const int st = (r >> 4) * 2 + (c >> 5), rr = r & 15, cc = c & 31, ob = rr * 64 + cc * 2; return st * 1024 + (ob ^ (((ob >> 9) & 1) << 5)); }
__host__ __device__ __forceinline__ void stage_rc(int b, int& R, int& C) { const int st = b / 1024, sb = b % 1024, swz = sb ^ (((sb >> 9) & 1) << 5); R = (st >> 1) * 16 + swz / 64; C = (st & 1) * 32 + (swz % 64) / 2; }
__host__ __device__ __forceinline__ int perm32(int rho) { const int n = rho >> 4, i = rho & 15; return 8 * (i >> 2) + 4 * n + (i & 3); }
struct Unit { int pm, pn; };
template <bool I8> __device__ __forceinline__ f32x4 mma1(const bf16x8 b, const bf16x8 a, const f32x4 c) {
    if constexpr (I8) return __builtin_bit_cast(f32x4, __builtin_amdgcn_mfma_i32_16x16x64_i8(__builtin_bit_cast(i32x4, b), __builtin_bit_cast(i32x4, a), __builtin_bit_cast(i32x4, c), 0, 0, 0));
    else return __builtin_amdgcn_mfma_f32_16x16x32_bf16(b, a, c, 0, 0, 0); }
struct Gemm { const bf16_t* A; const bf16_t* Bt; int M, N, K; };
struct StaticOrder {
    int nM, nN, nwg, G, c;
    __host__ __device__ void init(int M_, int N_, int G_, int c_) { nM = M_ / BM; nN = N_ / BM; nwg = nM * nN; G = G_; c = c_; }
    __host__ __device__ bool next(int i, Unit& u) const {
        const long L = (long)i * G + c; if (L >= nwg) return false;
        int wgid = (int)L; { const int q = nwg / NXCD, r = nwg % NXCD, xcd = wgid % NXCD, off = wgid / NXCD; wgid = (xcd < r ? xcd * (q + 1) : r * (q + 1) + (xcd - r) * q) + off; }
        const int nig = WGM * nN, gid = wgid / nig, fm = gid * WGM, gsz = (nM - fm) < WGM ? (nM - fm) : WGM;
        u.pm = fm + ((wgid % nig) % gsz); u.pn = (wgid % nig) / gsz; return true;
    }
    __device__ __forceinline__ void a_ready(const Unit&) const {}
    __device__ __forceinline__ void done(const Unit&) const {}
};
struct EpiBf16 {
    static constexpr bool PERM = true, AFTER_DRAIN = false;
    bf16_t* O; int ldc;
    const float* lbp;
    const float* sa; const float* sw;
    __device__ __forceinline__ void operator()(const f32x4 (&acc)[2][2][4][2], const Unit& u, int wr, int wc, int fr, int fq) const {
        const int row0 = u.pm * BM + wr * 64 + fr; const int col0 = u.pn * BM + wc * 32 + 8 * fq;
        const bool fg = lbp && (unsigned)(u.pn - 4) < 4u;
        float sav[8]; f32x4 swv[2][2], lbv[2][2];
#pragma unroll
        for (int i = 0; i < 8; ++i) sav[i] = sa[row0 + (i >> 2) * HALF + (i & 3) * 16];
#pragma unroll
        for (int bj = 0; bj < 2; ++bj) { swv[bj][0] = *(const f32x4*)(sw + col0 + bj * HALF); swv[bj][1] = *(const f32x4*)(sw + col0 + bj * HALF + 4);
            lbv[bj][0] = fg ? *(const f32x4*)(lbp + col0 + bj * HALF - 1024) : (f32x4){0.f, 0.f, 0.f, 0.f}; lbv[bj][1] = fg ? *(const f32x4*)(lbp + col0 + bj * HALF - 1020) : (f32x4){0.f, 0.f, 0.f, 0.f}; }
#pragma unroll
        for (int ai = 0; ai < 2; ++ai)
#pragma unroll
            for (int m = 0; m < 4; ++m) { const int row = row0 + ai * HALF + m * 16; bf16_t* rowp = O + (size_t)row * ldc + col0; const float sc = sav[ai * 4 + m];
#pragma unroll
                for (int bj = 0; bj < 2; ++bj) {
                    f32x4 v0 = __builtin_convertvector(__builtin_bit_cast(i32x4, acc[ai][bj][m][0]), f32x4) * (swv[bj][0] * sc), v1 = __builtin_convertvector(__builtin_bit_cast(i32x4, acc[ai][bj][m][1]), f32x4) * (swv[bj][1] * sc);
                    if (fg) {
#pragma unroll
                        for (int i = 0; i < 4; ++i) { v0[i] = (1.f - lbv[bj][0][i]) * __builtin_amdgcn_rcpf(1.f + __builtin_amdgcn_exp2f(v0[i] * 1.4426950408889634f));
                                                      v1[i] = (1.f - lbv[bj][1][i]) * __builtin_amdgcn_rcpf(1.f + __builtin_amdgcn_exp2f(v1[i] * 1.4426950408889634f)); } }
                    u32x4 w; w.x = pk2(v0[0], v0[1]); w.y = pk2(v0[2], v0[3]); w.z = pk2(v1[0], v1[1]); w.w = pk2(v1[2], v1[3]);
                    *(u32x4*)(rowp + bj * HALF) = w; } }
    }
};
struct EpiH {
    static constexpr bool PERM = false, AFTER_DRAIN = false;
    const float* x; bf16_t* hb; const float* sa; const float* sw; LAS unsigned char* scr;
    __device__ __forceinline__ void operator()(const f32x4 (&acc)[2][2][4][2], const Unit& u, int wr, int wc, int fr, int fq) const {
        const int lane = fr + 16 * fq, wid = wr * 4 + wc;
        LAS unsigned char* t = scr + wid * 2048;
        const int rr = lane >> 3, c4 = lane & 7;
        const int colb = u.pn * BM + wc * 32 + 4 * c4;
        const f32x4 swv[2] = {*(const f32x4*)(sw + colb), *(const f32x4*)(sw + colb + HALF)};
        f32x4 xv[4][2][2]; float sv[4][2];
        auto rowof = [&](int g) { return u.pm * BM + (g >> 2) * HALF + wr * 64 + (g & 3) * 16 + rr; };
#pragma unroll
        for (int g = 0; g < 4; ++g) { const int row = rowof(g); sv[g][0] = sa[row]; sv[g][1] = sa[row + 8];
#pragma unroll
            for (int bj = 0; bj < 2; ++bj)
#pragma unroll
                for (int k = 0; k < 2; ++k) xv[g][bj][k] = *(const f32x4*)(x + (size_t)(row + 8 * k) * DM + colb + bj * HALF); }
#pragma unroll
        for (int g = 0; g < 8; ++g) { const int ai = g >> 2, m = g & 3, sl = g & 3; const int row = rowof(g);
            f32x4 xc[2][2]; const float sc[2] = {sv[sl][0], sv[sl][1]};
#pragma unroll
            for (int bj = 0; bj < 2; ++bj)
#pragma unroll
                for (int k = 0; k < 2; ++k) xc[bj][k] = xv[sl][bj][k];
            if (g + 4 < 8) { const int rn = rowof(g + 4); sv[sl][0] = sa[rn]; sv[sl][1] = sa[rn + 8];
#pragma unroll
                for (int bj = 0; bj < 2; ++bj)
#pragma unroll
                    for (int k = 0; k < 2; ++k) xv[sl][bj][k] = *(const f32x4*)(x + (size_t)(rn + 8 * k) * DM + colb + bj * HALF); }
#pragma unroll
            for (int bj = 0; bj < 2; ++bj) {
                *(LAS f32x4*)(t + fr * 128 + (4 * fq) * 4) = acc[ai][bj][m][0]; *(LAS f32x4*)(t + fr * 128 + (16 + 4 * fq) * 4) = acc[ai][bj][m][1];
                asm volatile("s_waitcnt lgkmcnt(0)" ::: "memory");
#pragma unroll
                for (int k = 0; k < 2; ++k) { const f32x4 v = __builtin_convertvector(*(const LAS i32x4*)(t + (rr + 8 * k) * 128 + c4 * 16), f32x4) * (swv[bj] * sc[k]) + xc[bj][k];
                    u32x2 w; w.x = pk2(v[0], v[1]); w.y = pk2(v[2], v[3]); *(u32x2*)(hb + (size_t)(row + 8 * k) * DM + colb + bj * HALF) = w; }
                asm volatile("s_waitcnt lgkmcnt(0)" ::: "memory");
            }
        }
    }
};

template <class Epi, class Sched, bool ALIGN_EPI = false, bool SP2 = false, bool I8 = false>
__device__ __forceinline__ void gemm_phase(LAS unsigned char* lds, const Gemm g, const Sched& S, const Epi& E) {
    int tid0 = threadIdx.x; asm volatile("" : "+v"(tid0));
    const int tid = tid0, wid = __builtin_amdgcn_readfirstlane(tid >> 6), lane = tid & 63, wr = wid >> 2, wc = wid & 3, fr = lane & 15, fq = lane >> 4;
    const int K = g.K, nt = K / BK;
    unsigned voffA[2], voffB[2];
#pragma unroll
    for (int i = 0; i < 2; ++i) { int R, C; stage_rc(tid * 16 + i * 8192, R, C); const int Rb = Epi::PERM ? ((R & ~31) + perm32(R & 31)) : R;
        voffA[i] = (unsigned)(R * K + C) * 2u; voffB[i] = (unsigned)(Rb * K + C) * 2u; }
    const size_t kstep = (size_t)(BK * 2);
    const size_t hstep = (size_t)HALF * K * 2;
    const size_t tstep = 2 * hstep;
    const unsigned ldsw = (unsigned)wid * 1024u;
    const int aoff = lds_byte(wr * 64 + fr, fq * 8), boff = lds_byte(wc * 32 + fr, fq * 8);
#define PG8_SA(b, h) (((b) * 2 + (h)) * HTB)
#define PG8_SB(b, h) ((4 + (b) * 2 + (h)) * HTB)
#define PG8_STAGE(bufoff, gbase, voff) do { _Pragma("unroll") for (int _i = 0; _i < 2; ++_i) \
        __builtin_amdgcn_global_load_lds((const unsigned*)((const char*)(gbase) + (voff)[_i]), (LAS unsigned*)(lds + (bufoff) + ldsw + _i * 8192), 16, 0, 0); } while (0)
#define PG8_LDA(dst, b, h) do { _Pragma("unroll") for (int m = 0; m < 4; ++m) _Pragma("unroll") for (int k = 0; k < 2; ++k) dst[m][k] = *(const LAS bf16x8*)(lds + PG8_SA(b, h) + aoff + m * 2048 + k * 1024); } while (0)
#define PG8_LDB(dst, b, h) do { _Pragma("unroll") for (int n = 0; n < 2; ++n) _Pragma("unroll") for (int k = 0; k < 2; ++k) dst[n][k] = *(const LAS bf16x8*)(lds + PG8_SB(b, h) + boff + n * 2048 + k * 1024); } while (0)
#define PG8_MMA(ai, bj, At, Bt) do { __builtin_amdgcn_s_setprio(1); _Pragma("unroll") for (int m = 0; m < 4; ++m) _Pragma("unroll") for (int n = 0; n < 2; ++n) _Pragma("unroll") for (int k = 0; k < 2; ++k) \
        acc[ai][bj][m][n] = mma1<I8>(Bt[n][k], At[m][k], acc[ai][bj][m][n]); __builtin_amdgcn_s_setprio(0); } while (0)
#define PG8_WAIT_V(n) asm volatile("s_waitcnt vmcnt(" #n ")" ::: "memory")
#define PG8_WAIT_L(n) asm volatile("s_waitcnt lgkmcnt(" #n ")" ::: "memory")
#define PG8_BAR __builtin_amdgcn_s_barrier()
#define PG8_SCHED __builtin_amdgcn_sched_barrier(0)
    Unit cur, nxt; int ui = 0;
    if (!S.next(0, cur)) return;
    f32x4 acc[2][2][4][2];
#pragma unroll
    for (int a = 0; a < 2; ++a)
#pragma unroll
        for (int b = 0; b < 2; ++b)
#pragma unroll
            for (int m = 0; m < 4; ++m)
#pragma unroll
                for (int n = 0; n < 2; ++n) acc[a][b][m][n] = (f32x4){0.f, 0.f, 0.f, 0.f};
    bf16x8 At[4][2], B0[2][2], B1[2][2];
    const char* cA = (const char*)g.A + (size_t)cur.pm * tstep; const char* cB = (const char*)g.Bt + (size_t)cur.pn * tstep;
    S.a_ready(cur);
    if constexpr (SP2) {
        PG8_STAGE(PG8_SB(0, 0), cB, voffB); PG8_STAGE(PG8_SB(0, 1), cB + hstep, voffB); PG8_STAGE(PG8_SA(0, 0), cA, voffA); PG8_STAGE(PG8_SA(0, 1), cA + hstep, voffA);
        if (wr == 1) PG8_BAR;
        PG8_WAIT_V(2); PG8_BAR;
        PG8_STAGE(PG8_SB(1, 0), cB + kstep, voffB); PG8_STAGE(PG8_SA(1, 0), cA + kstep, voffA); PG8_STAGE(PG8_SB(1, 1), cB + hstep + kstep, voffB);
        PG8_WAIT_V(6); PG8_BAR;
    } else {
        PG8_STAGE(PG8_SB(0, 0), cB, voffB); PG8_STAGE(PG8_SA(0, 0), cA, voffA); PG8_STAGE(PG8_SB(0, 1), cB + hstep, voffB); PG8_STAGE(PG8_SA(0, 1), cA + hstep, voffA);
        if (wr == 1) PG8_BAR;
        PG8_WAIT_V(4); PG8_BAR;
        PG8_STAGE(PG8_SB(1, 0), cB + kstep, voffB); PG8_STAGE(PG8_SA(1, 0), cA + kstep, voffA); PG8_STAGE(PG8_SB(1, 1), cB + hstep + kstep, voffB);
        PG8_WAIT_V(6); PG8_BAR;
    }
    for (;;) {
        const bool has_next = S.next(ui + 1, nxt);
        const char* nA = has_next ? (const char*)g.A + (size_t)nxt.pm * tstep : cA; const char* nB = has_next ? (const char*)g.Bt + (size_t)nxt.pn * tstep : cB;
        for (int t = 0; t < nt; t += 2) {
            const bool last = (t == nt - 2);
            const char* a1 = cA + (size_t)(t + 1) * kstep;
            const char* a2 = last ? nA : cA + (size_t)(t + 2) * kstep; const char* b2 = last ? nB : cB + (size_t)(t + 2) * kstep;
            const char* a3 = a2 + kstep; const char* b3 = b2 + kstep;
            if (last && has_next) S.a_ready(nxt);
            if constexpr (SP2) {
            PG8_LDB(B0, 0, 0); PG8_LDB(B1, 0, 1); PG8_SCHED; PG8_LDA(At, 0, 0); PG8_STAGE(PG8_SA(1, 1), a1 + hstep, voffA);
            PG8_WAIT_V(8); PG8_WAIT_L(0); PG8_BAR; PG8_MMA(0, 0, At, B0); PG8_MMA(0, 1, At, B1); PG8_BAR; PG8_SCHED;
            PG8_LDA(At, 0, 1); PG8_STAGE(PG8_SB(0, 0), b2, voffB); PG8_STAGE(PG8_SB(0, 1), b2 + hstep, voffB); PG8_STAGE(PG8_SA(0, 0), a2, voffA);
            PG8_WAIT_V(8); PG8_WAIT_L(0); PG8_BAR; PG8_MMA(1, 0, At, B0); PG8_MMA(1, 1, At, B1); PG8_BAR; PG8_SCHED;
            PG8_LDB(B0, 1, 0); PG8_LDB(B1, 1, 1); PG8_SCHED; PG8_LDA(At, 1, 0); PG8_STAGE(PG8_SA(0, 1), a2 + hstep, voffA);
            PG8_WAIT_V(8); PG8_WAIT_L(0); PG8_BAR; PG8_MMA(0, 0, At, B0); PG8_MMA(0, 1, At, B1); PG8_BAR; PG8_SCHED;
            PG8_LDA(At, 1, 1); PG8_STAGE(PG8_SB(1, 0), b3, voffB); PG8_STAGE(PG8_SB(1, 1), b3 + hstep, voffB); PG8_STAGE(PG8_SA(1, 0), a3, voffA);
            PG8_WAIT_V(8); PG8_WAIT_L(0); PG8_BAR; PG8_MMA(1, 0, At, B0); PG8_MMA(1, 1, At, B1); PG8_BAR; PG8_SCHED;
            } else {
            PG8_LDB(B0, 0, 0); PG8_SCHED; PG8_LDA(At, 0, 0); PG8_STAGE(PG8_SA(1, 1), a1 + hstep, voffA);
            PG8_WAIT_L(8); PG8_BAR; PG8_WAIT_L(0); PG8_MMA(0, 0, At, B0); PG8_BAR; PG8_SCHED;
            PG8_LDB(B1, 0, 1); PG8_STAGE(PG8_SB(0, 0), b2, voffB);
            PG8_BAR; PG8_WAIT_L(0); PG8_MMA(0, 1, At, B1); PG8_BAR;
            PG8_LDA(At, 0, 1); PG8_STAGE(PG8_SA(0, 0), a2, voffA);
            PG8_BAR; PG8_WAIT_L(0); PG8_MMA(1, 0, At, B0); PG8_BAR; PG8_SCHED;
            PG8_STAGE(PG8_SB(0, 1), b2 + hstep, voffB);
            PG8_WAIT_V(6); PG8_BAR; PG8_MMA(1, 1, At, B1); PG8_BAR;
            PG8_LDB(B0, 1, 0); PG8_SCHED; PG8_LDA(At, 1, 0); PG8_STAGE(PG8_SA(0, 1), a2 + hstep, voffA);
            PG8_WAIT_L(8); PG8_BAR; PG8_WAIT_L(0); PG8_MMA(0, 0, At, B0); PG8_BAR; PG8_SCHED;
            PG8_LDB(B1, 1, 1); PG8_STAGE(PG8_SB(1, 0), b3, voffB);
            PG8_BAR; PG8_WAIT_L(0); PG8_MMA(0, 1, At, B1); PG8_BAR;
            PG8_LDA(At, 1, 1); PG8_STAGE(PG8_SA(1, 0), a3, voffA);
            PG8_BAR; PG8_WAIT_L(0); PG8_MMA(1, 0, At, B0); PG8_BAR; PG8_SCHED;
            PG8_STAGE(PG8_SB(1, 1), b3 + hstep, voffB);
            PG8_WAIT_V(6); PG8_BAR; PG8_MMA(1, 1, At, B1); PG8_BAR;
            }
        }
        if constexpr (ALIGN_EPI) { if (wr == 0) PG8_BAR; }
        if constexpr (!Epi::AFTER_DRAIN) { E(acc, cur, wr, wc, fr, fq); S.done(cur); }
        if (!has_next) break;
#pragma unroll
        for (int a = 0; a < 2; ++a)
#pragma unroll
            for (int b = 0; b < 2; ++b)
#pragma unroll
                for (int m = 0; m < 4; ++m)
#pragma unroll
                    for (int n = 0; n < 2; ++n) acc[a][b][m][n] = (f32x4){0.f, 0.f, 0.f, 0.f};
        cur = nxt; cA = nA; cB = nB; ++ui;
        if constexpr (ALIGN_EPI) { if (wr == 1) PG8_BAR; }
    }
    PG8_WAIT_V(0);
    if constexpr (!ALIGN_EPI) { if (wr == 0) PG8_BAR; }
    PG8_BAR;
#undef PG8_SA
#undef PG8_SB
#undef PG8_STAGE
#undef PG8_LDA
#undef PG8_LDB
#undef PG8_MMA
#undef PG8_WAIT_V
#undef PG8_WAIT_L
#undef PG8_BAR
#undef PG8_SCHED
}
}

struct Args {
    const float* in[21];
    float* out; unsigned char* ws;
    int ph_lo, ph_hi;
};
enum { I_X = 0, I_N1W, I_WIN, I_LB, I_HGNW, I_QNW, I_KCNW, I_KSNW, I_KWNW, I_POSK, I_POSV, I_WCK1, I_WCK2, I_WCV1, I_WCV2, I_WOUT, I_N2W, I_WQ, I_SK, I_PU, I_PV };

constexpr float Q8_MAGIC = 12582912.f;
DI unsigned pack_q8(float t0, float t1, float t2, float t3) {
    const unsigned lo = __builtin_amdgcn_perm(__builtin_bit_cast(unsigned, t1), __builtin_bit_cast(unsigned, t0), 0x0c0c0400u);
    const unsigned hi = __builtin_amdgcn_perm(__builtin_bit_cast(unsigned, t3), __builtin_bit_cast(unsigned, t2), 0x04000c0cu);
    return lo | hi; }
DI void transpose_item(const float* W, int K, int N, int Npad, bf16_t* WT, LAS float* scr, int item, int lane, const float* kscale) {
    const int nblk = Npad / 32, kb = item / nblk, nb = item % nblk, k0 = 64 * kb, n0 = 32 * nb;
    const int n = n0 + 4 * (lane & 7);
    f32x4 v[8];
#pragma unroll
    for (int i = 0; i < 8; ++i) { const int kk = 8 * i + (lane >> 3); v[i] = (n < N) ? *(const f32x4*)(W + (size_t)(k0 + kk) * N + n) : (f32x4){0.f, 0.f, 0.f, 0.f}; }
#pragma unroll
    for (int i = 0; i < 8; ++i) { const int kk = 8 * i + (lane >> 3); f32x4 y = v[i]; if (kscale) y = y * kscale[k0 + kk];
        LAS float* d = scr + kk * 33 + 4 * (lane & 7); d[0] = y[0]; d[1] = y[1]; d[2] = y[2]; d[3] = y[3]; }
    LDS_WAIT(); asm volatile("" ::: "memory");
    const int c = lane & 7;
#pragma unroll
    for (int j = 0; j < 4; ++j) { const int nn = (lane >> 3) + 8 * j; const LAS float* s = scr + (8 * c) * 33 + nn;
        u32x4 o; o.x = pk2(s[0 * 33], s[1 * 33]); o.y = pk2(s[2 * 33], s[3 * 33]); o.z = pk2(s[4 * 33], s[5 * 33]); o.w = pk2(s[6 * 33], s[7 * 33]);
        *(u32x4*)(WT + (size_t)(n0 + nn) * K + k0 + 8 * c) = o; }
    LDS_WAIT(); asm volatile("" ::: "memory");
}

DI void coltile_q8_item(const float* W, int N, unsigned char* WT, float* wscale, LAS unsigned char* lds, int tile, int tid) {
    const int cq = tid & 3, rg = tid >> 2, n0 = 16 * tile + 4 * cq, wv = tid >> 6;
    f32x4 v[16];
#pragma unroll
    for (int i = 0; i < 16; ++i) v[i] = (n0 < N) ? *(const f32x4*)(W + (size_t)(16 * rg + i) * N + n0) : (f32x4){0.f, 0.f, 0.f, 0.f};
    f32x4 m = (f32x4){0.f, 0.f, 0.f, 0.f};
#pragma unroll
    for (int i = 0; i < 16; ++i) { m[0] = fmaxf(m[0], fabsf(v[i][0])); m[1] = fmaxf(m[1], fabsf(v[i][1])); m[2] = fmaxf(m[2], fabsf(v[i][2])); m[3] = fmaxf(m[3], fabsf(v[i][3])); }
#pragma unroll
    for (int o = 4; o < 64; o <<= 1) { m[0] = fmaxf(m[0], __shfl_xor(m[0], o)); m[1] = fmaxf(m[1], __shfl_xor(m[1], o)); m[2] = fmaxf(m[2], __shfl_xor(m[2], o)); m[3] = fmaxf(m[3], __shfl_xor(m[3], o)); }
    LAS f32x4* wm = (LAS f32x4*)(lds + 131072 + 1024);
    __syncthreads();
    if ((tid & 63) < 4) wm[wv * 4 + cq] = m;
    __syncthreads();
#pragma unroll
    for (int w = 0; w < 8; ++w) { const f32x4 t = wm[w * 4 + cq]; m[0] = fmaxf(m[0], t[0]); m[1] = fmaxf(m[1], t[1]); m[2] = fmaxf(m[2], t[2]); m[3] = fmaxf(m[3], t[3]); }
    if (rg == 0) *(f32x4*)(wscale + n0) = m * (1.f / 127.f);
#pragma unroll
    for (int c = 0; c < 4; ++c) { const float qs = m[c] > 0.f ? 127.f / m[c] : 0.f; u32x4 o;
#pragma unroll
        for (int q = 0; q < 4; ++q) o[q] = pack_q8(fmaf(v[4 * q][c], qs, Q8_MAGIC), fmaf(v[4 * q + 1][c], qs, Q8_MAGIC), fmaf(v[4 * q + 2][c], qs, Q8_MAGIC), fmaf(v[4 * q + 3][c], qs, Q8_MAGIC));
        *(u32x4*)(WT + (size_t)(n0 + c) * 2048 + 16 * rg) = o; }
}
DI void peer_conv_rows(const Args& a, int tsel, int rp0, int nrp, int lane) {
    const float* src = a.in[tsel ? I_PV : I_PU]; unsigned char* dst = a.ws + (tsel ? WS_VB : WS_UB); float* isc = (float*)(dst + TAB_SCALE_OFF);
    f32x4 v[2][8], nx[2][8];
#pragma unroll
    for (int rr = 0; rr < 2; ++rr)
#pragma unroll
        for (int q = 0; q < 8; ++q) nx[rr][q] = *(const f32x4*)(src + (size_t)(2 * rp0 + rr) * DM + 256 * q + 4 * lane);
#pragma unroll 1
    for (int k = 0; k < nrp; ++k) {
#pragma unroll
        for (int rr = 0; rr < 2; ++rr)
#pragma unroll
            for (int q = 0; q < 8; ++q) v[rr][q] = nx[rr][q];
        if (k + 1 < nrp) {
#pragma unroll
            for (int rr = 0; rr < 2; ++rr)
#pragma unroll
                for (int q = 0; q < 8; ++q) nx[rr][q] = *(const f32x4*)(src + (size_t)(2 * (rp0 + k + 1) + rr) * DM + 256 * q + 4 * lane);
        }
#pragma unroll
        for (int rr = 0; rr < 2; ++rr) { const int row = 2 * (rp0 + k) + rr; float mx = 0.f;
#pragma unroll
            for (int q = 0; q < 8; ++q) mx = fmaxf(mx, fmaxf(fmaxf(fabsf(v[rr][q][0]), fabsf(v[rr][q][1])), fmaxf(fabsf(v[rr][q][2]), fabsf(v[rr][q][3]))));
#pragma unroll
            for (int o = 1; o < 64; o <<= 1) mx = fmaxf(mx, __shfl_xor(mx, o));
            const float top = tsel ? 448.f : 127.f;
            const float sc = (mx > 0.f) ? top / mx : 1.f;
            if (lane == 0) isc[row] = (mx > 0.f) ? mx / top : 1.f;
#pragma unroll
            for (int q = 0; q < 8; ++q) { const f32x4 y = v[rr][q] * sc; int pk;
                if (tsel) { pk = __builtin_amdgcn_cvt_pk_fp8_f32(y[0], y[1], 0, false); pk = __builtin_amdgcn_cvt_pk_fp8_f32(y[2], y[3], pk, true); }
                else pk = (int)pack_q8(y[0] + Q8_MAGIC, y[1] + Q8_MAGIC, y[2] + Q8_MAGIC, y[3] + Q8_MAGIC);
                *(unsigned*)(dst + (size_t)(2 * q + (lane >> 5)) * (16384 * 128) + (size_t)row * 128 + 4 * (lane & 31)) = (unsigned)pk; } }
    }
}
DI void sk_conv_item(const Args& a, int it, int lane) {
    const float* sk = a.in[I_SK]; bf16_t* skb = (bf16_t*)(a.ws + SM_SK); const size_t e = (size_t)it * 512 + lane * 8;
    const f32x4 v0 = *(const f32x4*)(sk + e), v1 = *(const f32x4*)(sk + e + 4);
    u32x4 w; w.x = pk2(v0[0], v0[1]); w.y = pk2(v0[2], v0[3]); w.z = pk2(v1[0], v1[1]); w.w = pk2(v1[2], v1[3]);
    *(u32x4*)(skb + e) = w;
}
constexpr int FILL_RP = 4;
#ifndef FILL_SPLIT
#define FILL_SPLIT 128
#endif
constexpr int FILL_TAIL = 64;
constexpr int FILL_PU = 0, FILL_PV = 8192 / (8 * FILL_RP), FILL_WOUT = 2 * FILL_PV, FILL_WQ = FILL_WOUT + DM / 16, FILL_SK = FILL_WQ + DM / 16, FILL_END = FILL_SK + 64;
DI void filler_item(const Args& a, LAS unsigned char* lds, int fi, int lane, int wave) {
    LAS float* scr = (LAS float*)(lds + wave * 8704);
    if (fi < FILL_PV) peer_conv_rows(a, 0, (fi * 8 + wave) * FILL_RP, FILL_RP, lane);
    else if (fi < FILL_WOUT) peer_conv_rows(a, 1, ((fi - FILL_PV) * 8 + wave) * FILL_RP, FILL_RP, lane);
    else if (fi < FILL_WQ) coltile_q8_item(a.in[I_WOUT], DM, a.ws + WS_WOUT, (float*)(a.ws + SM_SWO), lds, fi - FILL_WOUT, wave * 64 + lane);
    else if (fi < FILL_SK) coltile_q8_item(a.in[I_WQ], DM, a.ws + WS_WQ, (float*)(a.ws + SM_SWQ), lds, fi - FILL_WQ, wave * 64 + lane);
    else sk_conv_item(a, (fi - FILL_SK) * 8 + wave, lane);
}
DI void phase_prep(const Args& a, LAS unsigned char* lds, int gw, int NGW, int lane, int wave) {
    unsigned char* ws = a.ws;
    LAS float* scr = (LAS float*)(lds + wave * 8704);
    constexpr int I_IN = (DM / 64) * (NP / 32), I_C1 = (2048 / 64) * (256 / 32), I_C2 = (256 / 64) * (64 / 32);
    constexpr int NITEMS = I_IN + 2 * I_C1 + 2 * I_C2;
    for (int it = gw + I_IN; it < NITEMS; it += NGW) {
        int r = it;
        if (r < I_IN) { continue; } r -= I_IN;
        if (r < I_C1) { transpose_item(a.in[I_WCK1], 2048, 256, 256, (bf16_t*)(ws + SM_W1K), scr, r, lane, nullptr); continue; } r -= I_C1;
        if (r < I_C1) { transpose_item(a.in[I_WCV1], 2048, 256, 256, (bf16_t*)(ws + SM_W1V), scr, r, lane, nullptr); continue; } r -= I_C1;
        if (r < I_C2) { transpose_item(a.in[I_WCK2], 256, 64, 64, (bf16_t*)(ws + SM_W2K), scr, r, lane, nullptr); continue; } r -= I_C2;
        transpose_item(a.in[I_WCV2], 256, 64, 64, (bf16_t*)(ws + SM_W2V), scr, r, lane, nullptr);
    }
    {
        const float* x = a.in[I_X]; const float* w1 = a.in[I_N1W]; unsigned char* XN = ws + WS_XN; float* sxa = (float*)(ws + WS_XN + 32 * MiB);
        f32x4 wv[8];
#pragma unroll
        for (int j = 0; j < 8; ++j) wv[j] = *(const f32x4*)(w1 + 4 * lane + 256 * j);
        for (int m2 = gw; m2 < M / 2; m2 += NGW) {
            f32x4 v[2][8];
#pragma unroll
            for (int rr = 0; rr < 2; ++rr)
#pragma unroll
                for (int j = 0; j < 8; ++j) v[rr][j] = ((const f32x4*)(x + (size_t)(2 * m2 + rr) * DM) + lane)[64 * j];
#pragma unroll
            for (int rr = 0; rr < 2; ++rr) { float s = 0.f;
#pragma unroll
                for (int j = 0; j < 8; ++j) s += (v[rr][j][0] * v[rr][j][0] + v[rr][j][1] * v[rr][j][1]) + (v[rr][j][2] * v[rr][j][2] + v[rr][j][3] * v[rr][j][3]);
                const float rstd = __builtin_amdgcn_rsqf(wave_sum(s) * (1.f / DM) + EPS);
                f32x4 y[8]; float am = 0.f;
#pragma unroll
                for (int j = 0; j < 8; ++j) { y[j] = v[rr][j] * rstd * wv[j]; am = fmaxf(am, fmaxf(fmaxf(fabsf(y[j][0]), fabsf(y[j][1])), fmaxf(fabsf(y[j][2]), fabsf(y[j][3])))); }
#pragma unroll
                for (int o = 1; o < 64; o <<= 1) am = fmaxf(am, __shfl_xor(am, o));
                const float qs = am > 0.f ? 127.f / am : 0.f;
                if (lane == 0) sxa[2 * m2 + rr] = am * (1.f / 127.f);
                unsigned* o4 = (unsigned*)(XN + (size_t)(2 * m2 + rr) * DM) + lane;
#pragma unroll
                for (int j = 0; j < 8; ++j) o4[64 * j] = pack_q8(fmaf(y[j][0], qs, Q8_MAGIC), fmaf(y[j][1], qs, Q8_MAGIC), fmaf(y[j][2], qs, Q8_MAGIC), fmaf(y[j][3], qs, Q8_MAGIC)); }
        }
    }
    {
        const int tid = threadIdx.x, blk = blockIdx.x;
        if (blk == 0) { for (int c = tid; c < 1024; c += NTHREADS) { const float l0 = a.in[I_LB][c], l1 = a.in[I_LB][1024 + c]; ((float*)(ws + SM_LB))[c] = 1.f / (1.f + __expf(l1 - l0)); } }
        if (blk >= 1 && blk <= 32) { const int part = blk - 1, mat = tid >> 8, j = tid & 255;
            const float* w1 = a.in[mat ? I_WCV1 : I_WCK1]; const float* pos = a.in[mat ? I_POSV : I_POSK]; float acc = 0.f;
            for (int i0 = part * 64; i0 < part * 64 + 64; i0 += 16) {
                float wv[16], pv[16];
#pragma unroll
                for (int u = 0; u < 16; ++u) { wv[u] = w1[(size_t)(i0 + u) * 256 + j]; pv[u] = pos[i0 + u]; }
#pragma unroll
                for (int u = 0; u < 16; ++u) acc += pv[u] * wv[u]; }
            ((float*)(ws + SM_BIASP))[part * 512 + tid] = acc; }
    }
}

DI void rowquant_mix(const Args& a, int gw, int NGW, int lane) {
    const bf16_t* MIX = (const bf16_t*)(a.ws + WS_XN); unsigned char* A8 = a.ws + WS_MIX8; float* rs = (float*)(a.ws + WS_MIX8 + 32 * MiB);
    for (int row = gw; row < M; row += NGW) {
        u32x4 v[4]; float am = 0.f;
#pragma unroll
        for (int j = 0; j < 4; ++j) v[j] = ((const u32x4*)(MIX + (size_t)row * DM) + lane)[64 * j];
#pragma unroll
        for (int j = 0; j < 4; ++j)
#pragma unroll
            for (int i = 0; i < 4; ++i) am = fmaxf(am, fmaxf(fabsf(bflo(v[j][i])), fabsf(bfhi(v[j][i]))));
#pragma unroll
        for (int o = 1; o < 64; o <<= 1) am = fmaxf(am, __shfl_xor(am, o));
        const float qs = am > 0.f ? 127.f / am : 0.f;
        if (lane == 0) rs[row] = am * (1.f / 127.f);
        u32x2* o2 = (u32x2*)(A8 + (size_t)row * DM) + lane;
#pragma unroll
        for (int j = 0; j < 4; ++j) { u32x2 w;
            w.x = pack_q8(fmaf(bflo(v[j][0]), qs, Q8_MAGIC), fmaf(bfhi(v[j][0]), qs, Q8_MAGIC), fmaf(bflo(v[j][1]), qs, Q8_MAGIC), fmaf(bfhi(v[j][1]), qs, Q8_MAGIC));
            w.y = pack_q8(fmaf(bflo(v[j][2]), qs, Q8_MAGIC), fmaf(bfhi(v[j][2]), qs, Q8_MAGIC), fmaf(bflo(v[j][3]), qs, Q8_MAGIC), fmaf(bfhi(v[j][3]), qs, Q8_MAGIC));
            o2[64 * j] = w; }
    }
}
DI void rowquant_h(const Args& a, int gw, int NGW, int lane) {
    const float* w2 = a.in[I_N2W]; unsigned char* A8 = a.ws + WS_HQ8; float* rs = (float*)(a.ws + WS_DQ);
    f32x4 wv[8];
#pragma unroll
    for (int j = 0; j < 8; ++j) wv[j] = *(const f32x4*)(w2 + 4 * lane + 256 * j);
    for (int row = gw; row < M; row += NGW) {
        f32x4 v[8]; u32x2 hv[8]; float s = 0.f, am = 0.f;
#pragma unroll
        for (int j = 0; j < 8; ++j) hv[j] = ((const u32x2*)((const bf16_t*)(a.ws + WS_HB) + (size_t)row * DM) + lane)[64 * j];
#pragma unroll
        for (int j = 0; j < 8; ++j) { v[j] = (f32x4){bflo(hv[j].x), bfhi(hv[j].x), bflo(hv[j].y), bfhi(hv[j].y)}; s += (v[j][0] * v[j][0] + v[j][1] * v[j][1]) + (v[j][2] * v[j][2] + v[j][3] * v[j][3]); v[j] = v[j] * wv[j];
            am = fmaxf(am, fmaxf(fmaxf(fabsf(v[j][0]), fabsf(v[j][1])), fmaxf(fabsf(v[j][2]), fabsf(v[j][3])))); }
        s = wave_sum(s);
#pragma unroll
        for (int o = 1; o < 64; o <<= 1) am = fmaxf(am, __shfl_xor(am, o));
        const float qs = am > 0.f ? 127.f / am : 0.f;
        if (lane == 0) rs[row] = am * (1.f / 127.f) * __builtin_amdgcn_rsqf(s * (1.f / DM) + EPS);
        unsigned* o4 = (unsigned*)(A8 + (size_t)row * DM) + lane;
#pragma unroll
        for (int j = 0; j < 8; ++j) o4[64 * j] = pack_q8(fmaf(v[j][0], qs, Q8_MAGIC), fmaf(v[j][1], qs, Q8_MAGIC), fmaf(v[j][2], qs, Q8_MAGIC), fmaf(v[j][3], qs, Q8_MAGIC));
    }
}
DI int perm16(int t) { return (t & ~12) | ((t & 4) << 1) | ((t & 8) >> 1); }

DI void nsa_norm_row(const Args& a, int row, int lane) {
    bf16_t* pr = (bf16_t*)(a.ws + WS_P) + (size_t)row * NP;
    const int c8 = lane & 7;
    const f32x4 qw0 = *(const f32x4*)(a.in[I_QNW] + 8 * c8), qw1 = *(const f32x4*)(a.in[I_QNW] + 8 * c8 + 4);
    const float* kwp = a.in[lane < 32 ? I_KSNW : I_KWNW];
    const f32x4 kw0 = *(const f32x4*)(kwp + 8 * c8), kw1 = *(const f32x4*)(kwp + 8 * c8 + 4);
    bf16_t* p0 = pr + C_NQ + 8 * lane; bf16_t* p1 = pr + C_NQ + 512 + 8 * lane; bf16_t* p2 = pr + (lane < 32 ? C_NKS + 8 * lane : C_NKW + 8 * (lane - 32));
    const u32x4 v0 = *(const u32x4*)p0, v1 = *(const u32x4*)p1, v2 = *(const u32x4*)p2;
    auto nrm = [&](const u32x4 v, const f32x4 w0, const f32x4 w1, float extra) -> u32x4 {
        float f[8] = {bflo(v.x), bfhi(v.x), bflo(v.y), bfhi(v.y), bflo(v.z), bfhi(v.z), bflo(v.w), bfhi(v.w)};
        float s = 0.f;
#pragma unroll
        for (int i = 0; i < 8; ++i) s += f[i] * f[i];
        s += __shfl_xor(s, 1); s += __shfl_xor(s, 2); s += __shfl_xor(s, 4);
        const float r = __builtin_amdgcn_rsqf(s * (1.f / 64.f) + EPS) * extra;
        u32x4 o; o.x = pk2(f[0] * r * w0[0], f[1] * r * w0[1]); o.y = pk2(f[2] * r * w0[2], f[3] * r * w0[3]);
        o.z = pk2(f[4] * r * w1[0], f[5] * r * w1[1]); o.w = pk2(f[6] * r * w1[2], f[7] * r * w1[3]); return o; };
    *(u32x4*)p0 = nrm(v0, qw0, qw1, 0.125f * LOG2E);
    *(u32x4*)p1 = nrm(v1, qw0, qw1, 0.125f * LOG2E);
    *(u32x4*)p2 = nrm(v2, kw0, kw1, 1.f);
}

DI void vtrans_item(const Args& a, LAS unsigned char* scr, int item, int lane) {
    const int which = item >> 10, b = (item >> 7) & 7, g = (item >> 5) & 3, tt = item & 31;
    const bf16_t* src = (const bf16_t*)(a.ws + WS_P) + (size_t)(b * SEQ + 64 * tt + lane) * NP + (which ? C_NVW : C_NVS) + g * 64;
    u32x4 v[8];
#pragma unroll
    for (int j = 0; j < 8; ++j) v[j] = *(const u32x4*)(src + 8 * j);
    const int tp = perm16(lane);
#pragma unroll
    for (int j = 0; j < 8; ++j) {
        const unsigned w[4] = {v[j].x, v[j].y, v[j].z, v[j].w};
#pragma unroll
        for (int i = 0; i < 4; ++i) {
            *(LAS bf16_t*)(scr + (8 * j + 2 * i) * 144 + 2 * tp) = (bf16_t)(w[i] & 0xffffu);
            *(LAS bf16_t*)(scr + (8 * j + 2 * i + 1) * 144 + 2 * tp) = (bf16_t)(w[i] >> 16);
        }
    }
    LDS_WAIT(); asm volatile("" ::: "memory");
    bf16_t* dst = (bf16_t*)(a.ws + WS_VT) + (size_t)which * (32 * 64 * SEQ) + (size_t)((b * 4 + g) * 64 + lane) * SEQ + 64 * tt;
#pragma unroll
    for (int j = 0; j < 8; ++j) *(u32x4*)(dst + 8 * j) = *(const LAS u32x4*)(scr + lane * 144 + 16 * j);
    LDS_WAIT(); asm volatile("" ::: "memory");
}

DI void compress_item(const Args& a, LAS unsigned char* lds, int item, int tid, int lane, int wave) {
    const int kv = item >> 7, b = (item >> 4) & 7, g = (item >> 2) & 3, n0 = 32 * (item & 3);
    const int hi = lane >> 5, r32 = lane & 31;
    const bf16_t* P = (const bf16_t*)(a.ws + WS_P);
    const bf16_t* w1T = (const bf16_t*)(a.ws + (kv ? SM_W1V : SM_W1K));
    const bf16_t* w2T = (const bf16_t*)(a.ws + (kv ? SM_W2V : SM_W2K));
    int nabs = n0 + r32; if (nabs > 126) nabs = 126;
    const bf16_t* ap = P + (size_t)(b * SEQ + 16 * nabs) * NP + (kv ? C_NVC : C_NKC) + g * 64 + 8 * hi;
    const bf16_t* bp = w1T + (size_t)(32 * wave + r32) * 2048 + 8 * hi;
    float bpv[32]; { const float* bpart = (const float*)(a.ws + SM_BIASP) + kv * 256 + 32 * wave + r32;
#pragma unroll
        for (int p = 0; p < 32; ++p) bpv[p] = bpart[p * 512]; }
    f32x16 acc;
#pragma unroll
    for (int i = 0; i < 16; ++i) acc[i] = 0.f;
    {
        LAS unsigned char* wl = lds + 20480 + wave * 9216;
        LAS unsigned char* sa = lds + 20480 + 8 * 9216;
        const int r8 = lane >> 3, c8 = lane & 7;
        const bf16_t* gb[4];
        int naA = n0 + 4 * wave + (r8 & 3); if (naA > 126) naA = 126;
        const bf16_t* gA = P + (size_t)(b * SEQ + 16 * naA) * NP + (kv ? C_NVC : C_NKC) + g * 64 + 8 * c8;
#pragma unroll
        for (int q = 0; q < 4; ++q) gb[q] = w1T + (size_t)(32 * wave + r8 + 8 * q) * 2048 + 8 * c8;
        u32x4 raA = (u32x4){0u, 0u, 0u, 0u}, rb[4];
        auto gload = [&](int l) {
            if (lane < 32) raA = *(const u32x4*)(gA + (size_t)l * NP);
#pragma unroll
            for (int q = 0; q < 4; ++q) rb[q] = *(const u32x4*)(gb[q] + l * 64); };
        auto lwrite = [&](int buf) {
            if (lane < 32) *(LAS u32x4*)(sa + buf * 4608 + (4 * wave + r8) * 144 + c8 * 16) = raA;
#pragma unroll
            for (int q = 0; q < 4; ++q) *(LAS u32x4*)(wl + 4608 + (r8 + 8 * q) * 144 + c8 * 16) = rb[q]; };
        gload(0); lwrite(0); gload(1);
#pragma unroll 1
        for (int l = 0; l < 32; ++l) {
            LDS_WAIT(); __builtin_amdgcn_s_barrier(); asm volatile("" ::: "memory");
            bf16x8 fa[4], fb[4];
#pragma unroll
            for (int kk = 0; kk < 4; ++kk) { fa[kk] = *(const LAS bf16x8*)(sa + (l & 1) * 4608 + r32 * 144 + 32 * kk + 16 * hi); fb[kk] = *(const LAS bf16x8*)(wl + 4608 + r32 * 144 + 32 * kk + 16 * hi); }
            LDS_WAIT();
#pragma unroll
            for (int kk = 0; kk < 4; ++kk) acc = MFMA32(fa[kk], fb[kk], acc);
            if (l + 1 < 32) { lwrite((l + 1) & 1); if (l + 2 < 32) gload(l + 2); }
        }
    }
    bf16x8 w2f[2][16];
    if (wave == 0) {
#pragma unroll
        for (int db = 0; db < 2; ++db)
#pragma unroll
            for (int ks = 0; ks < 16; ++ks) w2f[db][ks] = *(const bf16x8*)(w2T + (size_t)(32 * db + r32) * 256 + 16 * ks + 8 * hi);
    }
    float bias = 0.f;
#pragma unroll
    for (int p = 0; p < 32; ++p) bias += bpv[p];
#pragma unroll
    for (int r = 0; r < 16; ++r) { const int n = crow(r, hi); *(LAS bf16_t*)(lds + (n * 264 + 32 * wave + r32) * 2) = f2bf(gelu_tanh(acc[r] + bias)); }
    f32x4 kcw[2][4];
#pragma unroll
    for (int db = 0; db < 2; ++db)
#pragma unroll
        for (int c4 = 0; c4 < 4; ++c4) kcw[db][c4] = (wave == 0 && kv == 0) ? *(const f32x4*)(a.in[I_KCNW] + 32 * db + 8 * c4 + 4 * hi) : (f32x4){0.f, 0.f, 0.f, 0.f};
    __syncthreads();
    if (wave == 0) {
        f32x16 c[2];
#pragma unroll
        for (int db = 0; db < 2; ++db) {
#pragma unroll
            for (int i = 0; i < 16; ++i) c[db][i] = 0.f;
#pragma unroll
            for (int ks = 0; ks < 16; ++ks) {
                const bf16x8 bv = *(const LAS bf16x8*)(lds + (r32 * 264 + 16 * ks + 8 * hi) * 2);
                c[db] = MFMA32(w2f[db][ks], bv, c[db]);
            }
        }
        const int bg = b * 4 + g;
        if (kv == 0) {
            float ss = 0.f;
#pragma unroll
            for (int db = 0; db < 2; ++db)
#pragma unroll
                for (int r = 0; r < 16; ++r) ss += c[db][r] * c[db][r];
            ss += __shfl_xor(ss, 32);
            const float rstd = __builtin_amdgcn_rsqf(ss * (1.f / 64.f) + EPS);
            bf16_t* kc = (bf16_t*)(a.ws + SM_KC) + (size_t)(bg * 128 + n0 + r32) * 64;
#pragma unroll
            for (int db = 0; db < 2; ++db)
#pragma unroll
                for (int c4 = 0; c4 < 4; ++c4) { const int d0 = 32 * db + 8 * c4 + 4 * hi; const f32x4 w = kcw[db][c4];
                    u32x2 o; o.x = pk2(c[db][4 * c4] * rstd * w[0], c[db][4 * c4 + 1] * rstd * w[1]); o.y = pk2(c[db][4 * c4 + 2] * rstd * w[2], c[db][4 * c4 + 3] * rstd * w[3]);
                    *(u32x2*)(kc + d0) = o; }
        } else {
            bf16_t* vct = (bf16_t*)(a.ws + SM_VCT) + (size_t)bg * 64 * 128 + perm16(n0 + r32);
#pragma unroll
            for (int db = 0; db < 2; ++db)
#pragma unroll
                for (int r = 0; r < 16; ++r) vct[(size_t)(32 * db + crow(r, hi)) * 128] = f2bf(c[db][r]);
        }
    }
    __syncthreads();
}

template <int CTRL> DI float dpp_f(float v) { return __builtin_bit_cast(float, __builtin_amdgcn_update_dpp(0, __builtin_bit_cast(int, v), CTRL, 0xf, 0xf, true)); }
template <int CTRL> DI int dpp_i(int v) { return __builtin_amdgcn_update_dpp(0, v, CTRL, 0xf, 0xf, true); }
constexpr int HL_QD = 0, HL_KD = 17408, HL_KET = 34816, HL_IT = 53248, HL_AT = 71680, HL_DEC = 80896, HL_SEG = 81408, HL_SSQ = 85504, HL_G = 87552;
static_assert(HL_G + 2 * 64 * 272 <= LDS_BYTES - 64, "hgrn LDS");
struct HgRaw { unsigned f[8], q[8], i[8]; u32x4 g[2]; };
DI void hgrn_item(const Args& a, LAS unsigned char* lds, int item, int tid, int lane, int wave) {
    const int b = item >> 3, h = item & 7;
    const bf16_t* P = (const bf16_t*)(a.ws + WS_P);
    bf16_t* MIX = (bf16_t*)(a.ws + WS_XN);
    const int c2 = tid & 63, sg = tid >> 6, l15 = lane & 15, q4 = lane >> 4;
    const f32x2 lb2 = *(const f32x2*)((const float*)(a.ws + SM_LB) + h * 128 + 2 * c2);
    const float gnw = a.in[I_HGNW][16 * wave + l15];
    const __amdgpu_buffer_rsrc_t prs = __builtin_amdgcn_make_buffer_rsrc((void*)P, 0, (int)((size_t)M * NP * 2), 0x00020000);
    const int voffA = ((8 * sg) * NP + h * 128 + 2 * c2) * 2;
    const int grow = tid >> 3, gch = tid & 7;
    const int voffG = (grow * NP + C_HG + h * 128 + 16 * gch) * 2;
    auto load_raw = [&](HgRaw& R, int n) { const int soff0 = (b * SEQ + 64 * n) * NP * 2;
#pragma unroll
        for (int tt = 0; tt < 8; ++tt) { R.f[tt] = __builtin_amdgcn_raw_buffer_load_b32(prs, voffA, soff0 + tt * NP * 2 + C_HF * 2, 0);
            R.q[tt] = __builtin_amdgcn_raw_buffer_load_b32(prs, voffA, soff0 + tt * NP * 2 + C_HQ * 2, 0);
            R.i[tt] = __builtin_amdgcn_raw_buffer_load_b32(prs, voffA, soff0 + tt * NP * 2 + C_HI * 2, 0); }
        R.g[0] = __builtin_bit_cast(u32x4, __builtin_amdgcn_raw_buffer_load_b128(prs, voffG, soff0, 0)); R.g[1] = __builtin_bit_cast(u32x4, __builtin_amdgcn_raw_buffer_load_b128(prs, voffG + 16, soff0, 0)); };
    f32x4 S[8];
#pragma unroll
    for (int i = 0; i < 8; ++i) S[i] = (f32x4){0.f, 0.f, 0.f, 0.f};
    HgRaw R; load_raw(R, 0);
    for (int n = 0; n < 32; ++n) {
        const int rowbase = b * SEQ + 64 * n;
        float cum[2][8], kk[2][8], qq[2][8]; unsigned iv[8]; float run0 = 1.f, run1 = 1.f;
#pragma unroll
        for (int tt = 0; tt < 8; ++tt) {
            kk[0][tt] = bflo(R.f[tt]); kk[1][tt] = bfhi(R.f[tt]);
            run0 *= 1.f - kk[0][tt]; run1 *= 1.f - kk[1][tt]; cum[0][tt] = run0; cum[1][tt] = run1;
            qq[0][tt] = bflo(R.q[tt]); qq[1][tt] = bfhi(R.q[tt]); iv[tt] = R.i[tt];
        }
        *(LAS u32x4*)(lds + HL_G + (n & 1) * 17408 + grow * 272 + gch * 32) = R.g[0]; *(LAS u32x4*)(lds + HL_G + (n & 1) * 17408 + grow * 272 + gch * 32 + 16) = R.g[1];
        *(LAS f32x2*)(lds + HL_SEG + (sg * 128 + 2 * c2) * 4) = (f32x2){run0, run1};
        if (n + 1 < 32) load_raw(R, n + 1);
        __syncthreads();
        float off0 = 1.f, off1 = 1.f, bend0 = 1.f, bend1 = 1.f;
#pragma unroll
        for (int s2 = 0; s2 < 8; ++s2) { const f32x2 v = *(const LAS f32x2*)(lds + HL_SEG + (s2 * 128 + 2 * c2) * 4); bend0 *= v[0]; bend1 *= v[1]; if (s2 < sg) { off0 *= v[0]; off1 *= v[1]; } }
        unsigned ke0[4], ke1[4];
#pragma unroll
        for (int tt = 0; tt < 8; ++tt) {
            const float eb0 = off0 * cum[0][tt], eb1 = off1 * cum[1][tt]; const int t = 8 * sg + tt;
            const float kd0 = kk[0][tt] * fast_rcp(eb0), kd1 = kk[1][tt] * fast_rcp(eb1);
            *(LAS unsigned*)(lds + HL_QD + (t * 136 + 2 * c2) * 2) = pk2(qq[0][tt] * eb0, qq[1][tt] * eb1);
            *(LAS unsigned*)(lds + HL_KD + (t * 136 + 2 * c2) * 2) = pk2(kd0, kd1);
            const unsigned e0 = pk2(kd0 * bend0, 0.f) & 0xffffu, e1 = pk2(kd1 * bend1, 0.f) & 0xffffu;
            if (tt & 1) { ke0[tt >> 1] |= e0 << 16; ke1[tt >> 1] |= e1 << 16; } else { ke0[tt >> 1] = e0; ke1[tt >> 1] = e1; }
        }
        *(LAS u32x4*)(lds + HL_KET + ((2 * c2) * 72 + 8 * sg) * 2) = (u32x4){ke0[0], ke0[1], ke0[2], ke0[3]};
        *(LAS u32x4*)(lds + HL_KET + ((2 * c2 + 1) * 72 + 8 * sg) * 2) = (u32x4){ke1[0], ke1[1], ke1[2], ke1[3]};
        { u32x4 i0, i1;
#pragma unroll
          for (int k = 0; k < 4; ++k) { i0[k] = (iv[2 * k] & 0xffffu) | (iv[2 * k + 1] << 16); i1[k] = (iv[2 * k] >> 16) | (iv[2 * k + 1] & 0xffff0000u); }
          *(LAS u32x4*)(lds + HL_IT + ((2 * c2) * 72 + 8 * sg) * 2) = i0; *(LAS u32x4*)(lds + HL_IT + ((2 * c2 + 1) * 72 + 8 * sg) * 2) = i1; }
        if (sg == 0) *(LAS f32x2*)(lds + HL_DEC + 2 * c2 * 4) = (f32x2){bend0, bend1};
        __syncthreads();
#pragma unroll
        for (int u = 0; u < 2; ++u) {
            const int tile = 2 * wave + u, tb = tile >> 2, sb = tile & 3;
            f32x4 acc = (f32x4){0.f, 0.f, 0.f, 0.f};
            if (sb <= tb) {
                bf16x8 av[4], bv[4];
#pragma unroll
                for (int ks = 0; ks < 4; ++ks) { av[ks] = *(const LAS bf16x8*)(lds + HL_QD + ((16 * tb + l15) * 136 + 32 * ks + 8 * q4) * 2);
                    bv[ks] = *(const LAS bf16x8*)(lds + HL_KD + ((16 * sb + l15) * 136 + 32 * ks + 8 * q4) * 2); }
                __builtin_amdgcn_sched_barrier(0);
#pragma unroll
                for (int ks = 0; ks < 4; ++ks) acc = MFMA16(av[ks], bv[ks], acc);
            }
#pragma unroll
            for (int r = 0; r < 4; ++r) { const int t = 16 * tb + 4 * q4 + r, s2 = 16 * sb + l15;
                *(LAS bf16_t*)(lds + HL_AT + (t * 72 + s2) * 2) = f2bf(s2 <= t ? acc[r] : 0.f); }
        }
        __syncthreads();
        f32x4 o[4];
        bf16x8 sfrag[4];
#pragma unroll
        for (int ks = 0; ks < 4; ++ks) { u32x4 w; w.x = pk2(S[2 * ks][0], S[2 * ks][1]); w.y = pk2(S[2 * ks][2], S[2 * ks][3]); w.z = pk2(S[2 * ks + 1][0], S[2 * ks + 1][1]); w.w = pk2(S[2 * ks + 1][2], S[2 * ks + 1][3]);
            sfrag[ks] = __builtin_bit_cast(bf16x8, w); }
        bf16x8 itf[2];
#pragma unroll
        for (int ks = 0; ks < 2; ++ks) itf[ks] = *(const LAS bf16x8*)(lds + HL_IT + ((16 * wave + l15) * 72 + 32 * ks + 8 * q4) * 2);
#pragma unroll
        for (int tb = 0; tb < 4; ++tb) {
            o[tb] = (f32x4){0.f, 0.f, 0.f, 0.f};
            bf16x8 at[2]; u32x2 lo[4], hi2[4];
#pragma unroll
            for (int ks = 0; ks < 2; ++ks) at[ks] = *(const LAS bf16x8*)(lds + HL_AT + ((16 * tb + l15) * 72 + 32 * ks + 8 * q4) * 2);
#pragma unroll
            for (int ks = 0; ks < 4; ++ks) { lo[ks] = *(const LAS u32x2*)(lds + HL_QD + ((16 * tb + l15) * 136 + 32 * ks + 4 * q4) * 2);
                hi2[ks] = *(const LAS u32x2*)(lds + HL_QD + ((16 * tb + l15) * 136 + 32 * ks + 16 + 4 * q4) * 2); }
            __builtin_amdgcn_sched_barrier(0);
#pragma unroll
            for (int ks = 0; ks < 2; ++ks) o[tb] = MFMA16(at[ks], itf[ks], o[tb]);
#pragma unroll
            for (int ks = 0; ks < 4; ++ks) o[tb] = MFMA16(__builtin_bit_cast(bf16x8, (u32x4){lo[ks].x, lo[ks].y, hi2[ks].x, hi2[ks].y}), sfrag[ks], o[tb]);
            __builtin_amdgcn_sched_barrier(0);
        }
#pragma unroll
        for (int cb = 0; cb < 8; cb += 2) {
            f32x4 d4[2]; bf16x8 kf[2][2];
#pragma unroll
            for (int c2i = 0; c2i < 2; ++c2i) { d4[c2i] = *(const LAS f32x4*)(lds + HL_DEC + (16 * (cb + c2i) + 4 * q4) * 4);
#pragma unroll
                for (int ks = 0; ks < 2; ++ks) kf[c2i][ks] = *(const LAS bf16x8*)(lds + HL_KET + ((16 * (cb + c2i) + l15) * 72 + 32 * ks + 8 * q4) * 2); }
            __builtin_amdgcn_sched_barrier(0);
#pragma unroll
            for (int c2i = 0; c2i < 2; ++c2i) { S[cb + c2i] = S[cb + c2i] * d4[c2i];
#pragma unroll
                for (int ks = 0; ks < 2; ++ks) S[cb + c2i] = MFMA16(kf[c2i][ks], itf[ks], S[cb + c2i]); }
            __builtin_amdgcn_sched_barrier(0);
        }
#pragma unroll
        for (int tb = 0; tb < 4; ++tb)
#pragma unroll
            for (int r = 0; r < 4; ++r) { float v = o[tb][r] * o[tb][r];
                v += dpp_f<0xB1>(v); v += dpp_f<0x4E>(v); v += dpp_f<0x141>(v); v += dpp_f<0x140>(v);
                if (l15 == 0) *(LAS float*)(lds + HL_SSQ + (wave * 64 + 16 * tb + 4 * q4 + r) * 4) = v; }
        __syncthreads();
        float rs_mine; { const int tm = 16 * (l15 >> 2) + 4 * q4 + (l15 & 3); float tot = 0.f;
#pragma unroll
            for (int w = 0; w < 8; ++w) tot += *(const LAS float*)(lds + HL_SSQ + (w * 64 + tm) * 4);
            rs_mine = __builtin_amdgcn_rsqf(tot * (1.f / 128.f) + EPS); }
#pragma unroll
        for (int tb = 0; tb < 4; ++tb)
#pragma unroll
            for (int r = 0; r < 4; ++r) { const int t = 16 * tb + 4 * q4 + r;
                const float rstd = __shfl(rs_mine, (lane & 48) + 4 * tb + r);
                const float g = bf2f(*(const LAS bf16_t*)(lds + HL_G + (n & 1) * 17408 + t * 272 + (16 * wave + l15) * 2));
                MIX[(size_t)(rowbase + t) * DM + h * 128 + 16 * wave + l15] = f2bf(o[tb][r] * rstd * gnw * (g * sigmoidf_(g))); }
    }
}

constexpr int AL_K = 0, AL_V = 18432, AL_IMP = 36864, AL_SELM = 70656, AL_STASH = 71680;
static_assert(AL_STASH + 8 * 8192 <= LDS_BYTES - 64, "attention LDS");
constexpr float NEGBIG = -1e30f;
DI bf16x8 pack8(const f32x16& p, int s) {
    u32x4 w; w.x = pk2(p[8 * s], p[8 * s + 1]); w.y = pk2(p[8 * s + 2], p[8 * s + 3]); w.z = pk2(p[8 * s + 4], p[8 * s + 5]); w.w = pk2(p[8 * s + 6], p[8 * s + 7]);
    return __builtin_bit_cast(bf16x8, w);
}
DI void attn_scores(LAS unsigned char* lds, int buf, const bf16x8 (&qf)[4], f32x16& p0, f32x16& p1, int q32, int hi) {
    const LAS unsigned char* kb = lds + AL_K + buf * 9216 + q32 * 144 + hi * 16;
#pragma unroll
    for (int i = 0; i < 16; ++i) { p0[i] = 0.f; p1[i] = 0.f; }
#pragma unroll
    for (int kk = 0; kk < 4; ++kk) {
        const bf16x8 a0 = *(const LAS bf16x8*)(kb + kk * 32), a1 = *(const LAS bf16x8*)(kb + 32 * 144 + kk * 32);
        p0 = MFMA32(a0, qf[kk], p0); p1 = MFMA32(a1, qf[kk], p1);
    }
}
DI void attn_pv(LAS unsigned char* lds, int buf, const f32x16& p0, const f32x16& p1, f32x16 (&o)[2], int q32, int hi) {
    const LAS unsigned char* vb = lds + AL_V + buf * 9216 + q32 * 144 + hi * 16;
    bf16x8 vf[2][4];
#pragma unroll
    for (int db = 0; db < 2; ++db)
#pragma unroll
        for (int k = 0; k < 4; ++k) vf[db][k] = *(const LAS bf16x8*)(vb + db * 32 * 144 + 32 * k);
    const bf16x8 pb0 = pack8(p0, 0), pb1 = pack8(p0, 1), pb2 = pack8(p1, 0), pb3 = pack8(p1, 1);
    __builtin_amdgcn_sched_barrier(0);
#pragma unroll
    for (int db = 0; db < 2; ++db) {
        o[db] = MFMA32(vf[db][0], pb0, o[db]);
        o[db] = MFMA32(vf[db][1], pb1, o[db]);
        o[db] = MFMA32(vf[db][2], pb2, o[db]);
        o[db] = MFMA32(vf[db][3], pb3, o[db]);
    }
}
DI void attn_vload(LAS unsigned char* lds, int buf, bf16x8 (&vf)[2][4], int q32, int hi) {
    const LAS unsigned char* vb = lds + AL_V + buf * 9216 + q32 * 144 + hi * 16;
#pragma unroll
    for (int db = 0; db < 2; ++db)
#pragma unroll
        for (int k = 0; k < 4; ++k) vf[db][k] = *(const LAS bf16x8*)(vb + db * 32 * 144 + 32 * k);
}
DI void attn_pv_regs(const bf16x8 (&vf)[2][4], const f32x16& p0, const f32x16& p1, f32x16 (&o)[2]) {
    const bf16x8 pb0 = pack8(p0, 0), pb1 = pack8(p0, 1), pb2 = pack8(p1, 0), pb3 = pack8(p1, 1);
#pragma unroll
    for (int db = 0; db < 2; ++db) {
        o[db] = MFMA32(vf[db][0], pb0, o[db]);
        o[db] = MFMA32(vf[db][1], pb1, o[db]);
        o[db] = MFMA32(vf[db][2], pb2, o[db]);
        o[db] = MFMA32(vf[db][3], pb3, o[db]);
    }
}
DI void attn_scores_biased(LAS unsigned char* lds, int buf, const bf16x8 (&qf)[4], const f32x16& a0, const f32x16& a1, f32x16& p0, f32x16& p1, int q32, int hi) {
    const LAS unsigned char* kb = lds + AL_K + buf * 9216 + q32 * 144 + hi * 16;
    bf16x8 kf[2][4];
#pragma unroll
    for (int kk = 0; kk < 4; ++kk) { kf[0][kk] = *(const LAS bf16x8*)(kb + kk * 32); kf[1][kk] = *(const LAS bf16x8*)(kb + 32 * 144 + kk * 32); }
    __builtin_amdgcn_sched_barrier(0);
    p0 = MFMA32(kf[0][0], qf[0], a0); p1 = MFMA32(kf[1][0], qf[0], a1);
#pragma unroll
    for (int kk = 1; kk < 4; ++kk) { p0 = MFMA32(kf[0][kk], qf[kk], p0); p1 = MFMA32(kf[1][kk], qf[kk], p1); }
}
template <int MODE>
DI void attn_stream(LAS unsigned char* lds, const bf16_t* kbase, const bf16_t* vbase, unsigned tmask, unsigned fullmask, unsigned mymask, int cur, int tq, float slope2, float gate,
                    const bf16x8 (&qf)[4], const f32x16& a0, const f32x16& a1, f32x16 (&o)[2], int tid, int q32, int hi) {
    const int srow = tid >> 3, sch = tid & 7;
    float m = NEGBIG, lsum = 0.f;
#pragma unroll
    for (int i = 0; i < 16; ++i) { o[0][i] = 0.f; o[1][i] = 0.f; }
    auto next_tile = [&]() -> int { if (!tmask) return -1; const int t = 31 - __clz(tmask); tmask &= ~(1u << t); return t; };
    int j = next_tile();
    u32x4 kA = *(const u32x4*)(kbase + (size_t)(64 * j + srow) * NP + 8 * sch), vA = *(const u32x4*)(vbase + (size_t)srow * SEQ + 64 * j + 8 * sch);
    u32x4 kB = kA, vB = vA;
    int jn = next_tile();
    if (jn >= 0) { kB = *(const u32x4*)(kbase + (size_t)(64 * jn + srow) * NP + 8 * sch); vB = *(const u32x4*)(vbase + (size_t)srow * SEQ + 64 * jn + 8 * sch); }
    __syncthreads();
    *(LAS u32x4*)(lds + AL_K + srow * 144 + sch * 16) = kA; *(LAS u32x4*)(lds + AL_V + srow * 144 + sch * 16) = vA;
    __syncthreads();
    auto step = [&](u32x4& kL, u32x4& vL, const u32x4& kS, const u32x4& vS, const int bufc) -> bool {
        const int jnn = (jn >= 0) ? next_tile() : -1;
        if (jnn >= 0) { kL = *(const u32x4*)(kbase + (size_t)(64 * jnn + srow) * NP + 8 * sch); vL = *(const u32x4*)(vbase + (size_t)srow * SEQ + 64 * jnn + 8 * sch); }
        f32x16 p0, p1;
        attn_scores_biased(lds, bufc, qf, a0, a1, p0, p1, q32, hi);
        bf16x8 vf[2][4]; attn_vload(lds, bufc, vf, q32, hi);
        const float Bj = -slope2 * (float)(64 * (cur - j));
        if (!((fullmask >> j) & 1u)) {
            const bool selv = (MODE == 0) ? (((mymask >> j) & 1u) != 0u) : true;
            float basef = (float)(tq - 64 * j - 4 * hi); asm volatile("" : "+v"(basef));
#pragma unroll
            for (int r = 0; r < 16; ++r) {
                const float d0 = basef - (float)((r & 3) + 8 * (r >> 2)), d1 = d0 - 32.f;
                const bool v0 = (MODE == 0) ? (selv && d0 >= 0.f) : (d0 >= 0.f && d0 < 512.f);
                const bool v1 = (MODE == 0) ? (selv && d1 >= 0.f) : (d1 >= 0.f && d1 < 512.f);
                p0[r] = v0 ? p0[r] : NEGBIG; p1[r] = v1 ? p1[r] : NEGBIG;
            }
        }
        float mx = fmaxf(p0[0], p1[0]);
#pragma unroll
        for (int r = 1; r < 16; ++r) mx = fmaxf(mx, fmaxf(p0[r], p1[r]));
        mx = fmaxf(mx, __shfl_xor(mx, 32));
        const float mcand = mx + Bj;
        if (__any(mcand > m)) {
            const float mnew = fmaxf(m, mcand), alpha = fast_exp2(m - mnew); m = mnew; lsum *= alpha;
#pragma unroll
            for (int i = 0; i < 16; ++i) { o[0][i] *= alpha; o[1][i] *= alpha; }
        }
        const float madj = m - Bj;
        float ps = 0.f;
#pragma unroll
        for (int r = 0; r < 16; ++r) { p0[r] = fast_exp2(p0[r] - madj); p1[r] = fast_exp2(p1[r] - madj); ps += p0[r] + p1[r]; }
        lsum += ps;
        attn_pv_regs(vf, p0, p1, o);
        if (jn < 0) return false;
        *(LAS u32x4*)(lds + AL_K + (bufc ^ 1) * 9216 + srow * 144 + sch * 16) = kS; *(LAS u32x4*)(lds + AL_V + (bufc ^ 1) * 9216 + srow * 144 + sch * 16) = vS;
        __syncthreads();
        j = jn; jn = jnn;
        return true;
    };
    for (;;) { if (!step(kA, vA, kB, vB, 0)) break; if (!step(kB, vB, kA, vA, 1)) break; }
    const float ltot = lsum + __shfl_xor(lsum, 32);
    const float sc = (m > -1e29f) ? gate * fast_rcp(ltot) : 0.f;
#pragma unroll
    for (int i = 0; i < 16; ++i) { o[0][i] *= sc; o[1][i] *= sc; }
}

DI void attn_item(const Args& a, LAS unsigned char* lds, int item, int tid, int lane, int wave) {
    const int qt = 31 - (item >> 5), b = (item >> 2) & 7, g = item & 3, bg = b * 4 + g;
    const int cur = qt, t0 = 64 * qt, r = wave >> 1, head = 4 * g + r, q32 = lane & 31, hi = lane >> 5, tl = 32 * (wave & 1) + q32, tq = t0 + tl;
    const bf16_t* P = (const bf16_t*)(a.ws + WS_P);
    const float slope2 = exp2f(-0.5f * (float)(head + 1)) * LOG2E;
    const bf16_t* prow = P + (size_t)(b * SEQ + tq) * NP;
    bf16x8 qf[4];
#pragma unroll
    for (int kk = 0; kk < 4; ++kk) qf[kk] = *(const bf16x8*)(prow + C_NQ + head * 64 + 16 * kk + 8 * hi);
    const float g0 = sigmoidf_(bf2f(prow[C_GATE + head * 3])), g1 = sigmoidf_(bf2f(prow[C_GATE + head * 3 + 1])), g2 = sigmoidf_(bf2f(prow[C_GATE + head * 3 + 2]));
    LAS float* stash = (LAS float*)(lds + AL_STASH + wave * 8192) + lane;
    const int srow = tid >> 3, sch = tid & 7;
    {
        const int ntile = (qt >= 16) ? 2 : 1;
        const bf16_t* kc = (const bf16_t*)(a.ws + SM_KC) + (size_t)bg * 128 * 64;
        const bf16_t* vct = (const bf16_t*)(a.ws + SM_VCT) + (size_t)bg * 64 * 128;
        {
            const u32x4 k0 = *(const u32x4*)(kc + (size_t)srow * 64 + 8 * sch), v0 = *(const u32x4*)(vct + (size_t)srow * 128 + 8 * sch);
            u32x4 k1 = k0, v1 = v0;
            if (ntile == 2) { k1 = *(const u32x4*)(kc + (size_t)(64 + srow) * 64 + 8 * sch); v1 = *(const u32x4*)(vct + (size_t)srow * 128 + 64 + 8 * sch); }
            *(LAS u32x4*)(lds + AL_K + srow * 144 + sch * 16) = k0; *(LAS u32x4*)(lds + AL_V + srow * 144 + sch * 16) = v0;
            *(LAS u32x4*)(lds + AL_K + 9216 + srow * 144 + sch * 16) = k1; *(LAS u32x4*)(lds + AL_V + 9216 + srow * 144 + sch * 16) = v1;
        }
        __syncthreads();
        f32x16 p[4];
        attn_scores(lds, 0, qf, p[0], p[1], q32, hi);
        attn_scores(lds, 1, qf, p[2], p[3], q32, hi);
        float mx = NEGBIG;
#pragma unroll
        for (int kb = 0; kb < 4; ++kb)
#pragma unroll
            for (int rr = 0; rr < 16; ++rr) { const int n = 32 * kb + crow(rr, hi); const int d = tq - (16 * n + 31);
                const bool v = (d >= 0) && (kb < 2 * ntile);
                p[kb][rr] = v ? p[kb][rr] - slope2 * (float)d : NEGBIG; mx = fmaxf(mx, p[kb][rr]); }
        mx = fmaxf(mx, __shfl_xor(mx, 32));
        float ps = 0.f;
#pragma unroll
        for (int kb = 0; kb < 4; ++kb)
#pragma unroll
            for (int rr = 0; rr < 16; ++rr) { p[kb][rr] = fast_exp2(p[kb][rr] - mx); ps += p[kb][rr]; }
        ps += __shfl_xor(ps, 32);
        const float inv = (mx > -1e29f) ? fast_rcp(ps) : 0.f;
#pragma unroll
        for (int kb = 0; kb < 4; ++kb)
#pragma unroll
            for (int rr = 0; rr < 16; ++rr) p[kb][rr] *= inv;
        float rc_prev = 0.f;
#pragma unroll
        for (int k = 0; k < 16; ++k) { const int kb = k >> 2, c4 = k & 3; const float bc = p[kb][4 * c4 + 3]; const float av = (p[kb][4 * c4] + p[kb][4 * c4 + 1]) + (p[kb][4 * c4 + 2] + bc);
            const float rc = __shfl_xor(bc, 32); const float v = av + (hi ? rc : rc_prev); rc_prev = rc;
            *(LAS float*)(lds + AL_IMP + ((r * 64 + tl) * 33 + 2 * k + hi) * 4) = v; }
        f32x16 o[2];
#pragma unroll
        for (int i = 0; i < 16; ++i) { o[0][i] = 0.f; o[1][i] = 0.f; }
        attn_pv(lds, 0, p[0], p[1], o, q32, hi);
        if (ntile == 2) attn_pv(lds, 1, p[2], p[3], o, q32, hi);
#pragma unroll
        for (int i = 0; i < 16; ++i) { stash[i * 64] = g0 * o[0][i]; stash[(16 + i) * 64] = g0 * o[1][i]; }
    }
    __syncthreads();
    {
        const int tok = tid >> 3, jg = tid & 7;
        float v[32];
#pragma unroll
        for (int j = 0; j < 32; ++j) { float s = 0.f;
#pragma unroll
            for (int rr = 0; rr < 4; ++rr) s += *(const LAS float*)(lds + AL_IMP + ((rr * 64 + tok) * 33 + j) * 4);
            const bool forced = (j == 0) || (j == cur) || (j == cur - 1);
            v[j] = forced ? 1e9f : ((j > cur) ? -1e9f : s); }
        unsigned bits = 0u;
#pragma unroll
        for (int i = 0; i < 4; ++i) {
            float mine = 0.f;
#pragma unroll
            for (int j = 0; j < 32; ++j) if ((j >> 2) == jg && (j & 3) == i) mine = v[j];
            const int jme = 4 * jg + i; int rank = 0;
#pragma unroll
            for (int j = 0; j < 32; ++j) rank += (v[j] > mine || (v[j] == mine && j < jme)) ? 1 : 0;
            if (rank < 16) bits |= 1u << jme;
        }
        bits |= __shfl_xor(bits, 1); bits |= __shfl_xor(bits, 2); bits |= __shfl_xor(bits, 4);
        if (jg == 0) *(LAS unsigned*)(lds + AL_SELM + tok * 4) = bits;
    }
    __syncthreads();
    unsigned umask = *(const LAS unsigned*)(lds + AL_SELM + lane * 4);
#pragma unroll
    for (int o2 = 1; o2 < 64; o2 <<= 1) umask |= __shfl_xor(umask, o2);
    const unsigned mymask = *(const LAS unsigned*)(lds + AL_SELM + tl * 4);
    const unsigned causal = (cur == 31) ? 0xffffffffu : ((1u << (cur + 1)) - 1u);
    umask = __builtin_amdgcn_readfirstlane(umask & causal);
    f32x16 ob[2];
    f32x16 ab0, ab1;
#pragma unroll
    for (int rr = 0; rr < 16; ++rr) { ab0[rr] = slope2 * (float)(crow(rr, hi) - tl); ab1[rr] = slope2 * (float)(crow(rr, hi) + 32 - tl); }
    unsigned amask = *(const LAS unsigned*)(lds + AL_SELM + lane * 4);
#pragma unroll
    for (int o2 = 1; o2 < 64; o2 <<= 1) amask &= __shfl_xor(amask, o2);
    const unsigned below = (1u << cur) - 1u;
    const unsigned sfull = __builtin_amdgcn_readfirstlane(amask) & below;
    attn_stream<0>(lds, P + (size_t)(b * SEQ) * NP + C_NKS + g * 64, (const bf16_t*)(a.ws + WS_VT) + (size_t)bg * 64 * SEQ, umask, sfull, mymask, cur, tq, slope2, g1, qf, ab0, ab1, ob, tid, q32, hi);
#pragma unroll
    for (int i = 0; i < 16; ++i) { stash[i * 64] += ob[0][i]; stash[(16 + i) * 64] += ob[1][i]; }
    const int wlo = cur >= 8 ? cur - 8 : 0;
    const unsigned wmask = causal & ~((1u << wlo) - 1u);
    const unsigned wfull = below & ~((1u << (cur >= 7 ? cur - 7 : 0)) - 1u);
    attn_stream<1>(lds, P + (size_t)(b * SEQ) * NP + C_NKW + g * 64, (const bf16_t*)(a.ws + WS_VT) + (size_t)(32 * 64 * SEQ) + (size_t)bg * 64 * SEQ, wmask, wfull, 0u, cur, tq, slope2, g2, qf, ab0, ab1, ob, tid, q32, hi);
#pragma unroll
    for (int i = 0; i < 16; ++i) { ob[0][i] += stash[i * 64]; ob[1][i] += stash[(16 + i) * 64]; }
    bf16_t* mo = (bf16_t*)(a.ws + WS_XN) + (size_t)(b * SEQ + tq) * DM + 1024 + head * 64;
#pragma unroll
    for (int db = 0; db < 2; ++db)
#pragma unroll
        for (int c4 = 0; c4 < 4; ++c4) { u32x2 w; w.x = pk2(ob[db][4 * c4], ob[db][4 * c4 + 1]); w.y = pk2(ob[db][4 * c4 + 2], ob[db][4 * c4 + 3]);
            *(u32x2*)(mo + 32 * db + 8 * c4 + 4 * hi) = w; }
}

DI unsigned f2sort(float f) { const unsigned u = __float_as_uint(f); return u ^ ((u >> 31) ? 0xffffffffu : 0x80000000u); }
DI float sort2f(unsigned u) { return __uint_as_float(u ^ ((u >> 31) ? 0x80000000u : 0xffffffffu)); }
DI void ce_desc(unsigned& x, unsigned& y) { const unsigned hi = max(x, y), lo = min(x, y); x = hi; y = lo; }
template <int NA> DI void sort16_desc(unsigned (&a)[NA], const int off) {
#define SN_CE(i, j) ce_desc(a[off + i], a[off + j]);
    SN_CE(0, 13) SN_CE(1, 12) SN_CE(2, 15) SN_CE(3, 14) SN_CE(4, 8) SN_CE(5, 6) SN_CE(7, 11) SN_CE(9, 10)
    SN_CE(0, 5) SN_CE(1, 7) SN_CE(2, 9) SN_CE(3, 4) SN_CE(6, 13) SN_CE(8, 14) SN_CE(10, 15) SN_CE(11, 12)
    SN_CE(0, 1) SN_CE(2, 3) SN_CE(4, 5) SN_CE(6, 8) SN_CE(7, 9) SN_CE(10, 11) SN_CE(12, 13) SN_CE(14, 15)
    SN_CE(0, 2) SN_CE(1, 3) SN_CE(4, 10) SN_CE(5, 11) SN_CE(6, 7) SN_CE(8, 9) SN_CE(12, 14) SN_CE(13, 15)
    SN_CE(1, 2) SN_CE(3, 12) SN_CE(4, 6) SN_CE(5, 7) SN_CE(8, 10) SN_CE(9, 11) SN_CE(13, 14)
    SN_CE(1, 4) SN_CE(2, 6) SN_CE(5, 8) SN_CE(7, 10) SN_CE(9, 13) SN_CE(11, 14)
    SN_CE(2, 4) SN_CE(3, 6) SN_CE(9, 12) SN_CE(11, 13)
    SN_CE(3, 5) SN_CE(6, 8) SN_CE(7, 9) SN_CE(10, 12)
    SN_CE(3, 4) SN_CE(5, 6) SN_CE(7, 8) SN_CE(9, 10) SN_CE(11, 12)
    SN_CE(6, 7) SN_CE(8, 9)
#undef SN_CE
}
template <int NA> DI void merge_top16(unsigned (&a)[NA], const int oa, const int ob) {
#pragma unroll
    for (int i = 0; i < 16; ++i) a[oa + i] = max(a[oa + i], a[ob + 15 - i]);
#pragma unroll
    for (int js = 0; js < 4; ++js) { const int j = 8 >> js;
#pragma unroll
        for (int i = 0; i < 16; ++i) { const int l = i ^ j; if (l > i) ce_desc(a[oa + i], a[oa + l]); } }
}
DI void top16_of_64(unsigned (&a)[64]) { sort16_desc(a, 0); sort16_desc(a, 16); sort16_desc(a, 32); sort16_desc(a, 48); merge_top16(a, 0, 16); merge_top16(a, 32, 48); merge_top16(a, 0, 32); }
DI void topk_item(const Args& a, LAS unsigned char* wl, int item, int lane, LAS unsigned* lcnt) {
    const int tt = item >> 3, h = item & 7, q32 = lane & 31, hi = lane >> 5, tok = 32 * tt + q32;
    const __amdgpu_buffer_rsrc_t SKb = __builtin_amdgcn_make_buffer_rsrc((void*)(a.ws + SM_SK), 0, 524288, 0x00020000);
    const __amdgpu_buffer_rsrc_t Qb = __builtin_amdgcn_make_buffer_rsrc((void*)(a.ws + WS_QP), 0, 64 << 20, 0x00020000);
    LAS unsigned* tab = (LAS unsigned*)wl;
    unsigned top[2][16];
#pragma unroll
    for (int p = 0; p < 2; ++p) {
        f32x16 acc[4];
#pragma unroll
        for (int kb = 0; kb < 4; ++kb)
#pragma unroll
            for (int i = 0; i < 16; ++i) acc[kb][i] = 0.f;
        const int kvo = (q32 * 128 + 8 * hi) * 2, qvo = (q32 * DM + 8 * hi) * 2;
        bf16x8 qv[8], kf0[8], kf1[8];
#pragma unroll
        for (int ks = 0; ks < 8; ++ks) qv[ks] = __builtin_bit_cast(bf16x8, __builtin_amdgcn_raw_buffer_load_b128(Qb, qvo, ((32 * tt) * DM + h * 256 + p * 128 + 16 * ks) * 2, 0));
        auto kload = [&](bf16x8 (&kf)[8], int bt) {
#pragma unroll
            for (int i = 0; i < 8; ++i) { const int ks = 2 * bt + (i >> 2), kb = i & 3;
                kf[i] = __builtin_bit_cast(bf16x8, __builtin_amdgcn_raw_buffer_load_b128(SKb, kvo, (((h * 2 + p) * 128 + 32 * kb) * 128 + 16 * ks) * 2, 0)); }
            __builtin_amdgcn_sched_barrier(0); };
        auto kmma = [&](const bf16x8 (&kf)[8], int bt) {
#pragma unroll
            for (int i = 0; i < 8; ++i) { const int ks = 2 * bt + (i >> 2), kb = i & 3; acc[kb] = MFMA32(kf[i], qv[ks], acc[kb]); }
            __builtin_amdgcn_sched_barrier(0); };
        kload(kf0, 0); kload(kf1, 1); kmma(kf0, 0); kload(kf0, 2); kmma(kf1, 1); kload(kf1, 3); kmma(kf0, 2); kmma(kf1, 3);
        int h4 = 4 * hi; asm volatile("" : "+v"(h4));
        unsigned key[64];
#pragma unroll
        for (int kb = 0; kb < 4; ++kb)
#pragma unroll
            for (int r = 0; r < 16; ++r) key[kb * 16 + r] = (f2sort(acc[kb][r]) & ~127u) | (unsigned)(127 - (32 * kb + (r & 3) + 8 * (r >> 2)) - h4);
        top16_of_64(key);
#pragma unroll
        for (int i = 0; i < 16; ++i) key[16 + i] = (unsigned)__shfl_xor((int)key[i], 32);
        merge_top16(key, 0, 16);
#pragma unroll
        for (int i = 0; i < 16; ++i) { top[p][i] = key[i]; tab[(p * 16 + i) * 64 + lane] = key[i]; }
    }
    unsigned cand[64]; { int n = 0;
#pragma unroll
        for (int i = 0; i < 16; ++i)
#pragma unroll
            for (int j = 0; j < 16; ++j) if ((i + 1) * (j + 1) <= 16) { cand[n] = (f2sort(sort2f(top[0][i] & ~127u) + sort2f(top[1][j] & ~127u)) & ~255u) | (unsigned)(255 - (16 * i + j)); ++n; }
#pragma unroll
        for (int i = 50; i < 64; ++i) cand[i] = 0u; }
    top16_of_64(cand);
    const float vmax = sort2f(cand[0] & ~255u);
    float e[16], esum = 0.f; unsigned ex[16];
#pragma unroll
    for (int rd = 0; rd < 16; ++rd) {
        const unsigned m = cand[rd]; const int cidx = 255 - (int)(m & 255u), ci = cidx >> 4, cj = cidx & 15;
        e[rd] = __expf(sort2f(m & ~255u) - vmax); esum += e[rd];
        const unsigned i0 = 127u - (tab[ci * 64 + lane] & 127u), i1 = 127u - (tab[(16 + cj) * 64 + lane] & 127u);
        ex[rd] = i0 * 128u + i1;
    }
    if (hi == 0) {
        LAS unsigned* cnt = lcnt + (q32 >> 4) * 16; unsigned* lt = (unsigned*)(a.ws + WS_LIST) + (size_t)(2 * tt + (q32 >> 4)) * 2048; unsigned* lm = (unsigned*)(a.ws + WS_LISTM) + (size_t)(2 * tt + (q32 >> 4)) * 4096;
        unsigned* pidx = (unsigned*)(a.ws + WS_PIDX) + (size_t)tok * 128 + h * 16; unsigned pos[16];
#pragma unroll
        for (int rd = 0; rd < 16; ++rd) { const unsigned g = ex[rd] >> 10, el = ex[rd] & 1023u;
            pos[rd] = __hip_atomic_fetch_add(cnt + g, 1u, __ATOMIC_RELAXED, __HIP_MEMORY_SCOPE_WORKGROUP);
            const unsigned ent = (el << 7) | (((el >> 1) & 7u) << 4) | ((unsigned)(q32 & 3) << 17) | ((unsigned)((q32 >> 2) & 3) << 24), p = pos[rd];
            if (p < 256u) lm[g * 256u + (p >> 6) * 64u + (p & 15u) * 4u + ((p >> 4) & 3u)] = ent;
            if (p >= 192u) lt[(size_t)g * (1024 * 2048) + (p & 15u) * 128u + (p >> 4)] = ent; }
#pragma unroll
        for (int k4 = 0; k4 < 4; ++k4) *(u32x4*)(pidx + 4 * k4) = (u32x4){pos[4 * k4], pos[4 * k4 + 1], pos[4 * k4 + 2], pos[4 * k4 + 3]};
        const float inv = 1.f / esum;
        unsigned* ei = (unsigned*)(a.ws + WS_EI) + (size_t)tok * 128 + h * 16; float* eg = (float*)(a.ws + WS_EG) + (size_t)tok * 128 + h * 16;
#pragma unroll
        for (int k4 = 0; k4 < 4; ++k4) {
            *(u32x4*)(ei + 4 * k4) = (u32x4){ex[4 * k4], ex[4 * k4 + 1], ex[4 * k4 + 2], ex[4 * k4 + 3]};
            *(f32x4*)(eg + 4 * k4) = (f32x4){e[4 * k4] * inv, e[4 * k4 + 1] * inv, e[4 * k4 + 2] * inv, e[4 * k4 + 3] * inv};
        }
    }
}

#define XB_TMO      128
#define XB_XCNT(j)  (256  + 64 * (j))
#define XB_XSUB(j)  (1280 + 64 * (j))
#define XB_XGEN(j)  (2304 + 64 * (j))
#define XB_TOP      3328
#define XB_TOPGEN   3392
#define XCD_BAR_WORDS 3456
#define XB_SPIN_CAP (1u << 22)
DI unsigned xb_ld(unsigned* p)              { return __hip_atomic_load(p, __ATOMIC_RELAXED, __HIP_MEMORY_SCOPE_AGENT); }
DI unsigned xb_add(unsigned* p, unsigned v) { return __hip_atomic_fetch_add(p, v, __ATOMIC_RELAXED, __HIP_MEMORY_SCOPE_AGENT); }
DI unsigned xb_xcc_id() { return (unsigned)__builtin_amdgcn_s_getreg((3 << 11) | 20) & 0xFu; }
#define XB_SPIN(cond, bar) do { unsigned _sp = 0; while (cond) { __builtin_amdgcn_s_sleep(1); \
    if ((++_sp & 255u) == 0u) { if (xb_ld(&(bar)[XB_TMO])) break; if (_sp > XB_SPIN_CAP) { atomicAdd(&(bar)[XB_TMO], 1u); break; } } } } while (0)
struct XcdBarrier { unsigned* bar; unsigned x; volatile LAS unsigned* st; };
DI XcdBarrier xcd_barrier_post(unsigned* bar, volatile LAS unsigned* st) {
    XcdBarrier b; b.bar = bar; b.x = xb_xcc_id(); b.st = st;
    if (threadIdx.x == 0) (void)xb_add(&bar[XB_XCNT(b.x)], 1u);
    return b;
}
DI void xcd_barrier_complete(unsigned* bar, unsigned x, unsigned& nloc, unsigned& nx) {
    const unsigned G = gridDim.x * gridDim.y * gridDim.z;
    unsigned sum, cnt, mine, sp = 0u;
    for (;;) {
        sum = 0u; cnt = 0u; mine = 0u;
#pragma unroll
        for (unsigned j = 0; j < 16; ++j) { const unsigned c = xb_ld(&bar[XB_XCNT(j)]); sum += c; cnt += (c > 0u) ? 1u : 0u; mine = (j == x) ? c : mine; }
        if (sum == G) break;
        __builtin_amdgcn_s_sleep(1);
        if ((++sp & 255u) == 0u) { if (xb_ld(&bar[XB_TMO])) break; if (sp > XB_SPIN_CAP) { atomicAdd(&bar[XB_TMO], 1u); break; } }
    }
    nloc = mine > 0u ? mine : 1u; nx = cnt > 0u ? cnt : 1u;
}
DI void xcd_barrier(const XcdBarrier& b) {
    asm volatile("s_waitcnt vmcnt(0)" ::: "memory");
    __syncthreads();
    if (threadIdx.x == 0) {
        unsigned* bar = b.bar;
        __builtin_amdgcn_s_waitcnt(0);
        unsigned nloc = b.st[0], nx = b.st[1];
        if (nloc == 0u) { xcd_barrier_complete(bar, b.x, nloc, nx); b.st[0] = nloc; b.st[1] = nx; }
        const unsigned old = xb_add(&bar[XB_XSUB(b.x)], 1u);
        const unsigned gen = old / nloc;
        if (old + 1u == (gen + 1u) * nloc) {
            __builtin_amdgcn_fence(__ATOMIC_RELEASE, "agent");
            asm volatile("s_waitcnt vmcnt(0)" ::: "memory");
            const unsigned og = xb_add(&bar[XB_TOP], 1u);
            const unsigned tg = og / nx;
            if (og + 1u == (tg + 1u) * nx) xb_add(&bar[XB_TOPGEN], 1u);
            else XB_SPIN(xb_ld(&bar[XB_TOPGEN]) == tg, bar);
            __builtin_amdgcn_fence(__ATOMIC_ACQUIRE, "agent");
            xb_add(&bar[XB_XGEN(b.x)], 1u);
            asm volatile("s_waitcnt vmcnt(0)" ::: "memory");
        } else {
            XB_SPIN(xb_ld(&bar[XB_XGEN(b.x)]) == gen, bar);
            __builtin_amdgcn_fence(__ATOMIC_ACQUIRE, "agent");
            asm volatile("s_waitcnt vmcnt(0)" ::: "memory");
        }
    }
    __syncthreads();
}

constexpr int SLICE_BYTES = 16384 * 128;
constexpr int PEER_TT = 128, PEER_NT = PEER_TT / 8;
struct PeerIdxW { u32x4 e4[4]; };
struct PeerVRows { u32x4 r[16]; unsigned hb; };
struct UTile { u32x4 a0, a1, e0, e1, e2; unsigned n, off; };
struct UBuf { i32x4 b0[2], b1[2]; unsigned en[2]; };
DI void peer_u_lds_phase(const Args& a, LAS unsigned char* lds, int tid, int lane, int wave) {
    LAS int* rslot = (LAS int*)(lds + LDS_BYTES - 64);
    unsigned* ctl = (unsigned*)(a.ws + WS_CTL);
    const int xcd = (int)(xb_xcc_id() & 7u);
    for (;;) {
        __syncthreads();
        if (tid == 0) { int role = -1;
            if (__hip_atomic_load(ctl + CW_ROLE + 512, __ATOMIC_RELAXED, __HIP_MEMORY_SCOPE_AGENT) < 256u)
                for (int q = 0; q < 8 && role < 0; ++q) { const int x = (xcd + q) & 7; const unsigned r = atomicAdd(ctl + CW_ROLE + 64 * x, 1u); if (r < 32u) role = (int)((((unsigned)x + 8u * (r >> 4)) << 4) | (r & 15u)); }
            if (role >= 0) atomicAdd(ctl + CW_ROLE + 512, 1u);
            *rslot = role; }
        __syncthreads();
        const int role = *rslot; if (role < 0) break;
        const int s = role >> 4, g = role & 15;
        { const unsigned char* src = a.ws + WS_UB + (size_t)s * SLICE_BYTES + (size_t)g * 131072;
#pragma unroll
          for (int hb = 0; hb < 2; ++hb) { u32x4 v[8];
#pragma unroll
            for (int i = 0; i < 8; ++i) v[i] = *(const u32x4*)(src + (size_t)(tid + 512 * (8 * hb + i)) * 16);
#pragma unroll
            for (int i = 0; i < 8; ++i) { const int idx = tid + 512 * (8 * hb + i), e = idx >> 3, c = idx & 7; *(LAS u32x4*)(lds + e * 128 + ((c ^ ((e >> 1) & 7)) << 4)) = v[i]; } } }
        __syncthreads();
        const int j = lane & 15, kg = lane >> 4;
        const __amdgpu_buffer_rsrc_t Hb = __builtin_amdgcn_make_buffer_rsrc((void*)(a.ws + WS_HQ8), 0, 32 << 20, 0x00020000);
        const __amdgpu_buffer_rsrc_t Mb = __builtin_amdgcn_make_buffer_rsrc((void*)(a.ws + WS_LISTM), 0, 16 << 20, 0x00020000);
        const __amdgpu_buffer_rsrc_t Lb = __builtin_amdgcn_make_buffer_rsrc((void*)(a.ws + WS_LIST + (size_t)g * (8 << 20)), 0, 8 << 20, 0x00020000);
        const __amdgpu_buffer_rsrc_t Cb = __builtin_amdgcn_make_buffer_rsrc((void*)(ctl + CW_CNT), 0, 131072, 0x00020000);
        const __amdgpu_buffer_rsrc_t Pb = __builtin_amdgcn_make_buffer_rsrc((void*)(a.ws + WS_PU + (size_t)s * M * 256), 0, M * 256, 0x00020000);
        auto load = [&](UTile& t, int T) {
            t.n = (unsigned)__builtin_amdgcn_raw_buffer_load_b32(Cb, 0, (T * 16 + g) * 4, 0); t.off = (unsigned)__builtin_amdgcn_raw_buffer_load_b32(Cb, 0, (CW_OFF - CW_CNT + T * 16 + g) * 4, 0);
            t.a0 = __builtin_bit_cast(u32x4, __builtin_amdgcn_raw_buffer_load_b128(Hb, j * DM + 128 * s + 16 * kg, T * (16 * DM), 0));
            t.a1 = __builtin_bit_cast(u32x4, __builtin_amdgcn_raw_buffer_load_b128(Hb, j * DM + 128 * s + 16 * kg + 64, T * (16 * DM), 0));
            t.e0 = __builtin_bit_cast(u32x4, __builtin_amdgcn_raw_buffer_load_b128(Mb, j * 16, T * 16384 + g * 1024, 0));
            t.e1 = __builtin_bit_cast(u32x4, __builtin_amdgcn_raw_buffer_load_b128(Mb, j * 16 + 256, T * 16384 + g * 1024, 0));
            t.e2 = __builtin_bit_cast(u32x4, __builtin_amdgcn_raw_buffer_load_b128(Mb, j * 16 + 512, T * 16384 + g * 1024, 0)); };
        auto issue = [&](UBuf& B, unsigned ea, unsigned eb) {
            B.en[0] = ea; B.en[1] = eb;
#pragma unroll
            for (int v = 0; v < 2; ++v) {
                const unsigned ad = (B.en[v] & 0x1FFFFu) ^ ((unsigned)kg << 4);
                B.b0[v] = *(const LAS i32x4*)(lds + ad); B.b1[v] = *(const LAS i32x4*)(lds + (ad ^ 64u)); }
            __builtin_amdgcn_sched_barrier(0); };
        auto finish = [&](const UBuf& B, const i32x4 a0, const i32x4 a1, int rt0, int so) {
            i32x4 c[2];
#pragma unroll
            for (int v = 0; v < 2; ++v) c[v] = __builtin_amdgcn_mfma_i32_16x16x64_i8(a0, B.b0[v], (i32x4){0, 0, 0, 0}, 0, 0, 0);
#pragma unroll
            for (int v = 0; v < 2; ++v) c[v] = __builtin_amdgcn_mfma_i32_16x16x64_i8(a1, B.b1[v], c[v], 0, 0, 0);
            __builtin_amdgcn_sched_barrier(0);
            asm volatile("s_nop 7\n\ts_nop 3" ::: "memory");
            __builtin_amdgcn_sched_barrier(0);
#pragma unroll
            for (int v = 0; v < 2; ++v) {
                int m0, m1, v01, v23, val;
                asm("v_bfe_i32 %0, %1, 17, 1" : "=v"(m0) : "v"(B.en[v])); asm("v_bfe_i32 %0, %1, 18, 1" : "=v"(m1) : "v"(B.en[v]));
                asm("v_bfi_b32 %0, %1, %2, %3" : "=v"(v01) : "v"(m0), "v"(c[v][1]), "v"(c[v][0])); asm("v_bfi_b32 %0, %1, %2, %3" : "=v"(v23) : "v"(m0), "v"(c[v][3]), "v"(c[v][2]));
                asm("v_bfi_b32 %0, %1, %2, %3" : "=v"(val) : "v"(m1), "v"(v23), "v"(v01));
                if ((B.en[v] >> 24) == (unsigned)kg) __builtin_amdgcn_raw_buffer_store_b16((unsigned short)(val >> 6), Pb, (16 * (rt0 + v) + j) * 2, so, 0); }
            __builtin_amdgcn_sched_barrier(0); };
        auto proc = [&](const UTile& t, int T) {
            const int n = (int)__builtin_amdgcn_readfirstlane(t.n), nh = (n + 31) >> 5, nrt = (n + 15) >> 4;
            const i32x4 a0 = __builtin_bit_cast(i32x4, t.a0), a1 = __builtin_bit_cast(i32x4, t.a1);
            const int so = T * 4096 + 2 * (int)__builtin_amdgcn_readfirstlane(t.off);
            UBuf B0, B1;
            if (nh > 0) { issue(B0, t.e0.x, t.e0.y);
                if (nh > 1) { issue(B1, t.e0.z, t.e0.w); finish(B0, a0, a1, 0, so);
                    if (nh > 2) { issue(B0, t.e1.x, t.e1.y); finish(B1, a0, a1, 2, so);
                        if (nh > 3) { issue(B1, t.e1.z, t.e1.w); finish(B0, a0, a1, 4, so);
                            if (nh > 4) { issue(B0, t.e2.x, t.e2.y); finish(B1, a0, a1, 6, so);
                                if (nh > 5) { issue(B1, t.e2.z, t.e2.w); finish(B0, a0, a1, 8, so); finish(B1, a0, a1, 10, so); }
                                else finish(B0, a0, a1, 8, so); }
                            else finish(B1, a0, a1, 6, so); }
                        else finish(B0, a0, a1, 4, so); }
                    else finish(B1, a0, a1, 2, so); }
                else finish(B0, a0, a1, 0, so); }
            if (nrt > 12) {
#pragma unroll 1
                for (int c0 = 12; c0 < nrt; c0 += 4) { const u32x4 x0 = __builtin_bit_cast(u32x4, __builtin_amdgcn_raw_buffer_load_b128(Lb, j * 512 + c0 * 4, T * 8192, 0));
                    issue(B0, x0.x, x0.y); finish(B0, a0, a1, c0, so);
                    if (c0 + 2 < nrt) { issue(B0, x0.z, x0.w); finish(B0, a0, a1, c0 + 2, so); } }
                __builtin_amdgcn_s_waitcnt(0x0F70);
            } };
        UTile t0, t1, t2, t3; load(t0, wave); __builtin_amdgcn_sched_barrier(0); load(t1, wave + 8); __builtin_amdgcn_sched_barrier(0); load(t2, wave + 16); __builtin_amdgcn_sched_barrier(0);
#pragma unroll 1
        for (int T = wave; T < M / 16; T += 32) {
            const int Tn = T + 32 < M / 16 ? T + 32 : T;
            load(t3, T + 24);
            proc(t0, T);
            load(t0, Tn);
            proc(t1, T + 8);
            load(t1, Tn + 8);
            proc(t2, T + 16);
            load(t2, Tn + 16);
            proc(t3, T + 24);
        }
    }
}
struct RedTile { unsigned e[4], pi[4]; float gt[4], dq[2]; u32x2 v[16]; unsigned offw; };
DI void peer_reduce_load(const Args& a, RedTile& R, int T, int tid, int lane, int wave) {
    const unsigned* EI = (const unsigned*)(a.ws + WS_EI); const float* EG = (const float*)(a.ws + WS_EG); const unsigned* PIDX = (const unsigned*)(a.ws + WS_PIDX);
#pragma unroll
    for (int i = 0; i < 4; ++i) { const size_t idx = (size_t)(16 * T + 2 * wave + (i >> 1)) * 128 + 64 * (i & 1) + lane; R.e[i] = EI[idx]; R.gt[i] = EG[idx]; R.pi[i] = PIDX[idx]; }
#pragma unroll
    for (int tl = 0; tl < 2; ++tl) R.dq[tl] = ((const float*)(a.ws + WS_DQ))[16 * T + 2 * wave + tl];
    const unsigned char* src = a.ws + WS_PU + (size_t)T * 4096 + (size_t)tid * 8;
#pragma unroll
    for (int i = 0; i < 16; ++i) R.v[i] = *(const u32x2*)(src + (size_t)i * (4 << 20));
    R.offw = ((const unsigned*)(a.ws + WS_CTL))[CW_OFF + T * 16 + (tid & 15)];
}
DI void peer_reduce_step(const Args& a, LAS unsigned char* lds, const RedTile& C, int T, RedTile& N, int Tn, int tid, int lane, int wave) {
    const float* isU = (const float*)(a.ws + WS_UB + TAB_SCALE_OFF); const float* isV = (const float*)(a.ws + WS_VB + TAB_SCALE_OFF);
    LAS unsigned* loff = (LAS unsigned*)(lds + 131072);
    float su[4], sv[4];
#pragma unroll
    for (int i = 0; i < 4; ++i) { su[i] = isU[C.e[i]]; sv[i] = isV[C.e[i]]; }
    __builtin_amdgcn_sched_barrier(0);
    peer_reduce_load(a, N, Tn, tid, lane, wave);
    __builtin_amdgcn_sched_barrier(0);
    LDS_WAIT(); __builtin_amdgcn_s_barrier(); asm volatile("" ::: "memory");
#pragma unroll
    for (int i = 0; i < 16; ++i) *(LAS u32x2*)(lds + i * 4096 + tid * 8) = C.v[i];
    if (tid < 16) loff[tid] = C.offw;
    LDS_WAIT(); __builtin_amdgcn_s_barrier(); asm volatile("" ::: "memory");
#pragma unroll
    for (int i = 0; i < 4; ++i) { const size_t idx = (size_t)(16 * T + 2 * wave + (i >> 1)) * 128 + 64 * (i & 1) + lane;
        const unsigned q = loff[C.e[i] >> 10] + C.pi[i]; int isum = 0;
#pragma unroll
        for (int s = 0; s < 16; ++s) isum += (int)*(const LAS short*)(lds + s * 4096 + q * 2);
        const float w = gelu_tanh((float)(isum * 64 + 512) * C.dq[i >> 1] * su[i]) * C.gt[i] * sv[i];
        ((unsigned*)(a.ws + WS_W))[idx] = C.e[i] | ((__float_as_uint(w) + 0x7fffu + ((__float_as_uint(w) >> 16) & 1u)) & 0xffff0000u); }
}
DI void peer_reduce_phase(const Args& a, LAS unsigned char* lds, int G, int tid, int lane, int wave) {
    constexpr int NT = M / 16; int T = blockIdx.x;
    if (T >= NT) return;
    RedTile A, B; peer_reduce_load(a, A, T, tid, lane, wave);
#pragma unroll 1
    for (; T < NT; T += 2 * G) { const int T1 = T + G, T2 = T + 2 * G;
        peer_reduce_step(a, lds, A, T, B, T1 < NT ? T1 : T, tid, lane, wave);
        if (T1 < NT) peer_reduce_step(a, lds, B, T1, A, T2 < NT ? T2 : T1, tid, lane, wave);
    }
}
DI void peer_v_item(const Args& a, int s, int tt, int lane, int wave) {
    const int g = lane >> 3, c8 = lane & 7;
    const __amdgpu_buffer_rsrc_t Vb = __builtin_amdgcn_make_buffer_rsrc((void*)(a.ws + WS_VB), 0, 32 << 20, 0x00020000);
    const __amdgpu_buffer_rsrc_t Wb = __builtin_amdgcn_make_buffer_rsrc((void*)(a.ws + WS_W), 0, 8 << 20, 0x00020000);
    const __amdgpu_buffer_rsrc_t Ob = __builtin_amdgcn_make_buffer_rsrc((void*)a.out, 0, (int)((size_t)M * DM * 4), 0x00020000);
    const __amdgpu_buffer_rsrc_t Hbb = __builtin_amdgcn_make_buffer_rsrc((void*)(a.ws + WS_HB), 0, (int)((size_t)M * DM * 2), 0x00020000);
    const int tok0 = PEER_TT * tt + wave;
    const int col = 128 * s + 2 * lane;
    const int psrc = ((lane >> 3) + 8 * (lane & 7)) * 4;
    auto pre = [&](PeerIdxW& E, int t) {
#pragma unroll
        for (int j = 0; j < 4; ++j) E.e4[j] = __builtin_bit_cast(u32x4, __builtin_amdgcn_raw_buffer_load_b128(Wb, g * 64 + 16 * j, (tok0 + 8 * t) * 512, 0)); };
    auto rows = [&](PeerVRows& R, const PeerIdxW& E, int t) {
#pragma unroll
        for (int i = 0; i < 16; ++i) R.r[i] = __builtin_bit_cast(u32x4, __builtin_amdgcn_raw_buffer_load_b128(Vb, (int)(E.e4[i >> 2][i & 3] & 0xffffu) * 128 + 16 * c8, s * SLICE_BYTES, 0));
        R.hb = (unsigned)__builtin_amdgcn_raw_buffer_load_b32(Hbb, col * 2, (tok0 + 8 * t) * (DM * 2), 0); };
    auto comp = [&](const PeerVRows& R, const u32x4 (&w4)[4], int t) {
        f32x2 o2[8];
#pragma unroll
        for (int j = 0; j < 8; ++j) o2[j] = (f32x2){0.f, 0.f};
#pragma unroll
        for (int i = 0; i < 16; ++i) { const float w = __uint_as_float(w4[i >> 2][i & 3] & 0xffff0000u); const f32x2 w2 = (f32x2){w, w};
#pragma unroll
            for (int q = 0; q < 4; ++q) { const unsigned u = R.r[i][q]; o2[2 * q] += w2 * __builtin_amdgcn_cvt_pk_f32_fp8(u, false); o2[2 * q + 1] += w2 * __builtin_amdgcn_cvt_pk_f32_fp8(u, true); } }
        float v[16];
#pragma unroll
        for (int j = 0; j < 8; ++j) { v[2 * j] = o2[j][0]; v[2 * j + 1] = o2[j][1]; }
#pragma unroll
        for (int i = 0; i < 8; ++i) { float x = v[i], y = v[i + 8];
            asm volatile("s_nop 1\n\tv_permlane32_swap_b32 %0, %1" : "+v"(x), "+v"(y)); v[i] = x + y; }
#pragma unroll
        for (int i = 0; i < 4; ++i) { float x = v[i], y = v[i + 4];
            asm volatile("s_nop 1\n\tv_permlane16_swap_b32 %0, %1" : "+v"(x), "+v"(y)); v[i] = x + y; }
        { const bool up = (lane & 8) != 0;
#pragma unroll
          for (int i = 0; i < 2; ++i) { const float send = up ? v[i] : v[i + 2], keep = up ? v[i + 2] : v[i]; v[i] = keep + dpp_f<0x128>(send); } }
        f32x2 h2 = (f32x2){bflo(R.hb), bfhi(R.hb)};
        h2[0] += __builtin_bit_cast(float, __builtin_amdgcn_ds_bpermute(psrc, __builtin_bit_cast(int, v[0]))); h2[1] += __builtin_bit_cast(float, __builtin_amdgcn_ds_bpermute(psrc, __builtin_bit_cast(int, v[1])));
        __builtin_amdgcn_raw_buffer_store_b64(__builtin_bit_cast(u32x2, h2), Ob, col * 4, (tok0 + 8 * t) * (DM * 4), 0); };
    PeerIdxW E0, E1; PeerVRows R0, R1; u32x4 wa[4], wb[4];
    pre(E0, 0); pre(E1, 1); rows(R0, E0, 0);
#pragma unroll
    for (int j = 0; j < 4; ++j) wa[j] = E0.e4[j];
#pragma unroll 1
    for (int t = 0; t < PEER_NT; t += 2) {
        rows(R1, E1, t + 1);
#pragma unroll
        for (int j = 0; j < 4; ++j) wb[j] = E1.e4[j];
        if (t + 2 < PEER_NT) pre(E0, t + 2);
        comp(R0, wa, t);
        if (t + 2 < PEER_NT) { rows(R0, E0, t + 2);
#pragma unroll
            for (int j = 0; j < 4; ++j) wa[j] = E0.e4[j]; }
        if (t + 3 < PEER_NT) pre(E1, t + 3);
        comp(R1, wb, t + 1);
    }
}
template <int VPH> DI void peer_sliced_phase(const Args& a, LAS unsigned char* lds, int tid, int lane, int wave) {
    LAS int* qslot = (LAS int*)(lds + LDS_BYTES - 64);
    const int xcd = (int)(xb_xcc_id() & 7u);
    constexpr int NI = 2 * (M / PEER_TT);
    unsigned* heads = (unsigned*)(a.ws + WS_CTL) + (VPH ? CW_PQV : CW_PQU);
    int qi = 0;
    auto claim_from = [&](int& r8) -> int {
        while (r8 < 8) { const int q = (xcd + r8) & 7; const unsigned r = atomicAdd(heads + 64 * q, 1u); if (r < (unsigned)NI) return (q << 12) | (int)r; ++r8; }
        return -1; };
    if (tid == 0) *qslot = claim_from(qi);
    __syncthreads();
    for (;;) {
        const int code = *qslot;
        if (code < 0) break;
        __syncthreads();
        unsigned nx = 0u;
        if (tid == 0 && qi < 8) nx = atomicAdd(heads + 64 * ((xcd + qi) & 7), 1u);
        const int q = code >> 12, i = code & 4095;
        const int s = q + 8 * (i / (M / PEER_TT)), tt = i % (M / PEER_TT);
        int l2 = (int)(threadIdx.x & 63u); asm volatile("" : "+v"(l2));
        peer_v_item(a, s, tt, l2, wave);
        if (tid == 0) { int nc;
            if (qi < 8 && nx < (unsigned)NI) nc = (((xcd + qi) & 7) << 12) | (int)nx;
            else { if (qi < 8) ++qi; nc = claim_from(qi); }
            *qslot = nc; }
        __syncthreads();
    }
}

constexpr int NPHASE = 10;
#ifndef DEPH4
#define DEPH4 2
#endif
#ifndef DEPH5
#define DEPH5 0
#endif
#ifndef REPK
#define REPK -1
#endif
#define NREP(k) ((REPK) == (k) ? 2 : 1)
#ifndef PHMASK
#define PHMASK 0x3ff
#endif
#ifndef N_LAUNCH_MODE
#define N_LAUNCH_MODE 1
#endif
__global__ void __launch_bounds__(NTHREADS, 2) fwd_kernel(Args a) {
    extern __shared__ __attribute__((aligned(16))) unsigned char lds_raw[];
    LAS unsigned char* lds = (LAS unsigned char*)lds_raw;
    cg::grid_group grid = cg::this_grid();
    int tid = threadIdx.x, lane = tid & 63, wave = __builtin_amdgcn_readfirstlane(tid >> 6);
    const int G = gridDim.x, NGW = G * NWAVES; int gw = blockIdx.x * NWAVES + wave;
#define FRESH() do { tid = threadIdx.x; asm volatile("" : "+v"(tid)); lane = tid & 63; wave = __builtin_amdgcn_readfirstlane(tid >> 6); gw = blockIdx.x * NWAVES + wave; } while (0)
    unsigned char* ws = a.ws;
    const int lo = a.ph_lo, hi = a.ph_hi;
#define IN(k) (lo <= (k) && (k) < hi)
#define SEAM(k) do { if (IN(k) && IN((k) + 1)) { if ((k) == 0) grid.sync(); else xcd_barrier(xbar); } } while (0)
    volatile LAS unsigned* xst = (volatile LAS unsigned*)(lds + LDS_BYTES - 32);
    if (tid < 2) xst[tid] = 0u;
    __syncthreads();
    constexpr bool SELF_ZERO = (N_LAUNCH_MODE == 1);
    XcdBarrier xbar;
    if constexpr (SELF_ZERO) { unsigned* ctl0 = (unsigned*)(ws + WS_CTL);
        for (int i = blockIdx.x * NTHREADS + tid; i < 16384; i += G * NTHREADS) ctl0[i] = 0u;
        xbar.bar = ctl0 + CW_XBAR; xbar.x = xb_xcc_id(); xbar.st = xst; }
    else xbar = xcd_barrier_post((unsigned*)(ws + WS_CTL) + CW_XBAR, xst);
    if (((PHMASK >> 0) & 1) && IN(0)) { FRESH(); for (int rep = 0; rep < NREP(0); ++rep) phase_prep(a, lds, gw, NGW, lane, wave);
        for (int tile = blockIdx.x; tile < NP / 16; tile += G) coltile_q8_item(a.in[I_WIN], NPROJ, ws + WS_WIN, (float*)(ws + SM_SWC), lds, tile, tid); }
    SEAM(0);
    if constexpr (SELF_ZERO) { if (threadIdx.x == 0) (void)xb_add(&xbar.bar[XB_XCNT(xbar.x)], 1u); }
    if (((PHMASK >> 1) & 1) && IN(1)) { FRESH();
        pg8::Gemm g{(const bf16_t*)(ws + WS_XN), (const bf16_t*)(ws + WS_WIN), M, NP, DM / 2}; pg8::StaticOrder S; S.init(M, NP, G, (int)blockIdx.x);
        pg8::EpiBf16 E{(bf16_t*)(ws + WS_P), NP, (const float*)(ws + SM_LB), (const float*)(ws + WS_XN + 32 * MiB), (const float*)(ws + SM_SWC)};
#pragma unroll 1
        for (int pass = 0; pass < 2; ++pass) {
            const int b = (int)blockIdx.x; int u0, un, us;
            if (pass == 0) { const int nodd = (G >> 4) * 8 + ((G & 15) > 8 ? (G & 15) - 8 : 0); un = 2 * (FILL_SPLIT - FILL_TAIL);
                if (nodd == 0) { u0 = b; us = G; } else if ((b >> 3) & 1) { u0 = (b >> 4) * 8 + (b & 7); us = nodd; } else { u0 = un; us = 1; } }
            else { const int rem = ((M / 256) * (NP / 256)) % G; un = FILL_TAIL;
                if (rem == 0) { u0 = b; us = G; } else if (b >= rem) { u0 = b - rem; us = G - rem; } else { u0 = un; us = 1; } }
            const int sh = pass == 0 ? 1 : 0, ibase = pass == 0 ? FILL_TAIL : 0;
            for (int u = u0; u < un; u += us) peer_conv_rows(a, 0, ((ibase + (u >> sh)) * 8 + wave) * FILL_RP + (u & sh) * (FILL_RP / 2), FILL_RP >> sh, lane);
            if (pass == 0) { for (int rep = 0; rep < NREP(1); ++rep) pg8::gemm_phase<pg8::EpiBf16, pg8::StaticOrder, true, true, true>(lds, g, S, E); }
        }
    }
    SEAM(1);
    if (((PHMASK >> 2) & 1) && IN(2)) { FRESH();
        for (int row = gw; row < M; row += NGW) nsa_norm_row(a, row, lane);
        for (int rep = 0; rep < NREP(2); ++rep) {
        for (int it = gw; it < 2048; it += NGW) vtrans_item(a, lds + wave * 9216, it, lane);
        __syncthreads();
        for (int it = blockIdx.x; it < 256; it += G) compress_item(a, lds, it, tid, lane, wave);
        }
    }
    SEAM(2);
    if (((PHMASK >> 3) & 1) && IN(3)) { FRESH();
        LAS int* qslot = (LAS int*)(lds + LDS_BYTES - 64);
        for (int rep = 0; rep < ((REPK) == 30 || (REPK) == 31 ? 2 : 1); ++rep) {
        unsigned* qhead = (unsigned*)(ws + WS_CTL) + CW_QUEUE + 64 * rep;
        const int item_lo = (rep == 1 && (REPK) == 31) ? 64 : 0, item_hi = (rep == 1 && (REPK) == 30) ? 64 : 64 + 1024 + FILL_END - FILL_SPLIT;
        for (;;) {
            __syncthreads();
            if (tid == 0) *qslot = (int)atomicAdd(qhead, 1u);
            __syncthreads();
            const int item = *qslot + item_lo;
            if (item >= item_hi) break;
            int tid2 = tid; asm volatile("" : "+v"(tid2));
            const int lane2 = tid2 & 63, wave2 = __builtin_amdgcn_readfirstlane(tid2 >> 6);

#ifndef NO_HGRN
            if (item < 64) hgrn_item(a, lds, item, tid2, lane2, wave2);
#endif
#ifndef NO_ATTN
            if (item >= 64) {
                constexpr int NF = FILL_END - FILL_SPLIT, NT = 1024 + NF; const int k = item - 64;
                const int a0 = (int)(((long)k * 1024) / NT), a1 = (int)(((long)(k + 1) * 1024) / NT);
                if (a1 != a0) attn_item(a, lds, a0, tid2, lane2, wave2); else filler_item(a, lds, k - a0 + FILL_SPLIT, lane2, wave2); }
#endif

        }
        }
    }
    SEAM(3);
    if (((PHMASK >> 4) & 1) && IN(4)) { FRESH();
        rowquant_mix(a, gw, NGW, lane);
        xcd_barrier(xbar);
        FRESH();
        pg8::Gemm g{(const bf16_t*)(ws + WS_MIX8), (const bf16_t*)(ws + WS_WOUT), M, DM, DM / 2}; pg8::StaticOrder S; S.init(M, DM, G, (int)blockIdx.x);
        pg8::EpiH E{a.in[I_X], (bf16_t*)(ws + WS_HB), (const float*)(ws + WS_MIX8 + 32 * MiB), (const float*)(ws + SM_SWO), lds + 131072};
        if ((blockIdx.x >> 3) & 1) { for (int i = 0; i < DEPH4; ++i) __builtin_amdgcn_s_sleep(127); }
        for (int rep = 0; rep < NREP(4); ++rep) pg8::gemm_phase<pg8::EpiH, pg8::StaticOrder, true, true, true>(lds, g, S, E);
    }
    SEAM(4);
    if (((PHMASK >> 5) & 1) && IN(5)) { FRESH();
        rowquant_h(a, gw, NGW, lane);
        xcd_barrier(xbar);
        FRESH();
        pg8::Gemm g{(const bf16_t*)(ws + WS_HQ8), (const bf16_t*)(ws + WS_WQ), M, DM, DM / 2}; pg8::StaticOrder S; S.init(M, DM, G, (int)blockIdx.x);
        pg8::EpiBf16 E{(bf16_t*)(ws + WS_QP), DM, nullptr, (const float*)(ws + WS_DQ), (const float*)(ws + SM_SWQ)};
        if ((blockIdx.x >> 3) & 1) { for (int i = 0; i < DEPH5; ++i) __builtin_amdgcn_s_sleep(127); }
        for (int rep = 0; rep < NREP(5); ++rep) pg8::gemm_phase<pg8::EpiBf16, pg8::StaticOrder, true, true, true>(lds, g, S, E);
    }
    SEAM(5);
    if (((PHMASK >> 6) & 1) && IN(6)) { FRESH(); for (int rep = 0; rep < NREP(6); ++rep) {
        LAS unsigned* lcnt = (LAS unsigned*)(lds + 131072);
        for (int it = gw; it < 4096; it += NGW) { int l2 = lane; asm volatile("" : "+v"(l2));
            if (tid < 32) lcnt[tid] = 0u;
            __syncthreads();
            topk_item(a, lds + wave * 16384, it, l2, lcnt);
            __syncthreads();
            if (tid < 32) { unsigned off = 0u; for (int g2 = 0; g2 < (tid & 15); ++g2) off += lcnt[(tid & 16) + g2];
                unsigned* ctl = (unsigned*)(ws + WS_CTL); const int ti = (2 * (it >> 3) + (tid >> 4)) * 16 + (tid & 15);
                ctl[CW_CNT + ti] = lcnt[tid]; ctl[CW_OFF + ti] = off; }
            { const int li = tid >> 4, g2 = li & 15; const unsigned n = lcnt[li], nup = (n + 63u) & ~63u;
                unsigned* lt = (unsigned*)(ws + WS_LIST) + (size_t)g2 * (1024 * 2048) + (size_t)(2 * (it >> 3) + (li >> 4)) * 2048;
                unsigned* lm = (unsigned*)(ws + WS_LISTM) + (size_t)(2 * (it >> 3) + (li >> 4)) * 4096 + g2 * 256;
#pragma unroll
                for (int k = 0; k < 4; ++k) { const unsigned p = n + (unsigned)(tid & 15) + 16u * k;
                    if (p < nup) { if (p < 256u) lm[(p >> 6) * 64u + (p & 15u) * 4u + ((p >> 4) & 3u)] = 0x80000000u; if (p >= 192u) lt[(p & 15u) * 128u + (p >> 4)] = 0x80000000u; } } }
        } } }
    SEAM(6);
    if (((PHMASK >> 7) & 1) && IN(7)) { FRESH(); peer_u_lds_phase(a, lds, tid, lane, wave); }
    SEAM(7);
    if (((PHMASK >> 8) & 1) && IN(8)) { FRESH(); peer_reduce_phase(a, lds, G, tid, lane, wave); }
    SEAM(8);
    if (((PHMASK >> 9) & 1) && IN(9)) { FRESH(); peer_sliced_phase<1>(a, lds, tid, lane, wave); }
#undef IN
#undef SEAM
}

extern "C" void kernel_launch(void* const* d_in, const int* in_sizes, int n_in, void* d_out, int out_size, void* d_ws, size_t ws_size, hipStream_t stream) {
    static int grid = 0;
    if (grid == 0) {
        int dev = 0, cus = 0, per_cu = 0;
        (void)hipGetDevice(&dev); (void)hipDeviceGetAttribute(&cus, hipDeviceAttributeMultiprocessorCount, dev);
        (void)hipFuncSetAttribute((const void*)fwd_kernel, hipFuncAttributeMaxDynamicSharedMemorySize, LDS_BYTES);
        (void)hipOccupancyMaxActiveBlocksPerMultiprocessor(&per_cu, (const void*)fwd_kernel, NTHREADS, LDS_BYTES);
        if (per_cu < 1) { fprintf(stderr, "occupancy query says %d blocks/CU\n", per_cu); per_cu = 1; }
        grid = cus;
        if (ws_size < WS_END) fprintf(stderr, "warning: ws_size %zu too small\n", ws_size);
    }
    if (N_LAUNCH_MODE != 1) (void)hipMemsetAsync((char*)d_ws + WS_CTL, 0, 65536, stream);
    Args a{};
    for (int i = 0; i < 21; ++i) a.in[i] = (const float*)d_in[i];
    a.out = (float*)d_out; a.ws = (unsigned char*)d_ws;
    if (N_LAUNCH_MODE == 1) {
        a.ph_lo = 0; a.ph_hi = NPHASE;
        void* args[] = {&a};
        hipError_t e = hipLaunchCooperativeKernel((const void*)fwd_kernel, dim3(grid), dim3(NTHREADS), args, LDS_BYTES, stream);
        if (e != hipSuccess) fprintf(stderr, "launch failed: %s\n", hipGetErrorString(e));
    } else {
        for (int p = 0; p < NPHASE; ++p) {
            a.ph_lo = p; a.ph_hi = p + 1;
            void* args[] = {&a};
            hipError_t e = hipLaunchCooperativeKernel((const void*)fwd_kernel, dim3(grid), dim3(NTHREADS), args, LDS_BYTES, stream);
            if (e != hipSuccess) { fprintf(stderr, "launch failed: %s\n", hipGetErrorString(e)); break; }
        }
    }
}
```
